# Optimizing an MI355X kernel written in HIP

```python
import math
import jax, jax.numpy as jnp
from jax import lax
import numpy as np

D_MODEL = 1024
BATCH = 16
SEQ = 256
DEPTH = 4
DEC_BATCH = 2
DEC_SEQ = 1024
PAST_LEN = 256

GRID_W = 64
N_RG = (DEPTH + 1) // 2
N_GLA = DEPTH // 2
N_ADA = 6
EPS = 1e-6
D_RNN = D_MODEL
CONV_W = 4
CONV_LEFT = 2
RG_BLOCKS = 16
RG_BW = D_RNN // RG_BLOCKS
RG_C = 8.0
GLA_HEADS = 4
GLA_DK = D_MODEL // 2 // GLA_HEADS
GLA_DV = D_MODEL // GLA_HEADS
GLA_QK = GLA_HEADS * GLA_DK
GLA_V = GLA_HEADS * GLA_DV
GLA_RANK = 16
GLA_TAU = 16.0
GLA_CHUNK = 64
GLA_IN = 2 * GLA_QK + 2 * GLA_V + 2 * GLA_RANK
PEER_HEADS = 8
PEER_NKEYS = 128
PEER_N = PEER_NKEYS * PEER_NKEYS
PEER_DKEY = 256
PEER_HALF = PEER_DKEY // 2
PEER_TOPK = 16
PEER_BLOCK = 128

kernel_name = 'hybrid_rglru_gla_peer_diffusion_step'


def rmsnorm(x, g):
    xf = x.astype(jnp.float32)
    y = xf * lax.rsqrt(jnp.mean(xf * xf, axis=-1, keepdims=True) + EPS)
    return (y * g.astype(jnp.float32)).astype(x.dtype)


def pre_mod(x, g, shift, scale):
    return rmsnorm(x, g) * (1 + scale) + shift


def ada_mod(cond, w, b):
    m = (jax.nn.silu(cond) @ w + b).reshape(cond.shape[0], N_ADA, cond.shape[-1])
    return [m[:, i, None, :] for i in range(N_ADA)]


def grid_pos_embed(rows, dim):
    t = jnp.arange(rows * GRID_W)
    r = (t // GRID_W).astype(jnp.float32)
    col = (t % GRID_W).astype(jnp.float32)
    nf = dim // 4
    freq = 1.0 / (10000.0 ** (jnp.arange(nf, dtype=jnp.float32) / nf))
    ar = r[:, None] * freq
    ac = col[:, None] * freq
    return jnp.concatenate([jnp.sin(ar), jnp.cos(ar), jnp.sin(ac), jnp.cos(ac)], axis=-1)


def to_col_major(x, rows):
    b, n, d = x.shape
    return x.reshape(b, rows, GRID_W, d).swapaxes(1, 2).reshape(b, n, d)


def from_col_major(x, rows):
    b, n, d = x.shape
    return x.reshape(b, GRID_W, rows, d).swapaxes(1, 2).reshape(b, n, d)


def centred_conv(x, w, b):
    L = x.shape[1]
    xp = jnp.pad(x, ((0, 0), (CONV_LEFT, CONV_W - 1 - CONV_LEFT), (0, 0)))
    return sum(xp[:, j:j + L] * w[j] for j in range(CONV_W)) + b


def block_diag(x, w, b):
    xb = x.reshape(x.shape[:-1] + (RG_BLOCKS, RG_BW))
    return jnp.einsum('blni,nij->blnj', xb, w).reshape(x.shape) + b


def linear_scan(a, b, h0):
    b = b.at[:, 0].add(a[:, 0] * h0)
    def comb(l, r):
        return (l[0] * r[0], r[0] * l[1] + r[1])
    _, h = lax.associative_scan(comb, (a, b), axis=1)
    return h


def rglru_dir(xc, wa, ba, wi, bi, lam, h0):
    r = jax.nn.sigmoid(block_diag(xc, wa, ba).astype(jnp.float32))
    i = jax.nn.sigmoid(block_diag(xc, wi, bi).astype(jnp.float32))
    log_a = -RG_C * r * jax.nn.softplus(-lam.astype(jnp.float32))
    a = jnp.exp(log_a)
    b = jnp.sqrt(-jnp.expm1(2.0 * log_a)) * (i * xc)
    h = linear_scan(a, b, h0.astype(jnp.float32))
    return h, h[:, -1]


def rglru_mixer(xm, p, h0):
    w_in, conv_w, conv_b, wa, ba, wi, bi, lam, w_out = p
    proj = xm @ w_in
    gate_br = jax.nn.gelu(proj[..., :D_RNN])
    xr = centred_conv(proj[..., D_RNN:], conv_w, conv_b).astype(jnp.float32)
    hf, sf = rglru_dir(xr, wa[0], ba[0], wi[0], bi[0], lam[0], h0[:, 0])
    hb, sb = rglru_dir(xr[:, ::-1], wa[1], ba[1], wi[1], bi[1], lam[1], h0[:, 1])
    h = hf + hb[:, ::-1]
    out = (gate_br * h.astype(gate_br.dtype)) @ w_out
    return out, jnp.stack([sf, sb], axis=1)


def gla_dir(q, k, v, log_a, s0):
    B, H, L, _ = q.shape
    C = GLA_CHUNK
    n = L // C
    q, k, v, log_a = [t.reshape(B, H, n, C, t.shape[-1]) for t in (q, k, v, log_a)]
    bcum = jnp.cumsum(log_a, axis=3)
    blast = bcum[:, :, :, -1:]
    q_in = q * jnp.exp(bcum)
    k_in = k * jnp.exp(-bcum)
    k_st = k * jnp.exp(blast - bcum)
    mask = jnp.tril(jnp.ones((C, C), dtype=bool))
    att = jnp.where(mask, jnp.einsum('bhnik,bhnjk->bhnij', q_in, k_in), 0.0)
    o_intra = jnp.einsum('bhnij,bhnjv->bhniv', att, v)
    u = jnp.einsum('bhnck,bhncv->bhnkv', k_st, v)
    g = jnp.exp(blast[:, :, :, 0])
    def step(s, inp):
        g_n, u_n = inp
        return g_n[..., None] * s + u_n, s
    s_fin, s_in = lax.scan(step, s0.astype(jnp.float32), (jnp.moveaxis(g, 2, 0), jnp.moveaxis(u, 2, 0)))
    s_in = jnp.moveaxis(s_in, 0, 2)
    o = o_intra + jnp.einsum('bhnck,bhnkv->bhncv', q_in, s_in)
    return o.reshape(B, H, L, -1), s_fin


def gla_mixer(xm, p, s0):
    w_in, w_al, b_al, norm_g, w_out = p
    B, L, _ = xm.shape
    proj = xm @ w_in
    q, k, v, g, z = jnp.split(proj, [GLA_QK, 2 * GLA_QK, 2 * GLA_QK + GLA_V, 2 * GLA_QK + 2 * GLA_V], axis=-1)
    def heads(t, d):
        return t.reshape(B, L, GLA_HEADS, d).transpose(0, 2, 1, 3).astype(jnp.float32)
    qh = heads(q, GLA_DK) * (GLA_DK ** -0.5)
    kh = heads(k, GLA_DK)
    vh = heads(v, GLA_DV)
    z = z.reshape(B, L, 2, GLA_RANK).astype(jnp.float32)
    log_a = jax.nn.log_sigmoid(jnp.einsum('bldr,drk->bldk', z, w_al.astype(jnp.float32)) + b_al.astype(jnp.float32)) / GLA_TAU
    la = log_a.reshape(B, L, 2, GLA_HEADS, GLA_DK).transpose(2, 0, 3, 1, 4)
    of, sf = gla_dir(qh, kh, vh, la[0], s0[:, 0])
    flip = lambda t: t[:, :, ::-1]
    ob, sb = gla_dir(flip(qh), flip(kh), flip(vh), flip(la[1]), s0[:, 1])
    o = (of + flip(ob)).transpose(0, 2, 1, 3)
    o = o * lax.rsqrt(jnp.mean(o * o, axis=-1, keepdims=True) + EPS)
    o = o.reshape(B, L, GLA_V) * norm_g.astype(jnp.float32)
    out = (jax.nn.silu(g.astype(jnp.float32)) * o).astype(xm.dtype) @ w_out
    return out, jnp.stack([sf, sb], axis=1)


def gla_mixer_grid(xm, p, s0, rows):
    out, st = gla_mixer(to_col_major(xm, rows), p, s0)
    return from_col_major(out, rows), st


def peer(xm, wq, k1, k2, u_tab, v_tab):
    B, L, D = xm.shape
    xt = xm.reshape(-1, D)
    T = xt.shape[0]
    q = (xt @ wq).reshape(T, PEER_HEADS, 2, PEER_HALF).astype(jnp.float32)
    s1 = jnp.einsum('thd,hnd->thn', q[:, :, 0], k1.astype(jnp.float32))
    s2 = jnp.einsum('thd,hnd->thn', q[:, :, 1], k2.astype(jnp.float32))
    v1, i1 = lax.top_k(s1, PEER_TOPK)
    v2, i2 = lax.top_k(s2, PEER_TOPK)
    cand = (v1[..., :, None] + v2[..., None, :]).reshape(T, PEER_HEADS, -1)
    cid = (i1[..., :, None] * PEER_NKEYS + i2[..., None, :]).reshape(T, PEER_HEADS, -1)
    sc, pos = lax.top_k(cand, PEER_TOPK)
    eid = jnp.take_along_axis(cid, pos, axis=-1)
    gate = jax.nn.softmax(sc, axis=-1)
    nb = T // PEER_BLOCK
    def block(args):
        xb, eb, gb = args
        ub = jnp.take(u_tab, eb, axis=0)
        act = jax.nn.gelu(jnp.einsum('td,thkd->thk', xb, ub).astype(jnp.float32))
        vb = jnp.take(v_tab, eb, axis=0)
        return jnp.einsum('thk,thkd->td', (gb * act).astype(vb.dtype), vb)
    out = lax.map(block, (xt.reshape(nb, PEER_BLOCK, D),
                          eid.reshape(nb, PEER_BLOCK, PEER_HEADS, PEER_TOPK),
                          gate.reshape(nb, PEER_BLOCK, PEER_HEADS, PEER_TOPK)))
    return out.reshape(B, L, D).astype(xm.dtype)


def setup_inputs(seed: int = 0) -> dict:
    key = jax.random.key(seed)
    ks = jax.random.split(key, 32)
    nrm = lambda k, s, sc: jax.random.normal(k, s, jnp.float32) * sc
    D = D_MODEL
    u = jax.random.uniform(ks[20], (N_RG, 2, D_RNN), jnp.float32, minval=0.9, maxval=0.999)
    s = u ** (1.0 / RG_C)
    rg_lambda = jnp.log(s) - jnp.log1p(-s)
    return {
        'x_prompt': nrm(ks[0], (BATCH, SEQ, D), 1.0),
        'x_sample': nrm(ks[1], (DEC_BATCH, DEC_SEQ, D), 1.0),
        'state_rglru': nrm(ks[2], (DEC_BATCH, N_RG, 2, D_RNN), 1.0),
        'state_gla': nrm(ks[3], (DEC_BATCH, N_GLA, 2, GLA_HEADS, GLA_DK, GLA_DV), 0.5),
        'c': nrm(ks[4], (DEC_BATCH, D), 1.0),
        'c_ctx': nrm(ks[5], (D,), 1.0),
        'norm1_g': 1.0 + nrm(ks[6], (DEPTH, D), 0.02),
        'norm2_g': 1.0 + nrm(ks[7], (DEPTH, D), 0.02),
        'ada_w': nrm(ks[8], (DEPTH, D, N_ADA * D), 0.5 * D ** -0.5),
        'ada_b': nrm(ks[9], (DEPTH, N_ADA * D), 0.02),
        'peer_wq': nrm(ks[10], (DEPTH, D, PEER_HEADS * PEER_DKEY), D ** -0.5),
        'peer_k1': nrm(ks[11], (DEPTH, PEER_HEADS, PEER_NKEYS, PEER_HALF), PEER_HALF ** -0.5),
        'peer_k2': nrm(ks[12], (DEPTH, PEER_HEADS, PEER_NKEYS, PEER_HALF), PEER_HALF ** -0.5),
        'peer_u': nrm(ks[13], (DEPTH, PEER_N, D), D ** -0.5),
        'peer_v': nrm(ks[14], (DEPTH, PEER_N, D), PEER_HEADS ** -0.5),
        'rg_w_in': nrm(ks[15], (N_RG, D, 2 * D_RNN), D ** -0.5),
        'rg_conv_w': nrm(ks[16], (N_RG, CONV_W, D_RNN), CONV_W ** -0.5),
        'rg_conv_b': nrm(ks[17], (N_RG, D_RNN), 0.02),
        'rg_wa': nrm(ks[18], (N_RG, 2, RG_BLOCKS, RG_BW, RG_BW), RG_BW ** -0.5),
        'rg_ba': nrm(ks[19], (N_RG, 2, D_RNN), 0.02),
        'rg_wi': nrm(ks[21], (N_RG, 2, RG_BLOCKS, RG_BW, RG_BW), RG_BW ** -0.5),
        'rg_bi': nrm(ks[22], (N_RG, 2, D_RNN), 0.02),
        'rg_lambda': rg_lambda,
        'rg_w_out': nrm(ks[23], (N_RG, D_RNN, D), D_RNN ** -0.5),
        'gla_w_in': nrm(ks[24], (N_GLA, D, GLA_IN), D ** -0.5),
        'gla_w_alpha': nrm(ks[25], (N_GLA, 2, GLA_RANK, GLA_QK), GLA_RANK ** -0.5),
        'gla_b_alpha': nrm(ks[26], (N_GLA, 2, GLA_QK), 0.1),
        'gla_norm_g': 1.0 + nrm(ks[27], (N_GLA, GLA_V), 0.02),
        'gla_w_out': nrm(ks[28], (N_GLA, GLA_V, D), GLA_V ** -0.5),
        'final_norm_g': 1.0 + nrm(ks[29], (D,), 0.02),
    }


def reference(x_prompt, x_sample, state_rglru, state_gla, c, c_ctx, norm1_g, norm2_g, ada_w, ada_b,
              peer_wq, peer_k1, peer_k2, peer_u, peer_v, rg_w_in, rg_conv_w, rg_conv_b, rg_wa, rg_ba,
              rg_wi, rg_bi, rg_lambda, rg_w_out, gla_w_in, gla_w_alpha, gla_b_alpha, gla_norm_g,
              gla_w_out, final_norm_g):
    bp = x_prompt.shape[0]
    rows = x_sample.shape[1] // GRID_W
    xp = x_prompt
    xs = x_sample + grid_pos_embed(rows, x_sample.shape[-1]).astype(x_sample.dtype)[None]
    rg_new = []
    gla_new = []
    for l in range(DEPTH):
        mod_p = ada_mod(c_ctx[None], ada_w[l], ada_b[l])
        mod_s = ada_mod(c, ada_w[l], ada_b[l])
        j = l // 2
        hp = pre_mod(xp, norm1_g[l], mod_p[0], mod_p[1])
        hs = pre_mod(xs, norm1_g[l], mod_s[0], mod_s[1])
        if l % 2 == 0:
            p = (rg_w_in[j], rg_conv_w[j], rg_conv_b[j], rg_wa[j], rg_ba[j], rg_wi[j], rg_bi[j],
                 rg_lambda[j], rg_w_out[j])
            op, st = rglru_mixer(hp, p, jnp.zeros((bp, 2, D_RNN), jnp.float32))
            rg_new.append(st)
            os_, _ = rglru_mixer(hs, p, state_rglru[:, j])
        else:
            p = (gla_w_in[j], gla_w_alpha[j], gla_b_alpha[j], gla_norm_g[j], gla_w_out[j])
            op, st = gla_mixer(hp, p, jnp.zeros((bp, 2, GLA_HEADS, GLA_DK, GLA_DV), jnp.float32))
            gla_new.append(st)
            os_, _ = gla_mixer_grid(hs, p, state_gla[:, j], rows)
        xp = xp + mod_p[2] * op
        xs = xs + mod_s[2] * os_
        pp = (peer_wq[l], peer_k1[l], peer_k2[l], peer_u[l], peer_v[l])
        xp = xp + mod_p[5] * peer(pre_mod(xp, norm2_g[l], mod_p[3], mod_p[4]), *pp)
        xs = xs + mod_s[5] * peer(pre_mod(xs, norm2_g[l], mod_s[3], mod_s[4]), *pp)
    y_prompt = rmsnorm(xp, final_norm_g)
    y_sample = rmsnorm(xs, final_norm_g)
    new_state_rglru = jnp.stack(rg_new, axis=1)
    new_state_gla = jnp.stack(gla_new, axis=1)
    return (y_prompt, y_sample, new_state_rglru, new_state_gla)
```

```cpp
#include <hip/hip_runtime.h>
#include <stdint.h>
#include <stdio.h>

#ifndef MULTI_LAUNCH
#define MULTI_LAUNCH 0
#endif

typedef __attribute__((ext_vector_type(8))) short bf16x8;
typedef __attribute__((ext_vector_type(4))) float f32x4;
typedef __attribute__((ext_vector_type(16))) float f32x16;
typedef __attribute__((ext_vector_type(2))) __bf16 bf2_t;
typedef unsigned short bf16_t;
typedef unsigned u32x4 __attribute__((ext_vector_type(4)));

#define NTHR 512
#define TTOK 6144
#define DM 1024
#define EPSV 1e-6f

constexpr size_t AL(size_t x) { return (x + 255) & ~(size_t)255; }
constexpr size_t OFF_BAR   = 0;
constexpr size_t OFF_MODS  = 16384;
constexpr size_t OFF_X     = AL(OFF_MODS + (size_t)4 * 3 * 6144 * 4);
constexpr size_t OFF_H     = AL(OFF_X + (size_t)TTOK * DM * 4);
constexpr size_t OFF_Y     = AL(OFF_H + (size_t)TTOK * DM * 2);
constexpr size_t OFF_PB    = AL(OFF_Y + (size_t)TTOK * DM * 2);
constexpr size_t OFF_HF    = AL(OFF_PB + (size_t)TTOK * 3104 * 4);
constexpr size_t OFF_HB    = AL(OFF_HF + (size_t)TTOK * DM * 4);
constexpr size_t OFF_TK    = AL(OFF_HB + (size_t)TTOK * DM * 4);
constexpr size_t OFF_RGWIN = AL(OFF_TK + (size_t)TTOK * 256 * 4);
constexpr size_t OFF_RGWOUT= AL(OFF_RGWIN + (size_t)2 * 2048 * 1024 * 2);
constexpr size_t OFF_GLWIN = AL(OFF_RGWOUT + (size_t)2 * 1024 * 1024 * 2);
constexpr size_t OFF_GLWOUT= AL(OFF_GLWIN + (size_t)2 * 3200 * 1024 * 2);
constexpr size_t OFF_PWQ   = AL(OFF_GLWOUT + (size_t)2 * 1024 * 1024 * 2);
constexpr size_t OFF_PK    = AL(OFF_PWQ + (size_t)4 * 2048 * 1024 * 2);
constexpr size_t OFF_PU    = AL(OFF_PK + (size_t)4 * 2 * 8 * 128 * 128 * 2);
constexpr size_t OFF_PV    = AL(OFF_PU + (size_t)4 * 16384 * 1024);
constexpr size_t OFF_SU    = AL(OFF_PV + (size_t)4 * 16384 * 1024);
constexpr size_t OFF_SV    = AL(OFF_SU + (size_t)4 * 16384 * 4);
constexpr size_t OFF_RGW   = AL(OFF_SV + (size_t)4 * 16384 * 4);
constexpr size_t OFF_QIN   = AL(OFF_RGW + (size_t)2 * 2 * 16 * 2 * 4096 * 2);
constexpr size_t OFF_GD    = AL(OFF_QIN + (size_t)768 * 64 * 136 * 2);
constexpr size_t OFF_UR    = AL(OFF_GD + (size_t)768 * 128 * 4);
constexpr size_t WS_END    = AL(OFF_UR + (size_t)768 * 8 * 16 * 64 * 8);

constexpr size_t OUT_Y    = 0;
constexpr size_t OUT_RG   = (size_t)TTOK * DM;
constexpr size_t OUT_GLA  = OUT_RG + 16 * 2 * 2 * 1024;

struct Params {
    const float* in[30];
    float* out;
    unsigned char* ws;
    int ph_lo, ph_hi;
};

enum { I_XP = 0, I_XS, I_SRG, I_SGLA, I_C, I_CCTX, I_N1G, I_N2G, I_ADAW, I_ADAB, I_PWQ, I_PK1, I_PK2, I_PU, I_PV,
       I_RGWIN, I_RGCW, I_RGCB, I_RGWA, I_RGBA, I_RGWI, I_RGBI, I_RGLAM, I_RGWOUT, I_GLWIN, I_GLWAL, I_GLBAL, I_GLNG, I_GLWOUT, I_FNG };

typedef float f32x2 __attribute__((ext_vector_type(2)));
__device__ __forceinline__ unsigned pack2(float a, float b) {
    f32x2 v = {a, b};
    return __builtin_bit_cast(unsigned, __builtin_convertvector(v, bf2_t));
}
__device__ __forceinline__ unsigned f2bf(float f) { return pack2(f, 0.f) & 0xffffu; }
__device__ __forceinline__ float bflo(unsigned u) { return __uint_as_float(u << 16); }
__device__ __forceinline__ float bfhi(unsigned u) { return __uint_as_float(u & 0xffff0000u); }
__device__ __forceinline__ float sigmoidf_(float x) { return 1.0f / (1.0f + __expf(-x)); }
__device__ __forceinline__ float siluf_(float x) { return x * sigmoidf_(x); }
__device__ __forceinline__ float gelu_tanh(float x) {
    float u = 0.7978845608028654f * (x + 0.044715f * x * x * x);
    float t = __expf(2.0f * u);
    float th = 1.0f - 2.0f / (t + 1.0f);
    return 0.5f * x * (1.0f + th);
}
__device__ __forceinline__ int ltid() { int t = threadIdx.x; asm volatile("" : "+v"(t)); return t; }
__device__ __forceinline__ int cond_of(int tok) { return tok < 4096 ? 0 : 1 + ((tok - 4096) >> 10); }
__device__ __forceinline__ float wave_sum(float v) {
#pragma unroll
    for (int o = 32; o >= 1; o >>= 1) v += __shfl_xor(v, o);
    return v;
}

#define XB_TMO      128
#define XB_XCNT(j)  (256  + 64 * (j))
#define XB_XSUB(j)  (1280 + 64 * (j))
#define XB_XGEN(j)  (2304 + 64 * (j))
#define XB_TOP      3328
#define XB_TOPGEN   3392
#define XCD_BAR_WORDS 3456
#define XB_SPIN_CAP (1u << 22)
#define LAS __attribute__((address_space(3)))

__device__ __forceinline__ unsigned xb_ld(unsigned* p)              { return __hip_atomic_load(p, __ATOMIC_RELAXED, __HIP_MEMORY_SCOPE_AGENT); }
__device__ __forceinline__ unsigned xb_add(unsigned* p, unsigned v) { return __hip_atomic_fetch_add(p, v, __ATOMIC_RELAXED, __HIP_MEMORY_SCOPE_AGENT); }
__device__ __forceinline__ unsigned xb_xcc_id() { return (unsigned)__builtin_amdgcn_s_getreg((3 << 11) | 20) & 0xFu; }
#define XB_SPIN(cond, bar) do { unsigned _sp = 0; while (cond) { __builtin_amdgcn_s_sleep(1); \
    if ((++_sp & 255u) == 0u) { if (xb_ld(&(bar)[XB_TMO])) break; if (_sp > XB_SPIN_CAP) { atomicAdd(&(bar)[XB_TMO], 1u); break; } } } } while (0)

struct XcdBarrier { unsigned* bar; unsigned x; volatile LAS unsigned* st; };

__device__ __forceinline__ XcdBarrier xcd_barrier_post(unsigned* bar, volatile LAS unsigned* st) {
    XcdBarrier b; b.bar = bar; b.x = xb_xcc_id(); b.st = st;
    if (threadIdx.x == 0) (void)xb_add(&bar[XB_XCNT(b.x)], 1u);
    return b;
}
__device__ __forceinline__ void xcd_barrier_complete(unsigned* bar, unsigned x, unsigned& nloc, unsigned& nx) {
    const unsigned G = gridDim.x * gridDim.y * gridDim.z;
    unsigned sum, cnt, mine, sp = 0u;
    for (;;) {
        sum = 0u; cnt = 0u; mine = 0u;
#pragma unroll
        for (unsigned j = 0; j < 16; ++j) { const unsigned c = xb_ld(&bar[XB_XCNT(j)]); sum += c; cnt += (c > 0u) ? 1u : 0u; mine = (j == x) ? c : mine; }
        if (sum == G) break;
        __builtin_amdgcn_s_sleep(1);
        if ((++sp & 255u) == 0u) { if (xb_ld(&bar[XB_TMO])) break; if (sp > XB_SPIN_CAP) { atomicAdd(&bar[XB_TMO], 1u); break; } }
    }
    nloc = mine > 0u ? mine : 1u; nx = cnt > 0u ? cnt : 1u;
}
__device__ __forceinline__ void xcd_barrier(const XcdBarrier& b) {
    asm volatile("s_waitcnt vmcnt(0)" ::: "memory");
    __syncthreads();
    if (threadIdx.x == 0) {
        unsigned* bar = b.bar;
        __builtin_amdgcn_s_waitcnt(0);
        unsigned nloc = b.st[0], nx = b.st[1];
        if (nloc == 0u) { xcd_barrier_complete(bar, b.x, nloc, nx); b.st[0] = nloc; b.st[1] = nx; }
        const unsigned old = xb_add(&bar[XB_XSUB(b.x)], 1u);
        const unsigned gen = old / nloc;
        if (old + 1u == (gen + 1u) * nloc) {
            __builtin_amdgcn_fence(__ATOMIC_RELEASE, "agent");
            asm volatile("s_waitcnt vmcnt(0)" ::: "memory");
            const unsigned og = xb_add(&bar[XB_TOP], 1u);
            const unsigned tg = og / nx;
            if (og + 1u == (tg + 1u) * nx) xb_add(&bar[XB_TOPGEN], 1u);
            else XB_SPIN(xb_ld(&bar[XB_TOPGEN]) == tg, bar);
            __builtin_amdgcn_fence(__ATOMIC_ACQUIRE, "agent");
            xb_add(&bar[XB_XGEN(b.x)], 1u);
            asm volatile("s_waitcnt vmcnt(0)" ::: "memory");
        } else {
            XB_SPIN(xb_ld(&bar[XB_XGEN(b.x)]) == gen, bar);
            __builtin_amdgcn_fence(__ATOMIC_ACQUIRE, "agent");
            asm volatile("s_waitcnt vmcnt(0)" ::: "memory");
        }
    }
    __syncthreads();
}

__device__ __forceinline__ void setup_ada_unit(const Params& p, int a, float* lds) {
    const int tid = ltid();
    const int l = a / 48, jb = (a % 48) * 128;
    float* scond = lds;
    float* part = lds + 3072;
    for (int i = tid; i < 3072; i += NTHR) {
        int n = i >> 10, k = i & 1023;
        float c = (n == 0) ? p.in[I_CCTX][k] : p.in[I_C][(n - 1) * 1024 + k];
        scond[i] = siluf_(c);
    }
    __syncthreads();
    const int lane = tid & 63, kg = tid >> 6;
    const float* w = p.in[I_ADAW] + (size_t)l * 1024 * 6144 + jb + lane * 2;
    float a0x = 0.f, a0y = 0.f, a1x = 0.f, a1y = 0.f, a2x = 0.f, a2y = 0.f;
#pragma unroll 1
    for (int k0 = 0; k0 < 128; k0 += 32) {
        float2 wv[32];
#pragma unroll
        for (int kk = 0; kk < 32; ++kk) { const f32x2 t_ = __builtin_nontemporal_load((const f32x2*)(w + (size_t)(kg * 128 + k0 + kk) * 6144)); wv[kk] = make_float2(t_[0], t_[1]); }
#pragma unroll
        for (int kk = 0; kk < 32; ++kk) {
            const int k = kg * 128 + k0 + kk;
            const float s0 = scond[k], s1 = scond[1024 + k], s2 = scond[2048 + k];
            a0x += s0 * wv[kk].x; a0y += s0 * wv[kk].y; a1x += s1 * wv[kk].x; a1y += s1 * wv[kk].y; a2x += s2 * wv[kk].x; a2y += s2 * wv[kk].y;
        }
    }
    float* pp = part + kg * 384 + lane * 2;
    pp[0] = a0x; pp[1] = a0y; pp[128] = a1x; pp[129] = a1y; pp[256] = a2x; pp[257] = a2y;
    __syncthreads();
    if (tid < 384) {
        const int n = tid >> 7, c2 = tid & 127;
        float sm = p.in[I_ADAB][l * 6144 + jb + c2];
#pragma unroll
        for (int g = 0; g < 8; ++g) sm += part[g * 384 + n * 128 + c2];
        float* mods = (float*)(p.ws + OFF_MODS);
        mods[(l * 3 + n) * 6144 + jb + c2] = sm;
    }
    __syncthreads();
}

__device__ __forceinline__ void setup_transpose_unit(const Params& p, int u, float* lds) {
    const int tid = ltid();
    const float* src; bf16_t* dst; int N, tiles_n, t, dstride = 1024;
    const bool gates = u >= 1424;
    const int i = u * 4;
    if (gates)         { t = 0; N = 64; tiles_n = 1; dstride = 64; src = p.in[I_RGWA]; dst = (bf16_t*)(p.ws + OFF_RGW) + (size_t)(i - 5696) * 4096; }
    else if (i < 1024) { int m = i / 512;          t = i % 512;          N = 2048; tiles_n = 32; src = p.in[I_RGWIN] + (size_t)m * 1024 * 2048;  dst = (bf16_t*)(p.ws + OFF_RGWIN) + (size_t)m * 2048 * 1024; }
    else if (i < 1536) { int m = (i - 1024) / 256; t = (i - 1024) % 256; N = 1024; tiles_n = 16; src = p.in[I_RGWOUT] + (size_t)m * 1024 * 1024; dst = (bf16_t*)(p.ws + OFF_RGWOUT) + (size_t)m * 1024 * 1024; }
    else if (i < 3136) { int m = (i - 1536) / 800; t = (i - 1536) % 800; N = 3104; tiles_n = 50; src = p.in[I_GLWIN] + (size_t)m * 1024 * 3104;  dst = (bf16_t*)(p.ws + OFF_GLWIN) + (size_t)m * 3200 * 1024; }
    else if (i < 3648) { int m = (i - 3136) / 256; t = (i - 3136) % 256; N = 1024; tiles_n = 16; src = p.in[I_GLWOUT] + (size_t)m * 1024 * 1024; dst = (bf16_t*)(p.ws + OFF_GLWOUT) + (size_t)m * 1024 * 1024; }
    else               { int m = (i - 3648) / 512; t = (i - 3648) % 512; N = 2048; tiles_n = 32; src = p.in[I_PWQ] + (size_t)m * 1024 * 2048;    dst = (bf16_t*)(p.ws + OFF_PWQ) + (size_t)m * 2048 * 1024; }
    const int mg = (i - 5696) >> 1;
    {
        const int k = tid >> 3, nc = (tid & 7) * 8;
        f32x4 v0[4], v1[4];
#pragma unroll
        for (int q = 0; q < 4; ++q) {
            const int tq = t + q, kt = tq / tiles_n, nt = tq % tiles_n;
            const float* sq = gates ? p.in[(q & 1) ? I_RGWI : I_RGWA] + (size_t)(mg + (q >> 1)) * 4096 : src;
            const int n = nt * 64 + nc;
            f32x4 z = {0.f, 0.f, 0.f, 0.f};
            v0[q] = z; v1[q] = z;
            if (n < N) {
                const f32x4* s4 = (const f32x4*)(sq + (size_t)((gates ? 0 : kt) * 64 + k) * N + n);
                v0[q] = __builtin_nontemporal_load(s4); v1[q] = __builtin_nontemporal_load(s4 + 1);
            }
        }
#pragma unroll
        for (int q = 0; q < 4; ++q) {
            float* tp = lds + q * 4160 + k * 65 + nc;
#pragma unroll
            for (int j = 0; j < 4; ++j) { tp[j] = v0[q][j]; tp[4 + j] = v1[q][j]; }
        }
    }
    __syncthreads();
    {
        const int n = tid >> 3, kc = (tid & 7) * 8;
#pragma unroll
        for (int q = 0; q < 4; ++q) {
            const int tq = t + q, kt = gates ? 0 : tq / tiles_n, nt = gates ? 0 : tq % tiles_n;
            bf16_t* dq = gates ? dst + (size_t)q * 4096 : dst;
            const float* tile = lds + q * 4160;
            float x[8];
#pragma unroll
            for (int j = 0; j < 8; ++j) x[j] = tile[(kc + j) * 65 + n];
            uint4 o; o.x = pack2(x[0], x[1]); o.y = pack2(x[2], x[3]); o.z = pack2(x[4], x[5]); o.w = pack2(x[6], x[7]);
            *(uint4*)(dq + (size_t)(nt * 64 + n) * dstride + kt * 64 + kc) = o;
        }
    }
    __syncthreads();
}

__device__ __forceinline__ void setup_convert_unit(const Params& p, int i) {
    const int tid = ltid();
    if (i < 256) {
        int side = i >> 7, ii = i & 127;
        size_t e = (size_t)ii * 4096;
        int l = (int)(e / 131072); size_t rest = e % 131072;
        const float* src = p.in[side ? I_PK2 : I_PK1] + e;
        bf16_t* dst = (bf16_t*)(p.ws + OFF_PK) + (size_t)l * 262144 + (size_t)side * 131072 + rest;
        const float4* s4 = (const float4*)(src + tid * 8);
        float4 v0 = s4[0], v1 = s4[1];
        uint4 o; o.x = pack2(v0.x, v0.y); o.y = pack2(v0.z, v0.w); o.z = pack2(v1.x, v1.y); o.w = pack2(v1.z, v1.w);
        *(uint4*)(dst + tid * 8) = o;
        return;
    }
    i -= 256;
    if (gridDim.x == 256 && (i & 1023) >= 256) return;
    const int tab = i >> 10;
    const int lane = tid & 63, w = tid >> 6;
    const float* src = p.in[tab ? I_PV : I_PU];
    unsigned char* dst = p.ws + (tab ? OFF_PV : OFF_PU);
    float* sc = (float*)(p.ws + (tab ? OFF_SV : OFF_SU));
    const size_t rowbase = (size_t)(i & 1023) * 64 + w * 8;
    f32x4 v[8][4];
#pragma unroll
    for (int rr = 0; rr < 8; ++rr) {
        const float* rp = src + (rowbase + rr) * 1024;
#pragma unroll
        for (int q = 0; q < 4; ++q) v[rr][q] = __builtin_nontemporal_load((const f32x4*)(rp + q * 256 + lane * 4));
    }
#pragma unroll
    for (int rr = 0; rr < 8; ++rr) {
        float am = 0.f;
#pragma unroll
        for (int q = 0; q < 4; ++q) am = fmaxf(am, fmaxf(fmaxf(fabsf(v[rr][q][0]), fabsf(v[rr][q][1])), fmaxf(fabsf(v[rr][q][2]), fabsf(v[rr][q][3]))));
#pragma unroll
        for (int o = 32; o >= 1; o >>= 1) am = fmaxf(am, __shfl_xor(am, o));
        const float scale = am > 0.f ? am * (1.0f / 448.0f) : 1.0f;
        const float inv = 1.0f / scale;
        unsigned o4[4];
#pragma unroll
        for (int q = 0; q < 4; ++q) {
            int pk = 0;
            pk = __builtin_amdgcn_cvt_pk_fp8_f32(v[rr][q][0] * inv, v[rr][q][1] * inv, pk, false);
            pk = __builtin_amdgcn_cvt_pk_fp8_f32(v[rr][q][2] * inv, v[rr][q][3] * inv, pk, true);
            o4[q] = (unsigned)pk;
        }
        const size_t row = rowbase + rr;
        { const u32x4 ov = {o4[0], o4[1], o4[2], o4[3]}; __builtin_nontemporal_store(ov, (u32x4*)(dst + row * 1024 + lane * 16)); }
        if (lane == 0) sc[row] = scale;
    }
}

__device__ __forceinline__ void setup_xinit_unit(const Params& p, int i) {
    const int tid = ltid();
    const int row = i * 4 + (tid >> 7), d0 = (tid & 127) * 8;
    float* X = (float*)(p.ws + OFF_X);
    float v[8];
    if (row < 4096) {
        const f32x4* s4 = (const f32x4*)(p.in[I_XP] + (size_t)row * 1024 + d0);
        const f32x4 a_ = __builtin_nontemporal_load(s4), b_ = __builtin_nontemporal_load(s4 + 1);
        const float4 a = make_float4(a_[0], a_[1], a_[2], a_[3]), b = make_float4(b_[0], b_[1], b_[2], b_[3]);
        v[0] = a.x; v[1] = a.y; v[2] = a.z; v[3] = a.w; v[4] = b.x; v[5] = b.y; v[6] = b.z; v[7] = b.w;
    } else {
        const f32x4* s4 = (const f32x4*)(p.in[I_XS] + (size_t)(row - 4096) * 1024 + d0);
        const f32x4 a_ = __builtin_nontemporal_load(s4), b_ = __builtin_nontemporal_load(s4 + 1);
        const float4 a = make_float4(a_[0], a_[1], a_[2], a_[3]), b = make_float4(b_[0], b_[1], b_[2], b_[3]);
        v[0] = a.x; v[1] = a.y; v[2] = a.z; v[3] = a.w; v[4] = b.x; v[5] = b.y; v[6] = b.z; v[7] = b.w;
        int n = (row - 4096) & 1023;
        float r = (float)(n >> 6), cc = (float)(n & 63);
#pragma unroll
        for (int j = 0; j < 8; ++j) {
            int d = d0 + j; int q = d >> 8, fi = d & 255;
            float freq = exp2f(-13.287712379549449f * ((float)fi * (1.0f / 256.0f)));
            float ang = ((q < 2) ? r : cc) * freq;
            v[j] += (q & 1) ? __cosf(ang) : __sinf(ang);
        }
    }
    float4* o4 = (float4*)(X + (size_t)row * 1024 + d0);
    o4[0] = make_float4(v[0], v[1], v[2], v[3]); o4[1] = make_float4(v[4], v[5], v[6], v[7]);
}

__device__ __forceinline__ void phase_setup(const Params& p, float* lds) {
    constexpr int NA = 192, NB = (5696 + 128) / 4, NC = 256 + 2048, ND = 1536;
    constexpr int total = NA + NB + NC + ND;
    for (int u = blockIdx.x; u < total; u += gridDim.x) {
        if (u < NA) setup_ada_unit(p, u, lds);
        else if (u < NA + NB) setup_transpose_unit(p, u - NA, lds);
        else if (u < NA + NB + NC) setup_convert_unit(p, u - NA - NB);
        else setup_xinit_unit(p, u - NA - NB - NC);
    }
}

__device__ __forceinline__ void premod_store(const float* x  , float ss, const float* g, const float* mrow, int shift_i, int scale_i,
                                             bf16_t* Hrow, int lane) {
    const float rs = rsqrtf(ss * (1.0f / 1024.0f) + EPSV);
    unsigned pk[8];
#pragma unroll
    for (int hf = 0; hf < 2; ++hf) {
        const int d0 = hf * 512 + lane * 8;
        float4 g0 = *(const float4*)(g + d0), g1 = *(const float4*)(g + d0 + 4);
        float4 s0 = *(const float4*)(mrow + shift_i * 1024 + d0), s1 = *(const float4*)(mrow + shift_i * 1024 + d0 + 4);
        float4 c0 = *(const float4*)(mrow + scale_i * 1024 + d0), c1 = *(const float4*)(mrow + scale_i * 1024 + d0 + 4);
        float gg[8] = {g0.x, g0.y, g0.z, g0.w, g1.x, g1.y, g1.z, g1.w};
        float sh[8] = {s0.x, s0.y, s0.z, s0.w, s1.x, s1.y, s1.z, s1.w};
        float sc[8] = {c0.x, c0.y, c0.z, c0.w, c1.x, c1.y, c1.z, c1.w};
        float o[8];
#pragma unroll
        for (int j = 0; j < 8; ++j) o[j] = (x[hf * 8 + j] * rs * gg[j]) * (1.0f + sc[j]) + sh[j];
#pragma unroll
        for (int j = 0; j < 4; ++j) pk[hf * 4 + j] = pack2(o[2 * j], o[2 * j + 1]);
    }
    *(uint4*)(Hrow + lane * 8) = make_uint4(pk[0], pk[1], pk[2], pk[3]);
    *(uint4*)(Hrow + 512 + lane * 8) = make_uint4(pk[4], pk[5], pk[6], pk[7]);
}

__device__ __forceinline__ void phase_norm(const Params& p, int l, int which  ) {
    const int lane = ltid() & 63, w = ltid() >> 6;
    const float* X = (const float*)(p.ws + OFF_X);
    bf16_t* H = (bf16_t*)(p.ws + OFF_H);
    const float* mods = (const float*)(p.ws + OFF_MODS) + (size_t)l * 3 * 6144;
    const float* g = p.in[which ? I_N2G : I_N1G] + l * 1024;
    for (int row = blockIdx.x * 8 + w; row < TTOK; row += gridDim.x * 8) {
        const float* xr = X + (size_t)row * 1024;
        float x[16];
        float4 a = *(const float4*)(xr + lane * 8), b = *(const float4*)(xr + lane * 8 + 4);
        float4 c = *(const float4*)(xr + 512 + lane * 8), d = *(const float4*)(xr + 512 + lane * 8 + 4);
        x[0] = a.x; x[1] = a.y; x[2] = a.z; x[3] = a.w; x[4] = b.x; x[5] = b.y; x[6] = b.z; x[7] = b.w;
        x[8] = c.x; x[9] = c.y; x[10] = c.z; x[11] = c.w; x[12] = d.x; x[13] = d.y; x[14] = d.z; x[15] = d.w;
        float ss = 0.f;
#pragma unroll
        for (int j = 0; j < 16; ++j) ss += x[j] * x[j];
        ss = wave_sum(ss);
        premod_store(x, ss, g, mods + cond_of(row) * 6144, which ? 3 : 0, which ? 4 : 1, H + (size_t)row * 1024, lane);
    }
}

#define GT_STRIDE 72
#define GT_BUF (2 * 128 * GT_STRIDE)

#define GLOAD(RR, k0) { RR##0 = *(const u32x4*)(ap0 + (k0)); RR##1 = *(const u32x4*)(ap1 + (k0)); RR##2 = *(const u32x4*)(bp0 + (k0)); RR##3 = *(const u32x4*)(bp1 + (k0)); }
#define GWRITE(RR, buf) { bf16_t* dA = lds + (buf) * GT_BUF; bf16_t* dB = dA + 128 * GT_STRIDE; \
        *(u32x4*)(dA + r0 * GT_STRIDE + kc) = RR##0; *(u32x4*)(dA + (r0 + 64) * GT_STRIDE + kc) = RR##1; \
        *(u32x4*)(dB + r0 * GT_STRIDE + kc) = RR##2; *(u32x4*)(dB + (r0 + 64) * GT_STRIDE + kc) = RR##3; }
#define GCOMPUTE(buf) { const bf16_t* sA = lds + (buf) * GT_BUF; const bf16_t* sB = sA + 128 * GT_STRIDE; \
        _Pragma("unroll") for (int kk = 0; kk < 4; ++kk) { \
            bf16x8 a = *(const bf16x8*)(sA + arow * GT_STRIDE + kk * 16 + koff); \
            bf16x8 b0 = *(const bf16x8*)(sB + (wn * 64 + (lane & 31)) * GT_STRIDE + kk * 16 + koff); \
            bf16x8 b1 = *(const bf16x8*)(sB + (wn * 64 + 32 + (lane & 31)) * GT_STRIDE + kk * 16 + koff); \
            acc[0] = __builtin_amdgcn_mfma_f32_32x32x16_bf16(a, b0, acc[0], 0, 0, 0); \
            acc[1] = __builtin_amdgcn_mfma_f32_32x32x16_bf16(a, b1, acc[1], 0, 0, 0); } }
#define GSTEP_L(ks, RL, RW) { GLOAD(RL, ((ks) + 3) * 64); GCOMPUTE((ks) & 1); GWRITE(RW, ((ks) + 1) & 1); __syncthreads(); }
#define GSTEP_N(ks, RW)     { GCOMPUTE((ks) & 1); GWRITE(RW, ((ks) + 1) & 1); __syncthreads(); }

struct GemmRegs { u32x4 a0, a1, a2, a3, b0, b1, b2, b3, c0, c1, c2, c3; };
#define Ra0 R.a0
#define Ra1 R.a1
#define Ra2 R.a2
#define Ra3 R.a3
#define Rb0 R.b0
#define Rb1 R.b1
#define Rb2 R.b2
#define Rb3 R.b3
#define Rc0 R.c0
#define Rc1 R.c1
#define Rc2 R.c2
#define Rc3 R.c3
__device__ __forceinline__ void gemm_prefetch(const bf16_t* __restrict__ A, const bf16_t* __restrict__ Bt, int m0, int n0, GemmRegs& R) {
    const int tid = ltid();
    const int r0 = tid >> 3, kc = (tid & 7) * 8;
    const bf16_t* ap0 = A + (size_t)(m0 + r0) * 1024 + kc;
    const bf16_t* ap1 = A + (size_t)(m0 + r0 + 64) * 1024 + kc;
    const bf16_t* bp0 = Bt + (size_t)(n0 + r0) * 1024 + kc;
    const bf16_t* bp1 = Bt + (size_t)(n0 + r0 + 64) * 1024 + kc;
    GLOAD(Ra, 0); GLOAD(Rb, 64); GLOAD(Rc, 128);
}
__device__ __forceinline__ void gemm_mainloop(const bf16_t* __restrict__ A, const bf16_t* __restrict__ Bt, int m0, int n0,
                                              bf16_t* lds, f32x16 (&acc)[2], GemmRegs& R) {
    const int tid = ltid(), lane = tid & 63, w = tid >> 6;
    const int wm = w >> 1, wn = w & 1;
#pragma unroll
    for (int i = 0; i < 16; ++i) { acc[0][i] = 0.f; acc[1][i] = 0.f; }
    const int r0 = tid >> 3, kc = (tid & 7) * 8;
    const bf16_t* ap0 = A + (size_t)(m0 + r0) * 1024 + kc;
    const bf16_t* ap1 = A + (size_t)(m0 + r0 + 64) * 1024 + kc;
    const bf16_t* bp0 = Bt + (size_t)(n0 + r0) * 1024 + kc;
    const bf16_t* bp1 = Bt + (size_t)(n0 + r0 + 64) * 1024 + kc;
    GWRITE(Ra, 0);
    __syncthreads();
    const int arow = wm * 32 + (lane & 31), koff = (lane >> 5) * 8;
    GSTEP_L(0, Ra, Rb)  GSTEP_L(1, Rb, Rc)  GSTEP_L(2, Rc, Ra)
    GSTEP_L(3, Ra, Rb)  GSTEP_L(4, Rb, Rc)  GSTEP_L(5, Rc, Ra)
    GSTEP_L(6, Ra, Rb)  GSTEP_L(7, Rb, Rc)  GSTEP_L(8, Rc, Ra)
    GSTEP_L(9, Ra, Rb)  GSTEP_L(10, Rb, Rc) GSTEP_L(11, Rc, Ra)
    GSTEP_L(12, Ra, Rb) GSTEP_N(13, Rc)     GSTEP_N(14, Ra)
    { GCOMPUTE(1); __syncthreads(); }
}

#define G2_BUF (384 * GT_STRIDE)
struct Gemm2Regs { u32x4 a0, a1, a2, a3, a4, a5, b0, b1, b2, b3, b4, b5, c0, c1, c2, c3, c4, c5; };
#define G2LOAD(RR, k0) { R2.RR##0 = *(const u32x4*)(ap0 + (k0)); R2.RR##1 = *(const u32x4*)(ap0 + (size_t)64 * 1024 + (k0)); \
        R2.RR##2 = *(const u32x4*)(ap0 + (size_t)128 * 1024 + (k0)); R2.RR##3 = *(const u32x4*)(ap0 + (size_t)192 * 1024 + (k0)); \
        R2.RR##4 = *(const u32x4*)(bp0 + (k0)); R2.RR##5 = *(const u32x4*)(bp0 + (size_t)64 * 1024 + (k0)); }
#define G2WRITE(RR, buf) { bf16_t* dA = lds + (buf) * G2_BUF; bf16_t* dB = dA + 256 * GT_STRIDE; \
        *(u32x4*)(dA + r0 * GT_STRIDE + kc) = R2.RR##0; *(u32x4*)(dA + (r0 + 64) * GT_STRIDE + kc) = R2.RR##1; \
        *(u32x4*)(dA + (r0 + 128) * GT_STRIDE + kc) = R2.RR##2; *(u32x4*)(dA + (r0 + 192) * GT_STRIDE + kc) = R2.RR##3; \
        *(u32x4*)(dB + r0 * GT_STRIDE + kc) = R2.RR##4; *(u32x4*)(dB + (r0 + 64) * GT_STRIDE + kc) = R2.RR##5; }
#define G2COMPUTE(buf) { const bf16_t* sA = lds + (buf) * G2_BUF; const bf16_t* sB = sA + 256 * GT_STRIDE; \
        _Pragma("unroll") for (int kk = 0; kk < 4; ++kk) { \
            bf16x8 a0 = *(const bf16x8*)(sA + arow * GT_STRIDE + kk * 16 + koff); \
            bf16x8 a1 = *(const bf16x8*)(sA + (arow + 32) * GT_STRIDE + kk * 16 + koff); \
            bf16x8 b0 = *(const bf16x8*)(sB + brow * GT_STRIDE + kk * 16 + koff); \
            bf16x8 b1 = *(const bf16x8*)(sB + (brow + 32) * GT_STRIDE + kk * 16 + koff); \
            acc[0] = __builtin_amdgcn_mfma_f32_32x32x16_bf16(a0, b0, acc[0], 0, 0, 0); \
            acc[1] = __builtin_amdgcn_mfma_f32_32x32x16_bf16(a0, b1, acc[1], 0, 0, 0); \
            acc[2] = __builtin_amdgcn_mfma_f32_32x32x16_bf16(a1, b0, acc[2], 0, 0, 0); \
            acc[3] = __builtin_amdgcn_mfma_f32_32x32x16_bf16(a1, b1, acc[3], 0, 0, 0); } }
#define G2STEP_L(ks, RL, RW) { G2LOAD(RL, ((ks) + 3) * 64); G2COMPUTE((ks) & 1); G2WRITE(RW, ((ks) + 1) & 1); __syncthreads(); }
#define G2STEP_N(ks, RW)     { G2COMPUTE((ks) & 1); G2WRITE(RW, ((ks) + 1) & 1); __syncthreads(); }
__device__ __forceinline__ void gemm2_prefetch(const bf16_t* __restrict__ A, const bf16_t* __restrict__ Bt, int m0, int n0, Gemm2Regs& R2) {
    const int tid = ltid();
    const int r0 = tid >> 3, kc = (tid & 7) * 8;
    const bf16_t* ap0 = A + (size_t)(m0 + r0) * 1024 + kc;
    const bf16_t* bp0 = Bt + (size_t)(n0 + r0) * 1024 + kc;
    G2LOAD(a, 0); G2LOAD(b, 64); G2LOAD(c, 128);
}
__device__ __forceinline__ void gemm2_mainloop(const bf16_t* __restrict__ A, const bf16_t* __restrict__ Bt, int m0, int n0,
                                               bf16_t* lds, f32x16 (&acc)[4], Gemm2Regs& R2) {
    const int tid = ltid(), lane = tid & 63, w = tid >> 6;
    const int wm = w >> 1, wn = w & 1;
#pragma unroll
    for (int i = 0; i < 16; ++i) { acc[0][i] = 0.f; acc[1][i] = 0.f; acc[2][i] = 0.f; acc[3][i] = 0.f; }
    const int r0 = tid >> 3, kc = (tid & 7) * 8;
    const bf16_t* ap0 = A + (size_t)(m0 + r0) * 1024 + kc;
    const bf16_t* bp0 = Bt + (size_t)(n0 + r0) * 1024 + kc;
    G2WRITE(a, 0);
    __syncthreads();
    const int arow = wm * 64 + (lane & 31), brow = wn * 64 + (lane & 31), koff = (lane >> 5) * 8;
    G2STEP_L(0, a, b)  G2STEP_L(1, b, c)  G2STEP_L(2, c, a)
    G2STEP_L(3, a, b)  G2STEP_L(4, b, c)  G2STEP_L(5, c, a)
    G2STEP_L(6, a, b)  G2STEP_L(7, b, c)  G2STEP_L(8, c, a)
    G2STEP_L(9, a, b)  G2STEP_L(10, b, c) G2STEP_L(11, c, a)
    G2STEP_L(12, a, b) G2STEP_N(13, c)    G2STEP_N(14, a)
    { G2COMPUTE(1); __syncthreads(); }
}

#define ACC_ROW(wm, lane, r) ((wm) * 32 + ((r) & 3) + 8 * ((r) >> 2) + 4 * ((lane) >> 5))
#define ACC_COL(wn, lane, nt) ((wn) * 64 + (nt) * 32 + ((lane) & 31))

enum { EPI_RGIN = 0, EPI_GLAIN = 1, EPI_OUT = 2 };

__device__ __forceinline__ void phase_gemm(const Params& p, int l, int kind, float* ldsf, bool dry = false) {
    bf16_t* lds = (bf16_t*)ldsf;
    const int lane = ltid() & 63, w = ltid() >> 6, wm = w >> 1, wn = w & 1;
    const int jl = l >> 1;
    const bf16_t* A; const bf16_t* Bt; int ntn, N;
    float* PB = (float*)(p.ws + OFF_PB);
    float* X = (float*)(p.ws + OFF_X);
    if (kind == EPI_RGIN)       { A = (const bf16_t*)(p.ws + OFF_H); Bt = (const bf16_t*)(p.ws + OFF_RGWIN) + (size_t)jl * 2048 * 1024; ntn = 16; N = 2048; }
    else if (kind == EPI_GLAIN) { A = (const bf16_t*)(p.ws + OFF_H); Bt = (const bf16_t*)(p.ws + OFF_GLWIN) + (size_t)jl * 3200 * 1024; ntn = 25; N = 3104; }
    else { A = (const bf16_t*)(p.ws + OFF_Y); Bt = (l & 1) ? (const bf16_t*)(p.ws + OFF_GLWOUT) + (size_t)jl * 1024 * 1024 : (const bf16_t*)(p.ws + OFF_RGWOUT) + (size_t)jl * 1024 * 1024; ntn = 8; N = 1024; }
    const float* mods = (const float*)(p.ws + OFF_MODS) + (size_t)l * 3 * 6144;
    if (kind != EPI_RGIN) {
        const int ntn2 = (kind == EPI_GLAIN) ? 21 : ntn;
        const int ntiles2 = 24 * ntn2;
        Gemm2Regs R2;
        if ((int)blockIdx.x < ntiles2) gemm2_prefetch(A, Bt, ((int)blockIdx.x % 24) * 256, ((int)blockIdx.x / 24) * 128, R2);
#pragma unroll 1
        for (int t = blockIdx.x; t < ntiles2; t += gridDim.x) {
            const int m0 = (t % 24) * 256, n0 = (t / 24) * 128;
            f32x16 acc[4];
            gemm2_mainloop(A, Bt, m0, n0, lds, acc, R2);
            { const int tn = t + gridDim.x; if (tn < ntiles2) gemm2_prefetch(A, Bt, (tn % 24) * 256, (tn / 24) * 128, R2); }
            const int cnd = cond_of(m0);
#pragma unroll
            for (int q = 0; q < 4; ++q) {
                const int col = n0 + wn * 64 + (q & 1) * 32 + (lane & 31);
                const float gate = (kind == EPI_OUT) ? mods[cnd * 6144 + 2 * 1024 + col] : 0.f;
#pragma unroll
                for (int r = 0; r < 16; ++r) {
                    const int row = m0 + (w >> 1) * 64 + (q >> 1) * 32 + (r & 3) + 8 * (r >> 2) + 4 * (lane >> 5);
                    float v = acc[q][r];
                    if (kind == EPI_GLAIN) {
                        if (col < 512) v *= 0.08838834764831845f;
                        if (col < N) PB[(size_t)row * 3104 + col] = v;
                    } else {
                        float* Xo = dry ? PB : X;
                        Xo[(size_t)row * 1024 + col] = X[(size_t)row * 1024 + col] + gate * v;
                    }
                }
            }
        }
        if (kind == EPI_OUT) return;
    }
    const int ntb = (kind == EPI_GLAIN) ? 21 : 0;
    const int ntiles = 48 * (ntn - ntb);
    GemmRegs R;
    if ((int)blockIdx.x < ntiles) gemm_prefetch(A, Bt, ((int)blockIdx.x % 48) * 128, (ntb + (int)blockIdx.x / 48) * 128, R);
#pragma unroll 1
    for (int t = blockIdx.x; t < ntiles; t += gridDim.x) {
        const int mt = t % 48, nt_ = ntb + t / 48;
        const int m0 = mt * 128, n0 = nt_ * 128;
        f32x16 acc[2];
        gemm_mainloop(A, Bt, m0, n0, lds, acc, R);
        { const int tn = t + gridDim.x; if (tn < ntiles) gemm_prefetch(A, Bt, (tn % 48) * 128, (ntb + tn / 48) * 128, R); }
#pragma unroll
        for (int nt = 0; nt < 2; ++nt) {
#pragma unroll
            for (int r = 0; r < 16; ++r) {
                const int row = m0 + ACC_ROW(wm, lane, r), col = n0 + ACC_COL(wn, lane, nt);
                float v = acc[nt][r];
                if (kind == EPI_RGIN) {
                    if (col < 1024) v = gelu_tanh(v);
                    PB[(size_t)row * 2048 + col] = v;
                } else if (kind == EPI_GLAIN) {
                    if (col < 512) v *= 0.08838834764831845f;
                    if (col < N) PB[(size_t)row * 3104 + col] = v;
                } else {
                    const float gate = mods[cond_of(row) * 6144 + 2 * 1024 + col];
                    float* Xo = dry ? PB : X;
                    Xo[(size_t)row * 1024 + col] = X[(size_t)row * 1024 + col] + gate * v;
                }
            }
        }
    }
}

__device__ __forceinline__ void phase_peerq(const Params& p, int l, float* ldsf) {
    bf16_t* lds = (bf16_t*)ldsf;
    const int tid = ltid(), lane = tid & 63, w = tid >> 6, wm = w >> 1, wn = w & 1;
    const bf16_t* A = (const bf16_t*)(p.ws + OFF_H);
    const bf16_t* Bt = (const bf16_t*)(p.ws + OFF_PWQ) + (size_t)l * 2048 * 1024;
    const bf16_t* PK = (const bf16_t*)(p.ws + OFF_PK) + (size_t)l * 262144;
    float* TK = (float*)(p.ws + OFF_TK);
    bf16_t* Qs = lds;
    float* Ss = ldsf + (128 * 136 * 2) / 4;
    GemmRegs R;
    if ((int)blockIdx.x < 768) gemm_prefetch(A, Bt, ((int)blockIdx.x / 16) * 128, ((int)blockIdx.x % 16) * 128, R);
#pragma unroll 1
    for (int t = blockIdx.x; t < 48 * 16; t += gridDim.x) {
        const int mt = t / 16, nt_ = t % 16;
        const int m0 = mt * 128, n0 = nt_ * 128;
        const int h = nt_ >> 1, side = nt_ & 1;
        f32x16 acc[2];
        gemm_mainloop(A, Bt, m0, n0, lds, acc, R);
        { const int tn = t + gridDim.x; if (tn < 768) gemm_prefetch(A, Bt, (tn / 16) * 128, (tn % 16) * 128, R); }
#pragma unroll
        for (int nt = 0; nt < 2; ++nt)
#pragma unroll
            for (int r = 0; r < 16; ++r)
                Qs[ACC_ROW(wm, lane, r) * 136 + ACC_COL(wn, lane, nt)] = (bf16_t)f2bf(acc[nt][r]);
        __syncthreads();
        const bf16_t* kp = PK + (size_t)(side * 8 + h) * 16384;
#pragma unroll
        for (int i = 0; i < 16; ++i) { acc[0][i] = 0.f; acc[1][i] = 0.f; }
#pragma unroll
        for (int kk = 0; kk < 8; ++kk) {
            bf16x8 a = *(const bf16x8*)(Qs + (wm * 32 + (lane & 31)) * 136 + kk * 16 + (lane >> 5) * 8);
            bf16x8 b0 = *(const bf16x8*)(kp + (wn * 64 + (lane & 31)) * 128 + kk * 16 + (lane >> 5) * 8);
            bf16x8 b1 = *(const bf16x8*)(kp + (wn * 64 + 32 + (lane & 31)) * 128 + kk * 16 + (lane >> 5) * 8);
            acc[0] = __builtin_amdgcn_mfma_f32_32x32x16_bf16(a, b0, acc[0], 0, 0, 0);
            acc[1] = __builtin_amdgcn_mfma_f32_32x32x16_bf16(a, b1, acc[1], 0, 0, 0);
        }
#pragma unroll
        for (int nt = 0; nt < 2; ++nt)
#pragma unroll
            for (int r = 0; r < 16; ++r)
                Ss[ACC_ROW(wm, lane, r) * 129 + ACC_COL(wn, lane, nt)] = acc[nt][r];
        __syncthreads();
        {
            const int row = tid & 127, part = tid >> 7;
            float v[16];
#pragma unroll
            for (int j = 0; j < 16; ++j) v[j] = -3.0e38f;
            const float* sr = Ss + row * 129 + part * 32;
#pragma unroll 4
            for (int n = 0; n < 32; ++n) {
                float x = __uint_as_float((__float_as_uint(sr[n]) & 0xffffff80u) | (unsigned)(part * 32 + n));
#pragma unroll
                for (int j = 15; j >= 1; --j) v[j] = __builtin_amdgcn_fmed3f(x, v[j - 1], v[j]);
                v[0] = fmaxf(x, v[0]);
            }
            float* mg = ldsf;
#define TOPK_MERGE() { \
                _Pragma("unroll") for (int j = 0; j < 16; ++j) v[j] = fmaxf(v[j], o[15 - j]); \
                _Pragma("unroll") for (int dd = 8; dd >= 1; dd >>= 1) { \
                    _Pragma("unroll") for (int i = 0; i < 16; ++i) { if ((i & dd) == 0) { const float hi_ = fmaxf(v[i], v[i + dd]), lo_ = fminf(v[i], v[i + dd]); v[i] = hi_; v[i + dd] = lo_; } } } }
            __syncthreads();
            if (part & 1) {
#pragma unroll
                for (int j = 0; j < 16; ++j) mg[((part >> 1) * 128 + row) * 17 + j] = v[j];
            }
            __syncthreads();
            if (!(part & 1)) {
                float o[16];
#pragma unroll
                for (int j = 0; j < 16; ++j) o[j] = mg[((part >> 1) * 128 + row) * 17 + j];
                TOPK_MERGE()
            }
            __syncthreads();
            if (part == 2) {
#pragma unroll
                for (int j = 0; j < 16; ++j) mg[row * 17 + j] = v[j];
            }
            __syncthreads();
            if (part == 0) {
                float o[16];
#pragma unroll
                for (int j = 0; j < 16; ++j) o[j] = mg[row * 17 + j];
                TOPK_MERGE()
                float4* og = (float4*)(TK + ((size_t)(m0 + row) * 16 + h * 2 + side) * 16);
                og[0] = make_float4(v[0], v[1], v[2], v[3]); og[1] = make_float4(v[4], v[5], v[6], v[7]);
                og[2] = make_float4(v[8], v[9], v[10], v[11]); og[3] = make_float4(v[12], v[13], v[14], v[15]);
            }
        }
        __syncthreads();
    }
}

__device__ __forceinline__ void conv_row(int l, int gw, int st, int& tab, int& r) {
    const int rid = gw * 16 + st; tab = rid >> 14; r = (l + 1) * 16384 + (rid & 16383);
}
__device__ __forceinline__ void phase_peer_gather(const Params& p, int l, float* ldsf, bool dry = false) {
    const int tid = ltid(), lane = tid & 63, w = tid >> 6;
    int* eidL = (int*)ldsf;
    float* gateL = ldsf + 24 * 128;
    float* suL = ldsf + 48 * 128;
    float* wL = ldsf + 72 * 128 + w * 384;
    int* cntL = (int*)(ldsf + 96 * 128);
    int* baseL = cntL + 192 * 16;
    int* eidU = baseL + 24 * 16;
    float* gateU = (float*)(eidU + 24 * 128);
    const float* TK = (const float*)(p.ws + OFF_TK);
    float* X = (float*)(p.ws + OFF_X);
    bf16_t* H = (bf16_t*)(p.ws + OFF_H);
    float* Xw = dry ? (float*)(p.ws + OFF_PB) : X;
    bf16_t* Hw = dry ? (bf16_t*)(p.ws + OFF_PB + (size_t)TTOK * DM * 4) : H;
    float* Yw = dry ? (float*)(p.ws + OFF_PB) : p.out + OUT_Y;
    const unsigned char* PU = p.ws + OFF_PU + (size_t)l * 16384 * 1024;
    const unsigned char* PV = p.ws + OFF_PV + (size_t)l * 16384 * 1024;
    const float* SU = (const float*)(p.ws + OFF_SU) + l * 16384;
    const float* SV = (const float*)(p.ws + OFF_SV) + l * 16384;
    const float* mods = (const float*)(p.ws + OFF_MODS) + (size_t)l * 3 * 6144;
    for (int sg = blockIdx.x; sg < 256; sg += gridDim.x) {
        const int t0 = sg * 24;
        const bool defer = (l < 3) && (gridDim.x == 256) && !dry;
        f32x4 cv0, cv1, cv2, cv3;
        cv0 = cv1 = cv2 = cv3 = (f32x4){0.f, 0.f, 0.f, 0.f};
#define CONV_ISSUE(st_) { if (defer) { int tab_, r_; conv_row(l, (int)blockIdx.x * 8 + w, (st_), tab_, r_); \
            const float* src_ = p.in[tab_ ? I_PV : I_PU] + (size_t)r_ * 1024 + lane * 4; \
            cv0 = __builtin_nontemporal_load((const f32x4*)src_); cv1 = __builtin_nontemporal_load((const f32x4*)(src_ + 256)); \
            cv2 = __builtin_nontemporal_load((const f32x4*)(src_ + 512)); cv3 = __builtin_nontemporal_load((const f32x4*)(src_ + 768)); } }
#define CONV_Q(v_) ({ int pk_ = 0; pk_ = __builtin_amdgcn_cvt_pk_fp8_f32((v_)[0] * inv_, (v_)[1] * inv_, pk_, false); \
            pk_ = __builtin_amdgcn_cvt_pk_fp8_f32((v_)[2] * inv_, (v_)[3] * inv_, pk_, true); (unsigned)pk_; })
#define CONV_AM(v_) fmaxf(fmaxf(fabsf((v_)[0]), fabsf((v_)[1])), fmaxf(fabsf((v_)[2]), fabsf((v_)[3])))
#define CONV_FINISH(st_) { if (defer) { int tab_, r_; conv_row(l, (int)blockIdx.x * 8 + w, (st_), tab_, r_); \
            float am_ = fmaxf(fmaxf(CONV_AM(cv0), CONV_AM(cv1)), fmaxf(CONV_AM(cv2), CONV_AM(cv3))); \
            _Pragma("unroll") for (int o_ = 32; o_ >= 1; o_ >>= 1) am_ = fmaxf(am_, __shfl_xor(am_, o_)); \
            const float scale_ = am_ > 0.f ? am_ * (1.0f / 448.0f) : 1.0f; const float inv_ = 1.0f / scale_; \
            const u32x4 ov_ = {CONV_Q(cv0), CONV_Q(cv1), CONV_Q(cv2), CONV_Q(cv3)}; \
            __builtin_nontemporal_store(ov_, (u32x4*)(p.ws + (tab_ ? OFF_PV : OFF_PU) + (size_t)r_ * 1024 + lane * 16)); \
            if (lane == 0) ((float*)(p.ws + (tab_ ? OFF_SV : OFF_SU)))[r_] = scale_; } }
        f32x2 xf2[3][8];
#pragma unroll
        for (int tt = 0; tt < 3; ++tt) {
            const int tok = t0 + w + tt * 8;
#pragma unroll
            for (int q = 0; q < 4; ++q) {
                uint2 hv = *(const uint2*)(H + (size_t)tok * 1024 + q * 256 + lane * 4);
                xf2[tt][q * 2] = (f32x2){bflo(hv.x), bfhi(hv.x)}; xf2[tt][q * 2 + 1] = (f32x2){bflo(hv.y), bfhi(hv.y)};
            }
        }
        __syncthreads();
        const int ctl = tid >> 3, ch = tid & 7;
        if (tid < 192) {
            const float* tk = TK + ((size_t)(t0 + ctl) * 16 + ch * 2) * 16;
            float v1[16], v2[16];
#pragma unroll
            for (int j = 0; j < 4; ++j) {
                float4 a = *(const float4*)(tk + j * 4), b = *(const float4*)(tk + 16 + j * 4);
                v1[j * 4] = a.x; v1[j * 4 + 1] = a.y; v1[j * 4 + 2] = a.z; v1[j * 4 + 3] = a.w;
                v2[j * 4] = b.x; v2[j * 4 + 1] = b.y; v2[j * 4 + 2] = b.z; v2[j * 4 + 3] = b.w;
            }
            int* idxL = (int*)(gateU + 24 * 128) + tid * 32;
#pragma unroll
            for (int j = 0; j < 16; ++j) {
                idxL[j] = (int)(__float_as_uint(v1[j]) & 127u); idxL[16 + j] = (int)(__float_as_uint(v2[j]) & 127u);
                v1[j] = __uint_as_float(__float_as_uint(v1[j]) & 0xffffff80u);
                v2[j] = __uint_as_float(__float_as_uint(v2[j]) & 0xffffff80u);
            }
            float top[16];
#pragma unroll
            for (int j = 0; j < 16; ++j) top[j] = -3.0e38f;
#pragma unroll
            for (int a = 0; a < 16; ++a) {
#pragma unroll
                for (int b = 0; b < 16; ++b) {
                    if ((a + 1) * (b + 1) <= 16) {
                        float sm = v1[a] + v2[b];
                        float x = __uint_as_float((__float_as_uint(sm) & 0xffffff00u) | (unsigned)(a * 16 + b));
#pragma unroll
                        for (int j = 15; j >= 1; --j) top[j] = __builtin_amdgcn_fmed3f(x, top[j - 1], top[j]);
                        top[0] = fmaxf(x, top[0]);
                    }
                }
            }
            const float mx = __uint_as_float(__float_as_uint(top[0]) & 0xffffff00u);
            float gg[16]; float sum = 0.f;
#pragma unroll
            for (int j = 0; j < 16; ++j) {
                float sv = __uint_as_float(__float_as_uint(top[j]) & 0xffffff00u);
                gg[j] = __expf(sv - mx); sum += gg[j];
            }
            const float inv = 1.0f / sum;
            int* myc = cntL + tid * 16;
#pragma unroll
            for (int b = 0; b < 16; ++b) myc[b] = 0;
            int eu[16];
#pragma unroll
            for (int j = 0; j < 16; ++j) {
                const unsigned ab = __float_as_uint(top[j]) & 0xffu;
                const int e = idxL[ab >> 4] * 128 + idxL[16 + (ab & 15u)];
                const int b = e >> 10;
                const int r = myc[b]; myc[b] = r + 1;
                eu[j] = e | (r << 16);
            }
#pragma unroll
            for (int j = 0; j < 16; ++j) { eidU[ctl * 128 + ch * 16 + j] = eu[j]; }
#pragma unroll
            for (int j = 0; j < 16; ++j) gg[j] *= inv;
#pragma unroll
            for (int j = 0; j < 16; ++j) gateU[ctl * 128 + ch * 16 + j] = gg[j];
        }
        __syncthreads();
        if (tid < 384) {
            const int tl = tid >> 4, b = tid & 15;
            int run = 0;
#pragma unroll
            for (int hh = 0; hh < 8; ++hh) { int* c = cntL + (tl * 8 + hh) * 16 + b; const int v = *c; *c = run; run += v; }
            baseL[tl * 16 + b] = run;
        }
        __syncthreads();
        if (tid < 24) {
            int run = 0;
#pragma unroll
            for (int b = 0; b < 16; ++b) { const int v = baseL[tid * 16 + b]; baseL[tid * 16 + b] = run; run += v; }
        }
        __syncthreads();
        if (tid < 192) {
#pragma unroll 4
            for (int j = 0; j < 16; ++j) {
                const int pk = eidU[ctl * 128 + ch * 16 + j];
                const int e = pk & 0xffff, r = pk >> 16, b = e >> 10;
                const int pos = baseL[ctl * 16 + b] + cntL[tid * 16 + b] + r;
                eidL[ctl * 128 + pos] = e;
                gateL[ctl * 128 + pos] = gateU[ctl * 128 + ch * 16 + j] * SV[e];
                suL[ctl * 128 + pos] = SU[e];
            }
        }
        __syncthreads();
        int ecur[3][8];
#pragma unroll
        for (int tt = 0; tt < 3; ++tt)
#pragma unroll
            for (int j = 0; j < 8; ++j) ecur[tt][j] = __builtin_amdgcn_readfirstlane(eidL[(w + tt * 8) * 128 + j]);
#pragma unroll 1
        for (int bt = 0; bt < 16; ++bt) {
            u32x4 ua[3][8];
#pragma unroll
            for (int tt = 0; tt < 3; ++tt) {
#pragma unroll
                for (int j = 0; j < 8; ++j) ua[tt][j] = *(const u32x4*)(PU + (size_t)ecur[tt][j] * 1024 + lane * 16);
            }
            {
                const int bn = (bt + 1) & 15;
#pragma unroll
                for (int tt = 0; tt < 3; ++tt)
#pragma unroll
                    for (int j = 0; j < 8; ++j) ecur[tt][j] = __builtin_amdgcn_readfirstlane(eidL[(w + tt * 8) * 128 + bn * 8 + j]);
            }
#pragma unroll
            for (int tt = 0; tt < 3; ++tt) {
                const int tl = w + tt * 8;
                float pp[8];
#pragma unroll
                for (int j = 0; j < 8; ++j) {
                    f32x2 sv = {0.f, 0.f};
#pragma unroll
                    for (int q = 0; q < 4; ++q) {
                        f32x2 lo = __builtin_amdgcn_cvt_pk_f32_fp8((int)ua[tt][j][q], false);
                        f32x2 hi = __builtin_amdgcn_cvt_pk_f32_fp8((int)ua[tt][j][q], true);
                        sv = xf2[tt][q * 2] * lo + sv;
                        sv = xf2[tt][q * 2 + 1] * hi + sv;
                    }
                    pp[j] = sv[0] + sv[1];
                }
                float q4[4], q2[2], s1;
                {
                    const bool hi = (lane & 32) != 0;
#pragma unroll
                    for (int i = 0; i < 4; ++i) { float a = pp[2 * i], b = pp[2 * i + 1]; float send = hi ? a : b, keep = hi ? b : a; q4[i] = keep + __shfl_xor(send, 32); }
                }
                {
                    const bool hi = (lane & 16) != 0;
#pragma unroll
                    for (int i = 0; i < 2; ++i) { float a = q4[2 * i], b = q4[2 * i + 1]; float send = hi ? a : b, keep = hi ? b : a; q2[i] = keep + __shfl_xor(send, 16); }
                }
                {
                    const bool hi = (lane & 8) != 0;
                    float a = q2[0], b = q2[1]; float send = hi ? a : b, keep = hi ? b : a; s1 = keep + __shfl_xor(send, 8);
                }
                s1 += __shfl_xor(s1, 4); s1 += __shfl_xor(s1, 2); s1 += __shfl_xor(s1, 1);
                const int jj = ((lane >> 5) & 1) + 2 * ((lane >> 4) & 1) + 4 * ((lane >> 3) & 1);
                if ((lane & 7) == 0) wL[tt * 128 + bt * 8 + jj] = gateL[tl * 128 + bt * 8 + jj] * gelu_tanh(s1 * suL[tl * 128 + bt * 8 + jj]);
            }
        }
        f32x2 acc2[3][8];
#pragma unroll
        for (int tt = 0; tt < 3; ++tt)
#pragma unroll
            for (int j = 0; j < 8; ++j) acc2[tt][j] = (f32x2){0.f, 0.f};
        CONV_ISSUE(0)
#pragma unroll 1
        for (int bt = 0; bt < 16; ++bt) {
            u32x4 va[3][8];
#pragma unroll
            for (int tt = 0; tt < 3; ++tt) {
#pragma unroll
                for (int j = 0; j < 8; ++j) va[tt][j] = *(const u32x4*)(PV + (size_t)ecur[tt][j] * 1024 + lane * 16);
            }
            {
                const int bn = (bt + 1) & 15;
#pragma unroll
                for (int tt = 0; tt < 3; ++tt)
#pragma unroll
                    for (int j = 0; j < 8; ++j) ecur[tt][j] = __builtin_amdgcn_readfirstlane(eidL[(w + tt * 8) * 128 + bn * 8 + j]);
            }
#pragma unroll
            for (int tt = 0; tt < 3; ++tt) {
#pragma unroll
                for (int j = 0; j < 8; ++j) {
                    const float wj = wL[tt * 128 + bt * 8 + j];
                    const f32x2 wj2 = {wj, wj};
#pragma unroll
                    for (int q = 0; q < 4; ++q) {
                        f32x2 lo = __builtin_amdgcn_cvt_pk_f32_fp8((int)va[tt][j][q], false);
                        f32x2 hi = __builtin_amdgcn_cvt_pk_f32_fp8((int)va[tt][j][q], true);
                        acc2[tt][q * 2] = wj2 * lo + acc2[tt][q * 2];
                        acc2[tt][q * 2 + 1] = wj2 * hi + acc2[tt][q * 2 + 1];
                    }
                }
            }
            CONV_FINISH(bt)
            if (bt + 1 < 16) CONV_ISSUE(bt + 1)
        }
        int oz2 = 0; asm volatile("" : "+v"(oz2));
#pragma unroll
        for (int tt = 0; tt < 3; ++tt) {
            const int lane = (ltid() & 63) + oz2, w = (ltid() >> 6) + oz2;
            const int tok = t0 + w + tt * 8;
            float* xr = X + (size_t)tok * 1024;
            const float* m5 = mods + cond_of(tok) * 6144 + 5 * 1024;
            float x[16];
#pragma unroll
            for (int q = 0; q < 4; ++q) {
                float4 a = *(const float4*)(xr + q * 256 + lane * 4);
                float4 g = *(const float4*)(m5 + q * 256 + lane * 4);
                x[q * 4] = a.x + g.x * acc2[tt][q * 2][0]; x[q * 4 + 1] = a.y + g.y * acc2[tt][q * 2][1];
                x[q * 4 + 2] = a.z + g.z * acc2[tt][q * 2 + 1][0]; x[q * 4 + 3] = a.w + g.w * acc2[tt][q * 2 + 1][1];
            }
            float ss = 0.f;
#pragma unroll
            for (int j = 0; j < 16; ++j) ss += x[j] * x[j];
            ss = wave_sum(ss);
            const float rs = rsqrtf(ss * (1.0f / 1024.0f) + EPSV);
            if (l < 3) {
                float* xw = Xw + (size_t)tok * 1024;
                const float* modn = (const float*)(p.ws + OFF_MODS) + (size_t)(l + 1) * 3 * 6144 + cond_of(tok) * 6144;
                const float* g1 = p.in[I_N1G] + (l + 1) * 1024;
                bf16_t* hw = Hw + (size_t)tok * 1024;
#pragma unroll
                for (int q = 0; q < 4; ++q) {
                    const int d0 = q * 256 + lane * 4;
                    *(float4*)(xw + d0) = make_float4(x[q * 4], x[q * 4 + 1], x[q * 4 + 2], x[q * 4 + 3]);
                    float4 g = *(const float4*)(g1 + d0), sh = *(const float4*)(modn + d0), sc = *(const float4*)(modn + 1024 + d0);
                    float o0 = (x[q * 4] * rs * g.x) * (1.0f + sc.x) + sh.x, o1 = (x[q * 4 + 1] * rs * g.y) * (1.0f + sc.y) + sh.y;
                    float o2 = (x[q * 4 + 2] * rs * g.z) * (1.0f + sc.z) + sh.z, o3 = (x[q * 4 + 3] * rs * g.w) * (1.0f + sc.w) + sh.w;
                    *(uint2*)(hw + d0) = make_uint2(pack2(o0, o1), pack2(o2, o3));
                }
            } else {
                const float* g = p.in[I_FNG];
                float* yo = Yw + (size_t)tok * 1024;
#pragma unroll
                for (int q = 0; q < 4; ++q) {
                    const int d0 = q * 256 + lane * 4;
                    float4 g0 = *(const float4*)(g + d0);
                    *(float4*)(yo + d0) = make_float4(x[q * 4] * rs * g0.x, x[q * 4 + 1] * rs * g0.y, x[q * 4 + 2] * rs * g0.z, x[q * 4 + 3] * rs * g0.w);
                }
            }
        }
    }
}

#define RG_XS 68
#define RG_RS 257
__device__ __forceinline__ void rg_unit(const Params& p, int l, int seq, int n, int ct, float* lds) {
    const int tid0 = ltid(), lane0 = tid0 & 63, w0 = tid0 >> 6;
    const int jl = l >> 1;
    const int L = seq < 16 ? 256 : 1024;
    const int tokbase = seq < 16 ? seq * 256 : 4096 + (seq - 16) * 1024;
    const int nsteps = L >> 8;
    const int cbase = n * 64, obase = cbase + ct * 32;
    float* xr = lds;
    float* aS = lds + 256 * RG_XS;
    float* bS = aS + 32 * RG_RS;
    float* segA = bS + 32 * RG_RS;
    float* segB = segA + 512;
    bf16_t* wS = (bf16_t*)(segB + 512);
    const float* PB = (const float*)(p.ws + OFF_PB);
    float* HF = (float*)(p.ws + OFF_HF);
    bf16_t* Y = (bf16_t*)(p.ws + OFF_Y);
    const int cg0 = tid0 & 15, tr0 = tid0 >> 4;
    f32x4 cwv[4]; f32x4 cbv;
    {
        const float* cw = p.in[I_RGCW] + jl * 4096 + cbase + cg0 * 4;
#pragma unroll
        for (int j = 0; j < 4; ++j) cwv[j] = *(const f32x4*)(cw + j * 1024);
        cbv = *(const f32x4*)(p.in[I_RGCB] + jl * 1024 + cbase + cg0 * 4);
    }
    const int sc0 = tid0 & 31, sg0 = tid0 >> 5;
    f32x4 rw[11];
#define RG_ISSUE(pb_) { const int pos0_ = (pb_) + tr * 8 - 2; \
        _Pragma("unroll") for (int j = 0; j < 11; ++j) { const int pp_ = pos0_ + j; \
            f32x4 z_ = {0.f, 0.f, 0.f, 0.f}; if (pp_ >= 0 && pp_ < L) z_ = *(const f32x4*)(PB + (size_t)(tokbase + pp_) * 2048 + 1024 + cbase + cg * 4); rw[j] = z_; } }
    { const int tr = tr0, cg = cg0; RG_ISSUE(0) }
    float hfreg[16];
#pragma unroll
    for (int j = 0; j < 16; ++j) hfreg[j] = 0.f;
    __syncthreads();
#pragma unroll 1
    for (int d = 0; d < 2; ++d) {
        const int m = (jl * 2 + d) * 16 + n;
        const bf16_t* WT = (const bf16_t*)(p.ws + OFF_RGW) + (size_t)m * 2 * 4096;
        {
            const int g_ = tid0 >> 8, j_ = (tid0 >> 3) & 31, k8 = (tid0 & 7) * 8;
            *(u32x4*)(wS + (g_ * 32 + j_) * 72 + k8) = *(const u32x4*)(WT + g_ * 4096 + (ct * 32 + j_) * 64 + k8);
        }
        const int cch = obase + (lane0 & 31);
        const float bav = p.in[I_RGBA][(jl * 2 + d) * 1024 + cch];
        const float biv = p.in[I_RGBI][(jl * 2 + d) * 1024 + cch];
        const float spv = __logf(1.0f + __expf(-p.in[I_RGLAM][(jl * 2 + d) * 1024 + cch]));
        float hc = 0.f;
        if (seq >= 16) hc = p.in[I_SRG][(((seq - 16) * 2 + jl) * 2 + d) * 1024 + obase + sc0];
#pragma unroll 1
        for (int st = 0; st < nsteps; ++st) {
            const int pbase = d ? (L - 256 - st * 256) : st * 256;
            int oz = 0; asm volatile("" : "+v"(oz));
            const int lane = lane0 + oz, w = w0 + oz, tid = tid0 + oz;
            const int cg = tid & 15, tr = tid >> 4, sc = tid & 31, sg = tid >> 5, tt = tid >> 1, half = tid & 1;
            if (!(nsteps == 1 && d == 1)) {
#pragma unroll
                for (int t = 0; t < 8; ++t) {
                    f32x4 o = cbv + cwv[0] * rw[t] + cwv[1] * rw[t + 1] + cwv[2] * rw[t + 2] + cwv[3] * rw[t + 3];
                    *(f32x4*)(xr + (tr * 8 + t) * RG_XS + cg * 4) = o;
                }
                if (nsteps > 1) {
                    int nd = d, nst = st + 1;
                    if (nst == nsteps) { nd = d + 1; nst = 0; }
                    if (nd < 2) { const int npb = nd ? (L - 256 - nst * 256) : nst * 256; RG_ISSUE(npb) }
                }
            }
            __syncthreads();
            f32x16 accR, accI;
#pragma unroll
            for (int i = 0; i < 16; ++i) { accR[i] = 0.f; accI[i] = 0.f; }
#pragma unroll
            for (int kk = 0; kk < 4; ++kk) {
                const float* ap = xr + (w * 32 + (lane & 31)) * RG_XS + kk * 16 + (lane >> 5) * 8;
                const float4 x0 = *(const float4*)ap, x1 = *(const float4*)(ap + 4);
                union { bf16x8 v; unsigned u[4]; } af;
                af.u[0] = pack2(x0.x, x0.y); af.u[1] = pack2(x0.z, x0.w); af.u[2] = pack2(x1.x, x1.y); af.u[3] = pack2(x1.z, x1.w);
                const bf16x8 bRk = *(const bf16x8*)(wS + (lane & 31) * 72 + kk * 16 + (lane >> 5) * 8);
                const bf16x8 bIk = *(const bf16x8*)(wS + (32 + (lane & 31)) * 72 + kk * 16 + (lane >> 5) * 8);
                accR = __builtin_amdgcn_mfma_f32_32x32x16_bf16(af.v, bRk, accR, 0, 0, 0);
                accI = __builtin_amdgcn_mfma_f32_32x32x16_bf16(af.v, bIk, accI, 0, 0, 0);
            }
#pragma unroll
            for (int r = 0; r < 16; ++r) {
                const int row = w * 32 + (r & 3) + 8 * (r >> 2) + 4 * (lane >> 5);
                const float rg = sigmoidf_(accR[r] + bav);
                const float ig = sigmoidf_(accI[r] + biv);
                const float av = __expf(-8.0f * rg * spv);
                const float mult = sqrtf(fmaxf(1.0f - av * av, 0.f));
                const float xc = xr[row * RG_XS + ct * 32 + (lane & 31)];
                const int s_ = d ? 255 - row : row;
                aS[(lane & 31) * RG_RS + s_] = av;
                bS[(lane & 31) * RG_RS + s_] = mult * ig * xc;
            }
            const int tok = tokbase + pbase + tt;
            f32x4 gq[4], hq[4];
            if (d == 1) {
                const float* gp = PB + (size_t)tok * 2048 + obase + half * 16;
#pragma unroll
                for (int j = 0; j < 4; ++j) gq[j] = *(const f32x4*)(gp + j * 4);
                if (nsteps > 1) {
                    const float* hp = HF + (size_t)tok * 1024 + obase + half * 16;
#pragma unroll
                    for (int j = 0; j < 4; ++j) hq[j] = *(const f32x4*)(hp + j * 4);
                }
            }
            __syncthreads();
            {
                const int base = sc * RG_RS + sg * 16;
                float av[16], bv[16];
                float Aa = 1.f, Bb = 0.f;
#pragma unroll
                for (int i = 0; i < 16; ++i) { av[i] = aS[base + i]; bv[i] = bS[base + i]; Bb = av[i] * Bb + bv[i]; Aa *= av[i]; }
                segA[sg * 32 + sc] = Aa; segB[sg * 32 + sc] = Bb;
                __syncthreads();
                float hin = hc, hall = hc;
#pragma unroll
                for (int g = 0; g < 16; ++g) {
                    const float sa = segA[g * 32 + sc], sb = segB[g * 32 + sc];
                    hall = sa * hall + sb;
                    if (g < sg) hin = hall;
                }
                float hcur = hin;
#pragma unroll
                for (int i = 0; i < 16; ++i) { hcur = av[i] * hcur + bv[i]; bS[base + i] = hcur; }
                hc = hall;
            }
            __syncthreads();
            {
                const int s_ = d ? 255 - tt : tt;
                float hv[16];
#pragma unroll
                for (int j = 0; j < 16; ++j) hv[j] = bS[(half * 16 + j) * RG_RS + s_];
                if (d == 0) {
                    if (nsteps == 1) {
#pragma unroll
                        for (int j = 0; j < 16; ++j) hfreg[j] = hv[j];
                    } else {
                        float* hp = HF + (size_t)tok * 1024 + obase + half * 16;
#pragma unroll
                        for (int j = 0; j < 4; ++j) *(float4*)(hp + j * 4) = make_float4(hv[4 * j], hv[4 * j + 1], hv[4 * j + 2], hv[4 * j + 3]);
                    }
                } else {
                    float hf[16];
                    if (nsteps == 1) {
#pragma unroll
                        for (int j = 0; j < 16; ++j) hf[j] = hfreg[j];
                    } else {
#pragma unroll
                        for (int j = 0; j < 4; ++j) { hf[4 * j] = hq[j][0]; hf[4 * j + 1] = hq[j][1]; hf[4 * j + 2] = hq[j][2]; hf[4 * j + 3] = hq[j][3]; }
                    }
                    unsigned o[8];
#pragma unroll
                    for (int j = 0; j < 4; ++j) {
                        o[2 * j] = pack2(gq[j][0] * (hf[4 * j] + hv[4 * j]), gq[j][1] * (hf[4 * j + 1] + hv[4 * j + 1]));
                        o[2 * j + 1] = pack2(gq[j][2] * (hf[4 * j + 2] + hv[4 * j + 2]), gq[j][3] * (hf[4 * j + 3] + hv[4 * j + 3]));
                    }
                    bf16_t* yp = Y + (size_t)tok * 1024 + obase + half * 16;
                    *(uint4*)yp = make_uint4(o[0], o[1], o[2], o[3]);
                    *(uint4*)(yp + 8) = make_uint4(o[4], o[5], o[6], o[7]);
                }
            }
        }
        if (seq < 16 && sg0 == 0)
            p.out[OUT_RG + ((seq * 2 + jl) * 2 + d) * 1024 + obase + sc0] = hc;
    }
}

__device__ __forceinline__ void phase_rgscan(const Params& p, int l, float* lds) {
    const int b = blockIdx.x, G = gridDim.x;
    int u, stride, end;
    if (G == 256) { if (b < 64) { u = b; stride = 1024; end = 64; } else { u = 64 + (b - 64); stride = 192; end = 576; } }
    else { u = b; stride = G; end = 576; }
#pragma unroll 1
    for (; u < end; u += stride) {
        int seq, rest;
        if (u < 64) { seq = 16 + (u >> 5); rest = u & 31; } else { seq = (u - 64) >> 5; rest = (u - 64) & 31; }
        rg_unit(p, l, seq, rest >> 1, rest & 1, lds);
    }
}

__device__ __forceinline__ int gla_tok(int seq, int d, int sidx) {
    if (seq < 16) { int pp = d ? 255 - sidx : sidx; return seq * 256 + pp; }
    int pp = d ? 1023 - sidx : sidx;
    return 4096 + (seq - 16) * 1024 + ((pp & 15) << 6) + (pp >> 4);
}

__device__ __forceinline__ int gla_uidx(int seq, int c, int h, int d) {
    const int cg = seq < 16 ? seq * 4 + c : 64 + (seq - 16) * 16 + c;
    return (cg * 4 + h) * 2 + d;
}

__device__ __forceinline__ void gla_pre_unit(const Params& p, int l, int seq, int h, int d, int c, float* ldsf) {
    const int tid = ltid(), lane = tid & 63, w = tid >> 6;
    const int jl = l >> 1;
    float* zs = ldsf;
    float* tot = ldsf + 1024;
    float* gd = ldsf + 1536;
    bf16_t* qin = (bf16_t*)(ldsf + 1664);
    bf16_t* kin = qin + 64 * 136;
    bf16_t* kinT = kin + 64 * 136;
    bf16_t* att = kinT + 128 * 72;
    bf16_t* vT = att + 64 * 72;
    const float* PB = (const float*)(p.ws + OFF_PB);
    float* O = (float*)(p.ws + (d ? OFF_HB : OFF_HF));
    const int uidx = gla_uidx(seq, c, h, d);
    const int kk = tid & 127, ig = tid >> 7;
    const int dvv = tid & 63, i8 = tid >> 6;
    float4 zreg = make_float4(0.f, 0.f, 0.f, 0.f);
    float qreg[16], kreg[16];
    if (tid < 256) { const int tok_ = gla_tok(seq, d, c * 64 + (tid >> 2)); zreg = *(const float4*)(PB + (size_t)tok_ * 3104 + 3072 + d * 16 + (tid & 3) * 4); }
#pragma unroll
    for (int ii = 0; ii < 16; ++ii) {
        const int tok_ = gla_tok(seq, d, c * 64 + ig * 16 + ii);
        qreg[ii] = PB[(size_t)tok_ * 3104 + h * 128 + kk]; kreg[ii] = PB[(size_t)tok_ * 3104 + 512 + h * 128 + kk];
    }
    f32x2 wal2[8];
#pragma unroll
    for (int r = 0; r < 8; ++r) {
        wal2[r][0] = p.in[I_GLWAL][((size_t)(jl * 2 + d) * 16 + 2 * r) * 512 + h * 128 + kk];
        wal2[r][1] = p.in[I_GLWAL][((size_t)(jl * 2 + d) * 16 + 2 * r + 1) * 512 + h * 128 + kk];
    }
    const float bal = p.in[I_GLBAL][(jl * 2 + d) * 512 + h * 128 + kk];
    __syncthreads();
    if (tid < 256) *(float4*)(zs + (tid >> 2) * 16 + (tid & 3) * 4) = zreg;
    {
        float vreg[4][8];
#pragma unroll
        for (int ii = 0; ii < 8; ++ii) {
            const int tok_ = gla_tok(seq, d, c * 64 + i8 * 8 + ii);
#pragma unroll
            for (int g = 0; g < 4; ++g) vreg[g][ii] = PB[(size_t)tok_ * 3104 + 1024 + h * 256 + g * 64 + dvv];
        }
#pragma unroll
        for (int g = 0; g < 4; ++g)
            *(uint4*)(vT + (g * 64 + dvv) * 72 + i8 * 8) = make_uint4(pack2(vreg[g][0], vreg[g][1]), pack2(vreg[g][2], vreg[g][3]), pack2(vreg[g][4], vreg[g][5]), pack2(vreg[g][6], vreg[g][7]));
    }
    __syncthreads();
    float cum[16]; float run = 0.f;
#pragma unroll
    for (int ii = 0; ii < 16; ++ii) {
        const int i = ig * 16 + ii;
        const f32x4 z0 = *(const f32x4*)(zs + i * 16), z1 = *(const f32x4*)(zs + i * 16 + 4), z2 = *(const f32x4*)(zs + i * 16 + 8), z3 = *(const f32x4*)(zs + i * 16 + 12);
        f32x2 xa = z0.xy * wal2[0];
        xa = z0.zw * wal2[1] + xa; xa = z1.xy * wal2[2] + xa; xa = z1.zw * wal2[3] + xa;
        xa = z2.xy * wal2[4] + xa; xa = z2.zw * wal2[5] + xa; xa = z3.xy * wal2[6] + xa; xa = z3.zw * wal2[7] + xa;
        const float x = bal + xa[0] + xa[1];
        const float ls = fminf(x, 0.f) - __logf(1.0f + __expf(-fabsf(x)));
        run += ls * 0.0625f; cum[ii] = run;
    }
    tot[ig * 128 + kk] = run;
    __syncthreads();
    float off = 0.f, blast = 0.f;
#pragma unroll
    for (int g = 0; g < 4; ++g) { const float tv = tot[g * 128 + kk]; blast += tv; if (g < ig) off += tv; }
    if (ig == 0) { const float gv = __expf(blast); ((float*)(p.ws + OFF_GD))[(size_t)uidx * 128 + kk] = gv; }
    {
        unsigned kp[8];
#pragma unroll
        for (int ii = 0; ii < 16; ++ii) {
            const int i = ig * 16 + ii;
            const float bc = off + cum[ii];
            const unsigned qk = pack2(qreg[ii] * __expf(bc), kreg[ii] * __expf(-bc));
            const unsigned qb = qk & 0xffffu, kb = qk >> 16;
            qin[i * 136 + kk] = (bf16_t)qb;
            kin[i * 136 + kk] = (bf16_t)kb;
            if (ii & 1) kp[ii >> 1] |= kb << 16; else kp[ii >> 1] = kb;
        }
        *(uint4*)(kinT + kk * 72 + ig * 16) = make_uint4(kp[0], kp[1], kp[2], kp[3]);
        *(uint4*)(kinT + kk * 72 + ig * 16 + 8) = make_uint4(kp[4], kp[5], kp[6], kp[7]);
    }
    __syncthreads();
    {
        const uint4* qs = (const uint4*)qin;
        uint4* qg = (uint4*)(p.ws + OFF_QIN + (size_t)uidx * 64 * 136 * 2);
        for (int i = tid; i < 1088; i += NTHR) qg[i] = qs[i];
    }
    const int mt = w >> 1;
    const int l15 = lane & 15, l4 = lane >> 4;
#pragma unroll
    for (int nn = 0; nn < 2; ++nn) {
        const int nt = (w & 1) * 2 + nn;
        f32x4 acc = {0.f, 0.f, 0.f, 0.f};
        if (nt <= mt) {
#pragma unroll
            for (int ks = 0; ks < 4; ++ks) {
                bf16x8 a = *(const bf16x8*)(qin + (mt * 16 + l15) * 136 + ks * 32 + l4 * 8);
                bf16x8 b = *(const bf16x8*)(kin + (nt * 16 + l15) * 136 + ks * 32 + l4 * 8);
                acc = __builtin_amdgcn_mfma_f32_16x16x32_bf16(a, b, acc, 0, 0, 0);
            }
        }
#pragma unroll
        for (int r = 0; r < 4; ++r) {
            const int i = mt * 16 + l4 * 4 + r, j = nt * 16 + l15;
            att[i * 72 + j] = (bf16_t)f2bf(j <= i ? acc[r] : 0.f);
        }
    }
    {
        uint2* ug = (uint2*)(p.ws + OFF_UR) + ((size_t)uidx * 8 + w) * 16 * 64 + lane;
        const bf16x8 a0 = *(const bf16x8*)(kinT + (w * 16 + l15) * 72 + l4 * 8);
        const bf16x8 a1 = *(const bf16x8*)(kinT + (w * 16 + l15) * 72 + 32 + l4 * 8);
#pragma unroll 4
        for (int nt = 0; nt < 16; ++nt) {
            f32x4 acc = {0.f, 0.f, 0.f, 0.f};
            bf16x8 b0 = *(const bf16x8*)(vT + (nt * 16 + l15) * 72 + l4 * 8);
            bf16x8 b1 = *(const bf16x8*)(vT + (nt * 16 + l15) * 72 + 32 + l4 * 8);
            acc = __builtin_amdgcn_mfma_f32_16x16x32_bf16(a0, b0, acc, 0, 0, 0);
            acc = __builtin_amdgcn_mfma_f32_16x16x32_bf16(a1, b1, acc, 0, 0, 0);
            ug[nt * 64] = make_uint2(pack2(acc[0], acc[1]), pack2(acc[2], acc[3]));
        }
    }
    __syncthreads();
    {
        const bf16x8 a0 = *(const bf16x8*)(att + (mt * 16 + l15) * 72 + l4 * 8);
        const bf16x8 a1 = *(const bf16x8*)(att + (mt * 16 + l15) * 72 + 32 + l4 * 8);
        int tokr[4];
#pragma unroll
        for (int r = 0; r < 4; ++r) tokr[r] = gla_tok(seq, d, c * 64 + mt * 16 + l4 * 4 + r);
#pragma unroll 4
        for (int nn = 0; nn < 8; ++nn) {
            const int nt = (w & 1) * 8 + nn;
            f32x4 acc = {0.f, 0.f, 0.f, 0.f};
            bf16x8 b0 = *(const bf16x8*)(vT + (nt * 16 + l15) * 72 + l4 * 8);
            bf16x8 b1 = *(const bf16x8*)(vT + (nt * 16 + l15) * 72 + 32 + l4 * 8);
            acc = __builtin_amdgcn_mfma_f32_16x16x32_bf16(a0, b0, acc, 0, 0, 0);
            acc = __builtin_amdgcn_mfma_f32_16x16x32_bf16(a1, b1, acc, 0, 0, 0);
#pragma unroll
            for (int r = 0; r < 4; ++r) O[(size_t)tokr[r] * 1024 + h * 256 + nt * 16 + l15] = acc[r];
        }
    }
}

__device__ __forceinline__ void phase_gla_pre(const Params& p, int l, float* lds) {
#pragma unroll 1
    for (int u = blockIdx.x; u < 768; u += gridDim.x) {
        const int d = u & 1, h = (u >> 1) & 3, cg = u >> 3;
        int seq, c;
        if (cg < 64) { seq = cg >> 2; c = cg & 3; } else { seq = 16 + ((cg - 64) >> 4); c = (cg - 64) & 15; }
        gla_pre_unit(p, l, seq, h, d, c, lds);
    }
}

__device__ __forceinline__ void gla_scan_unit(const Params& p, int l, int seq, int h, int d, int e, float* ldsf, bool dry) {
    const int tid = ltid(), lane = tid & 63, w = tid >> 6;
    const int jl = l >> 1;
    const int nch = seq < 16 ? 4 : 16;
    bf16_t* ST = (bf16_t*)ldsf;
    float* O = (float*)(p.ws + (d ? OFF_HB : OFF_HF));
    float* Ow = dry ? (float*)(p.ws + WS_END) : O;
    const int kt = w, mt = w >> 1;
    const int l15 = lane & 15, l4 = lane >> 4;
    f32x4 S[4];
    __syncthreads();
#pragma unroll
    for (int nt = 0; nt < 4; ++nt) {
#pragma unroll
        for (int r = 0; r < 4; ++r) {
            const int k = kt * 16 + l4 * 4 + r, dv = nt * 16 + l15;
            float v = 0.f;
            if (seq >= 16) v = p.in[I_SGLA][((((size_t)((seq - 16) * 2 + jl) * 2 + d) * 4 + h) * 128 + k) * 256 + e * 64 + dv];
            S[nt][r] = v;
        }
        *(uint2*)(ST + (nt * 16 + l15) * 136 + kt * 16 + l4 * 4) = make_uint2(pack2(S[nt][0], S[nt][1]), pack2(S[nt][2], S[nt][3]));
    }
    bf16x8 aA[4], aB[4], aC[4];
    uint2 uA[4], uB[4], uC[4];
    f32x4 gA, gB, gC, oA[2], oB[2], oC[2];
#define GLB_LOAD(S_, c_) { const int ui_ = gla_uidx(seq, (c_), h, d); \
        const uint2* ug_ = (const uint2*)(p.ws + OFF_UR) + ((size_t)ui_ * 8 + kt) * 16 * 64 + lane; \
        _Pragma("unroll") for (int nt = 0; nt < 4; ++nt) u##S_[nt] = ug_[(e * 4 + nt) * 64]; \
        g##S_ = *(const f32x4*)((const float*)(p.ws + OFF_GD) + (size_t)ui_ * 128 + kt * 16 + l4 * 4); \
        const bf16_t* qg_ = (const bf16_t*)(p.ws + OFF_QIN) + (size_t)ui_ * 64 * 136 + (mt * 16 + l15) * 136 + l4 * 8; \
        _Pragma("unroll") for (int ks = 0; ks < 4; ++ks) a##S_[ks] = *(const bf16x8*)(qg_ + ks * 32); \
        _Pragma("unroll") for (int nn = 0; nn < 2; ++nn) { _Pragma("unroll") for (int r = 0; r < 4; ++r) { \
            const int tok_ = gla_tok(seq, d, (c_) * 64 + mt * 16 + l4 * 4 + r); \
            o##S_[nn][r] = O[(size_t)tok_ * 1024 + h * 256 + e * 64 + ((w & 1) * 2 + nn) * 16 + l15]; } } }
#define GLB_STEP(S_, cc_) if ((cc_) < nch) { \
        _Pragma("unroll") for (int nn = 0; nn < 2; ++nn) { \
            const int nt = (w & 1) * 2 + nn; \
            f32x4 acc = o##S_[nn]; \
            _Pragma("unroll") for (int ks = 0; ks < 4; ++ks) { \
                bf16x8 b = *(const bf16x8*)(ST + (nt * 16 + l15) * 136 + ks * 32 + l4 * 8); \
                acc = __builtin_amdgcn_mfma_f32_16x16x32_bf16(a##S_[ks], b, acc, 0, 0, 0); } \
            _Pragma("unroll") for (int r = 0; r < 4; ++r) { \
                const int tok_ = gla_tok(seq, d, (cc_) * 64 + mt * 16 + l4 * 4 + r); \
                Ow[(size_t)tok_ * 1024 + h * 256 + e * 64 + nt * 16 + l15] = acc[r]; } } \
        __syncthreads(); \
        _Pragma("unroll") for (int nt = 0; nt < 4; ++nt) { \
            { const uint2 uu_ = u##S_[nt]; const f32x4 uf_ = {bflo(uu_.x), bfhi(uu_.x), bflo(uu_.y), bfhi(uu_.y)}; S[nt] = g##S_ * (S[nt] + uf_); } \
            *(uint2*)(ST + (nt * 16 + l15) * 136 + kt * 16 + l4 * 4) = make_uint2(pack2(S[nt][0], S[nt][1]), pack2(S[nt][2], S[nt][3])); } \
        if ((cc_) + 3 < nch) GLB_LOAD(S_, (cc_) + 3) \
        __syncthreads(); }
    GLB_LOAD(A, 0) GLB_LOAD(B, 1) GLB_LOAD(C, 2)
    __syncthreads();
#pragma unroll
    for (int c = 0; c < 18; c += 3) {
        int oz = 0; asm volatile("" : "+v"(oz));
        const int lane_i = lane + oz, w_i = w + oz;
        {
            const int lane = lane_i, w = w_i, kt = w_i, mt = w_i >> 1, l15 = lane_i & 15, l4 = lane_i >> 4;
            GLB_STEP(A, c)
            GLB_STEP(B, c + 1)
            GLB_STEP(C, c + 2)
        }
    }
    if (seq < 16) {
#pragma unroll
        for (int nt = 0; nt < 4; ++nt)
#pragma unroll
            for (int r = 0; r < 4; ++r) {
                const int k = kt * 16 + l4 * 4 + r, dv = nt * 16 + l15;
                p.out[OUT_GLA + ((((size_t)(seq * 2 + jl) * 2 + d) * 4 + h) * 128 + k) * 256 + e * 64 + dv] = S[nt][r];
            }
    }
}

__device__ __forceinline__ void phase_gla(const Params& p, int l, float* lds, bool dry = false) {
    const int b = blockIdx.x, G = gridDim.x;
    int u, stride, end;
    if (G == 256) { if (b < 64) { u = b; stride = 1024; end = 64; } else { u = 64 + (b - 64); stride = 192; end = 576; } }
    else { u = b; stride = G; end = 576; }
#pragma unroll 1
    for (; u < end; u += stride) {
        int seq, rest;
        if (u < 64) { seq = 16 + (u >> 5); rest = u & 31; } else { seq = (u - 64) >> 5; rest = (u - 64) & 31; }
        gla_scan_unit(p, l, seq, rest >> 3, (rest >> 2) & 1, rest & 3, lds, dry);
    }
}

__device__ __forceinline__ void phase_gla_norm(const Params& p, int l) {
    const int lane = ltid() & 63, w = ltid() >> 6;
    const int jl = l >> 1;
    const float* OF = (const float*)(p.ws + OFF_HF);
    const float* OB = (const float*)(p.ws + OFF_HB);
    const float* PB = (const float*)(p.ws + OFF_PB);
    bf16_t* Y = (bf16_t*)(p.ws + OFF_Y);
    const float* ng = p.in[I_GLNG] + jl * 1024;
    for (int tok = blockIdx.x * 8 + w; tok < TTOK; tok += gridDim.x * 8) {
#pragma unroll
        for (int hh = 0; hh < 4; ++hh) {
            const int d0 = hh * 256 + lane * 4;
            float4 a = *(const float4*)(OF + (size_t)tok * 1024 + d0), b = *(const float4*)(OB + (size_t)tok * 1024 + d0);
            float o0 = a.x + b.x, o1 = a.y + b.y, o2 = a.z + b.z, o3 = a.w + b.w;
            float ss = wave_sum(o0 * o0 + o1 * o1 + o2 * o2 + o3 * o3);
            const float rs = rsqrtf(ss * (1.0f / 256.0f) + EPSV);
            float4 gn = *(const float4*)(ng + d0);
            float4 gg = *(const float4*)(PB + (size_t)tok * 3104 + 2048 + d0);
            float y0 = siluf_(gg.x) * (o0 * rs * gn.x), y1 = siluf_(gg.y) * (o1 * rs * gn.y);
            float y2 = siluf_(gg.z) * (o2 * rs * gn.z), y3 = siluf_(gg.w) * (o3 * rs * gn.w);
            *(uint2*)(Y + (size_t)tok * 1024 + d0) = make_uint2(pack2(y0, y1), pack2(y2, y3));
        }
    }
}

#define LDS_FLOATS 38400
#define NPHASE 34
#ifndef REP_MASK
#define REP_MASK 0
#endif

__device__ __forceinline__ bool phase_noop(int ph) {
    if (ph < 2) return false;
    const int l = (ph - 2) / 8, s = (ph - 2) % 8;
    return ((s == 2) || (s == 3)) && ((l & 1) == 0);
}

__global__ void __launch_bounds__(NTHR) hybrid_fwd(Params p) {
    __shared__ __attribute__((aligned(16))) float lds[LDS_FLOATS];
    __shared__ uint4 xb_words;
    if (threadIdx.x == 0) xb_words = make_uint4(0u, 0u, 0u, 0u);
    __syncthreads();
    XcdBarrier bar = xcd_barrier_post((unsigned*)(p.ws + OFF_BAR), (volatile LAS unsigned*)&xb_words);
    bool first = true;
    for (int ph = p.ph_lo; ph < p.ph_hi; ++ph) {
        if (phase_noop(ph)) continue;
        if (!first) xcd_barrier(bar);
        first = false;
        if (ph == 0) { for (int r = 0; r < 1 + ((REP_MASK >> 0) & 1); ++r) { if (r) __syncthreads(); phase_setup(p, lds); } }
        else if (ph == 1) phase_norm(p, 0, 0);
        else {
            const int l = (ph - 2) / 8, s = (ph - 2) % 8;
            const bool gla = (l & 1) != 0;
            if (s == 0 || s == 4) {
                const int kind = (s == 4) ? EPI_OUT : (gla ? EPI_GLAIN : EPI_RGIN);
                const int nrep = 1 + ((REP_MASK >> 2) & 1);
                for (int r = 0; r < nrep; ++r) { if (r) __syncthreads(); phase_gemm(p, l, kind, lds, (kind == EPI_OUT) && (r + 1 < nrep)); }
            } else switch (s) {
                case 1: if (gla) { for (int r = 0; r < 1 + ((REP_MASK >> 4) & 1); ++r) { if (r) __syncthreads(); phase_gla_pre(p, l, lds); } }
                        else { for (int r = 0; r < 1 + ((REP_MASK >> 3) & 1); ++r) { if (r) __syncthreads(); phase_rgscan(p, l, lds); } } break;
                case 2: { const int nrep = 1 + ((REP_MASK >> 5) & 1); for (int r = 0; r < nrep; ++r) { if (r) __syncthreads(); phase_gla(p, l, lds, r + 1 < nrep); } } break;
                case 3: phase_gla_norm(p, l); break;
                case 5: for (int r = 0; r < 1 + ((REP_MASK >> 1) & 1); ++r) phase_norm(p, l, 1); break;
                case 6: for (int r = 0; r < 1 + ((REP_MASK >> 6) & 1); ++r) { if (r) __syncthreads(); phase_peerq(p, l, lds); } break;
                case 7: { const int nrep = 1 + ((REP_MASK >> 7) & 1); for (int r = 0; r < nrep; ++r) { if (r) __syncthreads(); phase_peer_gather(p, l, lds, r + 1 < nrep); } } break;
            }
        }
    }
}

extern "C" void kernel_launch(void* const* d_in, const int* in_sizes, int n_in, void* d_out, int out_size, void* d_ws, size_t ws_size,
                              hipStream_t stream) {
    static int grid = 0;
    if (grid == 0) {
        int dev = 0, cus = 0, per_cu = 0;
        hipGetDevice(&dev);
        hipDeviceGetAttribute(&cus, hipDeviceAttributeMultiprocessorCount, dev);
        hipOccupancyMaxActiveBlocksPerMultiprocessor(&per_cu, (const void*)hybrid_fwd, NTHR, 0);
        (void)hipGetLastError();
        if (per_cu < 1) fprintf(stderr, "kernel_launch: occupancy query says %d blocks per CU\n", per_cu);
        grid = cus > 0 ? cus : 256;
        if (ws_size < WS_END) fprintf(stderr, "kernel_launch: workspace too small (%zu < %zu)\n", ws_size, (size_t)WS_END);
    }
    hipMemsetAsync((char*)d_ws + OFF_BAR, 0, 16384, stream);
    Params p{};
    for (int i = 0; i < 30; ++i) p.in[i] = (const float*)d_in[i];
    p.out = (float*)d_out; p.ws = (unsigned char*)d_ws;
#if MULTI_LAUNCH
    for (int ph = 0; ph < NPHASE; ++ph) {
        p.ph_lo = ph; p.ph_hi = ph + 1;
        hipLaunchKernelGGL(hybrid_fwd, dim3(grid), dim3(NTHR), 0, stream, p);
    }
#else
    p.ph_lo = 0; p.ph_hi = NPHASE;
    void* args[] = {&p};
    hipError_t e = hipLaunchCooperativeKernel((const void*)hybrid_fwd, dim3(grid), dim3(NTHR), args, 0, stream);
    if (e != hipSuccess) fprintf(stderr, "cooperative launch failed: %s (grid %d)\n", hipGetErrorString(e), grid);
#endif
}
```

```cpp
#include <hip/hip_runtime.h>
#include <stdint.h>
#include <stdio.h>

#ifndef MULTI_LAUNCH
#define MULTI_LAUNCH 0
#endif

typedef __attribute__((ext_vector_type(8))) short bf16x8;
typedef __attribute__((ext_vector_type(4))) float f32x4;
typedef __attribute__((ext_vector_type(16))) float f32x16;
typedef __attribute__((ext_vector_type(2))) __bf16 bf2_t;
typedef unsigned short bf16_t;
typedef unsigned u32x4 __attribute__((ext_vector_type(4)));

#define NTHR 512
#define TTOK 6144
#define DM 1024
#define EPSV 1e-6f

constexpr size_t AL(size_t x) { return (x + 255) & ~(size_t)255; }
constexpr size_t OFF_BAR   = 0;
constexpr size_t OFF_MODS  = 16384;
constexpr size_t OFF_X     = AL(OFF_MODS + (size_t)4 * 3 * 6144 * 4);
constexpr size_t OFF_H     = AL(OFF_X + (size_t)TTOK * DM * 4);
constexpr size_t OFF_Y     = AL(OFF_H + (size_t)TTOK * DM * 2);
constexpr size_t OFF_PB    = AL(OFF_Y + (size_t)TTOK * DM * 2);
constexpr size_t OFF_HF    = AL(OFF_PB + (size_t)TTOK * 3104 * 4);
constexpr size_t OFF_HB    = AL(OFF_HF + (size_t)TTOK * DM * 4);
constexpr size_t OFF_TK    = AL(OFF_HB + (size_t)TTOK * DM * 4);
constexpr size_t OFF_RGWIN = AL(OFF_TK + (size_t)TTOK * 256 * 4);
constexpr size_t OFF_RGWOUT= AL(OFF_RGWIN + (size_t)2 * 2048 * 1024 * 2);
constexpr size_t OFF_GLWIN = AL(OFF_RGWOUT + (size_t)2 * 1024 * 1024 * 2);
constexpr size_t OFF_GLWOUT= AL(OFF_GLWIN + (size_t)2 * 3200 * 1024 * 2);
constexpr size_t OFF_PWQ   = AL(OFF_GLWOUT + (size_t)2 * 1024 * 1024 * 2);
constexpr size_t OFF_PK    = AL(OFF_PWQ + (size_t)4 * 2048 * 1024 * 2);
constexpr size_t OFF_PU    = AL(OFF_PK + (size_t)4 * 2 * 8 * 128 * 128 * 2);
constexpr size_t OFF_PV    = AL(OFF_PU + (size_t)4 * 16384 * 1024);
constexpr size_t OFF_SU    = AL(OFF_PV + (size_t)4 * 16384 * 1024);
constexpr size_t OFF_SV    = AL(OFF_SU + (size_t)4 * 16384 * 4);
constexpr size_t OFF_RGW   = AL(OFF_SV + (size_t)4 * 16384 * 4);
constexpr size_t OFF_QIN   = AL(OFF_RGW + (size_t)2 * 2 * 16 * 2 * 4096 * 2);
constexpr size_t OFF_GD    = AL(OFF_QIN + (size_t)768 * 64 * 136 * 2);
constexpr size_t OFF_UR    = AL(OFF_GD + (size_t)768 * 128 * 4);
constexpr size_t WS_END    = AL(OFF_UR + (size_t)768 * 8 * 16 * 64 * 8);

constexpr size_t OUT_Y    = 0;
constexpr size_t OUT_RG   = (size_t)TTOK * DM;
constexpr size_t OUT_GLA  = OUT_RG + 16 * 2 * 2 * 1024;

struct Params {
    const float* in[30];
    float* out;
    unsigned char* ws;
    int ph_lo, ph_hi;
};

enum { I_XP = 0, I_XS, I_SRG, I_SGLA, I_C, I_CCTX, I_N1G, I_N2G, I_ADAW, I_ADAB, I_PWQ, I_PK1, I_PK2, I_PU, I_PV,
       I_RGWIN, I_RGCW, I_RGCB, I_RGWA, I_RGBA, I_RGWI, I_RGBI, I_RGLAM, I_RGWOUT, I_GLWIN, I_GLWAL, I_GLBAL, I_GLNG, I_GLWOUT, I_FNG };

typedef float f32x2 __attribute__((ext_vector_type(2)));
__device__ __forceinline__ unsigned pack2(float a, float b) {
    f32x2 v = {a, b};
    return __builtin_bit_cast(unsigned, __builtin_convertvector(v, bf2_t));
}
__device__ __forceinline__ unsigned f2bf(float f) { return pack2(f, 0.f) & 0xffffu; }
__device__ __forceinline__ float bflo(unsigned u) { return __uint_as_float(u << 16); }
__device__ __forceinline__ float bfhi(unsigned u) { return __uint_as_float(u & 0xffff0000u); }
__device__ __forceinline__ float sigmoidf_(float x) { return 1.0f / (1.0f + __expf(-x)); }
__device__ __forceinline__ float siluf_(float x) { return x * sigmoidf_(x); }
__device__ __forceinline__ float gelu_tanh(float x) {
    float u = 0.7978845608028654f * (x + 0.044715f * x * x * x);
    float t = __expf(2.0f * u);
    float th = 1.0f - 2.0f / (t + 1.0f);
    return 0.5f * x * (1.0f + th);
}
__device__ __forceinline__ int ltid() { int t = threadIdx.x; asm volatile("" : "+v"(t)); return t; }
__device__ __forceinline__ int cond_of(int tok) { return tok < 4096 ? 0 : 1 + ((tok - 4096) >> 10); }
__device__ __forceinline__ float wave_sum(float v) {
#pragma unroll
    for (int o = 32; o >= 1; o >>= 1) v += __shfl_xor(v, o);
    return v;
}

#define XB_TMO      128
#define XB_XCNT(j)  (256  + 64 * (j))
#define XB_XSUB(j)  (1280 + 64 * (j))
#define XB_XGEN(j)  (2304 + 64 * (j))
#define XB_TOP      3328
#define XB_TOPGEN   3392
#define XCD_BAR_WORDS 3456
#define XB_SPIN_CAP (1u << 22)
#define LAS __attribute__((address_space(3)))

__device__ __forceinline__ unsigned xb_ld(unsigned* p)              { return __hip_atomic_load(p, __ATOMIC_RELAXED, __HIP_MEMORY_SCOPE_AGENT); }
__device__ __forceinline__ unsigned xb_add(unsigned* p, unsigned v) { return __hip_atomic_fetch_add(p, v, __ATOMIC_RELAXED, __HIP_MEMORY_SCOPE_AGENT); }
__device__ __forceinline__ unsigned xb_xcc_id() { return (unsigned)__builtin_amdgcn_s_getreg((3 << 11) | 20) & 0xFu; }
#define XB_SPIN(cond, bar) do { unsigned _sp = 0; while (cond) { __builtin_amdgcn_s_sleep(1); \
    if ((++_sp & 255u) == 0u) { if (xb_ld(&(bar)[XB_TMO])) break; if (_sp > XB_SPIN_CAP) { atomicAdd(&(bar)[XB_TMO], 1u); break; } } } } while (0)

struct XcdBarrier { unsigned* bar; unsigned x; volatile LAS unsigned* st; };

__device__ __forceinline__ XcdBarrier xcd_barrier_post(unsigned* bar, volatile LAS unsigned* st) {
    XcdBarrier b; b.bar = bar; b.x = xb_xcc_id(); b.st = st;
    if (threadIdx.x == 0) (void)xb_add(&bar[XB_XCNT(b.x)], 1u);
    return b;
}
__device__ __forceinline__ void xcd_barrier_complete(unsigned* bar, unsigned x, unsigned& nloc, unsigned& nx) {
    const unsigned G = gridDim.x * gridDim.y * gridDim.z;
    unsigned sum, cnt, mine, sp = 0u;
    for (;;) {
        sum = 0u; cnt = 0u; mine = 0u;
#pragma unroll
        for (unsigned j = 0; j < 16; ++j) { const unsigned c = xb_ld(&bar[XB_XCNT(j)]); sum += c; cnt += (c > 0u) ? 1u : 0u; mine = (j == x) ? c : mine; }
        if (sum == G) break;
        __builtin_amdgcn_s_sleep(1);
        if ((++sp & 255u) == 0u) { if (xb_ld(&bar[XB_TMO])) break; if (sp > XB_SPIN_CAP) { atomicAdd(&bar[XB_TMO], 1u); break; } }
    }
    nloc = mine > 0u ? mine : 1u; nx = cnt > 0u ? cnt : 1u;
}
__device__ __forceinline__ void xcd_barrier(const XcdBarrier& b) {
    asm volatile("s_waitcnt vmcnt(0)" ::: "memory");
    __syncthreads();
    if (threadIdx.x == 0) {
        unsigned* bar = b.bar;
        __builtin_amdgcn_s_waitcnt(0);
        unsigned nloc = b.st[0], nx = b.st[1];
        if (nloc == 0u) { xcd_barrier_complete(bar, b.x, nloc, nx); b.st[0] = nloc; b.st[1] = nx; }
        const unsigned old = xb_add(&bar[XB_XSUB(b.x)], 1u);
        const unsigned gen = old / nloc;
        if (old + 1u == (gen + 1u) * nloc) {
            __builtin_amdgcn_fence(__ATOMIC_RELEASE, "agent");
            asm volatile("s_waitcnt vmcnt(0)" ::: "memory");
            const unsigned og = xb_add(&bar[XB_TOP], 1u);
            const unsigned tg = og / nx;
            if (og + 1u == (tg + 1u) * nx) xb_add(&bar[XB_TOPGEN], 1u);
            else XB_SPIN(xb_ld(&bar[XB_TOPGEN]) == tg, bar);
            __builtin_amdgcn_fence(__ATOMIC_ACQUIRE, "agent");
            xb_add(&bar[XB_XGEN(b.x)], 1u);
            asm volatile("s_waitcnt vmcnt(0)" ::: "memory");
        } else {
            XB_SPIN(xb_ld(&bar[XB_XGEN(b.x)]) == gen, bar);
            __builtin_amdgcn_fence(__ATOMIC_ACQUIRE, "agent");
            asm volatile("s_waitcnt vmcnt(0)" ::: "memory");
        }
    }
    __syncthreads();
}

__device__ __forceinline__ void setup_ada_unit(const Params& p, int a, float* lds) {
    const int tid = ltid();
    const int l = a / 48, jb = (a % 48) * 128;
    float* scond = lds;
    float* part = lds + 3072;
    for (int i = tid; i < 3072; i += NTHR) {
        int n = i >> 10, k = i & 1023;
        float c = (n == 0) ? p.in[I_CCTX][k] : p.in[I_C][(n - 1) * 1024 + k];
        scond[i] = siluf_(c);
    }
    __syncthreads();
    const int lane = tid & 63, kg = tid >> 6;
    const float* w = p.in[I_ADAW] + (size_t)l * 1024 * 6144 + jb + lane * 2;
    float a0x = 0.f, a0y = 0.f, a1x = 0.f, a1y = 0.f, a2x = 0.f, a2y = 0.f;
#pragma unroll 1
    for (int k0 = 0; k0 < 128; k0 += 32) {
        float2 wv[32];
#pragma unroll
        for (int kk = 0; kk < 32; ++kk) { const f32x2 t_ = __builtin_nontemporal_load((const f32x2*)(w + (size_t)(kg * 128 + k0 + kk) * 6144)); wv[kk] = make_float2(t_[0], t_[1]); }
#pragma unroll
        for (int kk = 0; kk < 32; ++kk) {
            const int k = kg * 128 + k0 + kk;
            const float s0 = scond[k], s1 = scond[1024 + k], s2 = scond[2048 + k];
            a0x += s0 * wv[kk].x; a0y += s0 * wv[kk].y; a1x += s1 * wv[kk].x; a1y += s1 * wv[kk].y; a2x += s2 * wv[kk].x; a2y += s2 * wv[kk].y;
        }
    }
    float* pp = part + kg * 384 + lane * 2;
    pp[0] = a0x; pp[1] = a0y; pp[128] = a1x; pp[129] = a1y; pp[256] = a2x; pp[257] = a2y;
    __syncthreads();
    if (tid < 384) {
        const int n = tid >> 7, c2 = tid & 127;
        float sm = p.in[I_ADAB][l * 6144 + jb + c2];
#pragma unroll
        for (int g = 0; g < 8; ++g) sm += part[g * 384 + n * 128 + c2];
        float* mods = (float*)(p.ws + OFF_MODS);
        mods[(l * 3 + n) * 6144 + jb + c2] = sm;
    }
    __syncthreads();
}

__device__ __forceinline__ void setup_transpose_unit(const Params& p, int u, float* lds) {
    const int tid = ltid();
    const float* src; bf16_t* dst; int N, tiles_n, t, dstride = 1024;
    const bool gates = u >= 1424;
    const int i = u * 4;
    if (gates)         { t = 0; N = 64; tiles_n = 1; dstride = 64; src = p.in[I_RGWA]; dst = (bf16_t*)(p.ws + OFF_RGW) + (size_t)(i - 5696) * 4096; }
    else if (i < 1024) { int m = i / 512;          t = i % 512;          N = 2048; tiles_n = 32; src = p.in[I_RGWIN] + (size_t)m * 1024 * 2048;  dst = (bf16_t*)(p.ws + OFF_RGWIN) + (size_t)m * 2048 * 1024; }
    else if (i < 1536) { int m = (i - 1024) / 256; t = (i - 1024) % 256; N = 1024; tiles_n = 16; src = p.in[I_RGWOUT] + (size_t)m * 1024 * 1024; dst = (bf16_t*)(p.ws + OFF_RGWOUT) + (size_t)m * 1024 * 1024; }
    else if (i < 3136) { int m = (i - 1536) / 800; t = (i - 1536) % 800; N = 3104; tiles_n = 50; src = p.in[I_GLWIN] + (size_t)m * 1024 * 3104;  dst = (bf16_t*)(p.ws + OFF_GLWIN) + (size_t)m * 3200 * 1024; }
    else if (i < 3648) { int m = (i - 3136) / 256; t = (i - 3136) % 256; N = 1024; tiles_n = 16; src = p.in[I_GLWOUT] + (size_t)m * 1024 * 1024; dst = (bf16_t*)(p.ws + OFF_GLWOUT) + (size_t)m * 1024 * 1024; }
    else               { int m = (i - 3648) / 512; t = (i - 3648) % 512; N = 2048; tiles_n = 32; src = p.in[I_PWQ] + (size_t)m * 1024 * 2048;    dst = (bf16_t*)(p.ws + OFF_PWQ) + (size_t)m * 2048 * 1024; }
    const int mg = (i - 5696) >> 1;
    {
        const int k = tid >> 3, nc = (tid & 7) * 8;
        f32x4 v0[4], v1[4];
#pragma unroll
        for (int q = 0; q < 4; ++q) {
            const int tq = t + q, kt = tq / tiles_n, nt = tq % tiles_n;
            const float* sq = gates ? p.in[(q & 1) ? I_RGWI : I_RGWA] + (size_t)(mg + (q >> 1)) * 4096 : src;
            const int n = nt * 64 + nc;
            f32x4 z = {0.f, 0.f, 0.f, 0.f};
            v0[q] = z; v1[q] = z;
            if (n < N) {
                const f32x4* s4 = (const f32x4*)(sq + (size_t)((gates ? 0 : kt) * 64 + k) * N + n);
                v0[q] = __builtin_nontemporal_load(s4); v1[q] = __builtin_nontemporal_load(s4 + 1);
            }
        }
#pragma unroll
        for (int q = 0; q < 4; ++q) {
            float* tp = lds + q * 4160 + k * 65 + nc;
#pragma unroll
            for (int j = 0; j < 4; ++j) { tp[j] = v0[q][j]; tp[4 + j] = v1[q][j]; }
        }
    }
    __syncthreads();
    {
        const int n = tid >> 3, kc = (tid & 7) * 8;
#pragma unroll
        for (int q = 0; q < 4; ++q) {
            const int tq = t + q, kt = gates ? 0 : tq / tiles_n, nt = gates ? 0 : tq % tiles_n;
            bf16_t* dq = gates ? dst + (size_t)q * 4096 : dst;
            const float* tile = lds + q * 4160;
            float x[8];
#pragma unroll
            for (int j = 0; j < 8; ++j) x[j] = tile[(kc + j) * 65 + n];
            uint4 o; o.x = pack2(x[0], x[1]); o.y = pack2(x[2], x[3]); o.z = pack2(x[4], x[5]); o.w = pack2(x[6], x[7]);
            *(uint4*)(dq + (size_t)(nt * 64 + n) * dstride + kt * 64 + kc) = o;
        }
    }
    __syncthreads();
}

__device__ __forceinline__ void setup_convert_unit(const Params& p, int i, bool force = false) {
    const int tid = ltid();
    if (i < 256) {
        int side = i >> 7, ii = i & 127;
        size_t e = (size_t)ii * 4096;
        int l = (int)(e / 131072); size_t rest = e % 131072;
        const float* src = p.in[side ? I_PK2 : I_PK1] + e;
        bf16_t* dst = (bf16_t*)(p.ws + OFF_PK) + (size_t)l * 262144 + (size_t)side * 131072 + rest;
        const float4* s4 = (const float4*)(src + tid * 8);
        float4 v0 = s4[0], v1 = s4[1];
        uint4 o; o.x = pack2(v0.x, v0.y); o.y = pack2(v0.z, v0.w); o.z = pack2(v1.x, v1.y); o.w = pack2(v1.z, v1.w);
        *(uint4*)(dst + tid * 8) = o;
        return;
    }
    i -= 256;
    if (!force && gridDim.x == 256 && (i & 1023) >= 256) return;
    const int tab = i >> 10;
    const int lane = tid & 63, w = tid >> 6;
    const float* src = p.in[tab ? I_PV : I_PU];
    unsigned char* dst = p.ws + (tab ? OFF_PV : OFF_PU);
    float* sc = (float*)(p.ws + (tab ? OFF_SV : OFF_SU));
    const size_t rowbase = (size_t)(i & 1023) * 64 + w * 8;
    f32x4 v[8][4];
#pragma unroll
    for (int rr = 0; rr < 8; ++rr) {
        const float* rp = src + (rowbase + rr) * 1024;
#pragma unroll
        for (int q = 0; q < 4; ++q) v[rr][q] = __builtin_nontemporal_load((const f32x4*)(rp + q * 256 + lane * 4));
    }
#pragma unroll
    for (int rr = 0; rr < 8; ++rr) {
        float am = 0.f;
#pragma unroll
        for (int q = 0; q < 4; ++q) am = fmaxf(am, fmaxf(fmaxf(fabsf(v[rr][q][0]), fabsf(v[rr][q][1])), fmaxf(fabsf(v[rr][q][2]), fabsf(v[rr][q][3]))));
#pragma unroll
        for (int o = 32; o >= 1; o >>= 1) am = fmaxf(am, __shfl_xor(am, o));
        const float scale = am > 0.f ? am * (1.0f / 448.0f) : 1.0f;
        const float inv = 1.0f / scale;
        unsigned o4[4];
#pragma unroll
        for (int q = 0; q < 4; ++q) {
            int pk = 0;
            pk = __builtin_amdgcn_cvt_pk_fp8_f32(v[rr][q][0] * inv, v[rr][q][1] * inv, pk, false);
            pk = __builtin_amdgcn_cvt_pk_fp8_f32(v[rr][q][2] * inv, v[rr][q][3] * inv, pk, true);
            o4[q] = (unsigned)pk;
        }
        const size_t row = rowbase + rr;
        { const u32x4 ov = {o4[0], o4[1], o4[2], o4[3]}; __builtin_nontemporal_store(ov, (u32x4*)(dst + row * 1024 + lane * 16)); }
        if (lane == 0) sc[row] = scale;
    }
}

__device__ __forceinline__ void setup_xinit_unit(const Params& p, int i) {
    const int tid = ltid();
    const int row = i * 4 + (tid >> 7), d0 = (tid & 127) * 8;
    float* X = (float*)(p.ws + OFF_X);
    float v[8];
    if (row < 4096) {
        const f32x4* s4 = (const f32x4*)(p.in[I_XP] + (size_t)row * 1024 + d0);
        const f32x4 a_ = __builtin_nontemporal_load(s4), b_ = __builtin_nontemporal_load(s4 + 1);
        const float4 a = make_float4(a_[0], a_[1], a_[2], a_[3]), b = make_float4(b_[0], b_[1], b_[2], b_[3]);
        v[0] = a.x; v[1] = a.y; v[2] = a.z; v[3] = a.w; v[4] = b.x; v[5] = b.y; v[6] = b.z; v[7] = b.w;
    } else {
        const f32x4* s4 = (const f32x4*)(p.in[I_XS] + (size_t)(row - 4096) * 1024 + d0);
        const f32x4 a_ = __builtin_nontemporal_load(s4), b_ = __builtin_nontemporal_load(s4 + 1);
        const float4 a = make_float4(a_[0], a_[1], a_[2], a_[3]), b = make_float4(b_[0], b_[1], b_[2], b_[3]);
        v[0] = a.x; v[1] = a.y; v[2] = a.z; v[3] = a.w; v[4] = b.x; v[5] = b.y; v[6] = b.z; v[7] = b.w;
        int n = (row - 4096) & 1023;
        float r = (float)(n >> 6), cc = (float)(n & 63);
#pragma unroll
        for (int j = 0; j < 8; ++j) {
            int d = d0 + j; int q = d >> 8, fi = d & 255;
            float freq = exp2f(-13.287712379549449f * ((float)fi * (1.0f / 256.0f)));
            float ang = ((q < 2) ? r : cc) * freq;
            v[j] += (q & 1) ? __cosf(ang) : __sinf(ang);
        }
    }
    float4* o4 = (float4*)(X + (size_t)row * 1024 + d0);
    o4[0] = make_float4(v[0], v[1], v[2], v[3]); o4[1] = make_float4(v[4], v[5], v[6], v[7]);
}

__device__ __forceinline__ void phase_setup(const Params& p, float* lds) {
    constexpr int NA = 192, NB = (5696 + 128) / 4, NC = 256 + 2048, ND = 1536;
    constexpr int total = NA + NB + NC + ND;
    for (int u = blockIdx.x; u < total; u += gridDim.x) {
        if (u < NA) setup_ada_unit(p, u, lds);
        else if (u < NA + NB) setup_transpose_unit(p, u - NA, lds);
        else if (u < NA + NB + NC) setup_convert_unit(p, u - NA - NB);
        else setup_xinit_unit(p, u - NA - NB - NC);
    }
}

__device__ __forceinline__ void premod_store(const float* x  , float ss, const float* g, const float* mrow, int shift_i, int scale_i,
                                             bf16_t* Hrow, int lane) {
    const float rs = rsqrtf(ss * (1.0f / 1024.0f) + EPSV);
    unsigned pk[8];
#pragma unroll
    for (int hf = 0; hf < 2; ++hf) {
        const int d0 = hf * 512 + lane * 8;
        float4 g0 = *(const float4*)(g + d0), g1 = *(const float4*)(g + d0 + 4);
        float4 s0 = *(const float4*)(mrow + shift_i * 1024 + d0), s1 = *(const float4*)(mrow + shift_i * 1024 + d0 + 4);
        float4 c0 = *(const float4*)(mrow + scale_i * 1024 + d0), c1 = *(const float4*)(mrow + scale_i * 1024 + d0 + 4);
        float gg[8] = {g0.x, g0.y, g0.z, g0.w, g1.x, g1.y, g1.z, g1.w};
        float sh[8] = {s0.x, s0.y, s0.z, s0.w, s1.x, s1.y, s1.z, s1.w};
        float sc[8] = {c0.x, c0.y, c0.z, c0.w, c1.x, c1.y, c1.z, c1.w};
        float o[8];
#pragma unroll
        for (int j = 0; j < 8; ++j) o[j] = (x[hf * 8 + j] * rs * gg[j]) * (1.0f + sc[j]) + sh[j];
#pragma unroll
        for (int j = 0; j < 4; ++j) pk[hf * 4 + j] = pack2(o[2 * j], o[2 * j + 1]);
    }
    *(uint4*)(Hrow + lane * 8) = make_uint4(pk[0], pk[1], pk[2], pk[3]);
    *(uint4*)(Hrow + 512 + lane * 8) = make_uint4(pk[4], pk[5], pk[6], pk[7]);
}

__device__ __forceinline__ void phase_norm(const Params& p, int l, int which  ) {
    const int lane = ltid() & 63, w = ltid() >> 6;
    const float* X = (const float*)(p.ws + OFF_X);
    bf16_t* H = (bf16_t*)(p.ws + OFF_H);
    const float* mods = (const float*)(p.ws + OFF_MODS) + (size_t)l * 3 * 6144;
    const float* g = p.in[which ? I_N2G : I_N1G] + l * 1024;
    for (int row = blockIdx.x * 8 + w; row < TTOK; row += gridDim.x * 8) {
        const float* xr = X + (size_t)row * 1024;
        float x[16];
        float4 a = *(const float4*)(xr + lane * 8), b = *(const float4*)(xr + lane * 8 + 4);
        float4 c = *(const float4*)(xr + 512 + lane * 8), d = *(const float4*)(xr + 512 + lane * 8 + 4);
        x[0] = a.x; x[1] = a.y; x[2] = a.z; x[3] = a.w; x[4] = b.x; x[5] = b.y; x[6] = b.z; x[7] = b.w;
        x[8] = c.x; x[9] = c.y; x[10] = c.z; x[11] = c.w; x[12] = d.x; x[13] = d.y; x[14] = d.z; x[15] = d.w;
        float ss = 0.f;
#pragma unroll
        for (int j = 0; j < 16; ++j) ss += x[j] * x[j];
        ss = wave_sum(ss);
        premod_store(x, ss, g, mods + cond_of(row) * 6144, which ? 3 : 0, which ? 4 : 1, H + (size_t)row * 1024, lane);
    }
}

#define GT_STRIDE 72
#define GT_BUF (2 * 128 * GT_STRIDE)

#define GLOAD(RR, k0) { RR##0 = *(const u32x4*)(ap0 + (k0)); RR##1 = *(const u32x4*)(ap1 + (k0)); RR##2 = *(const u32x4*)(bp0 + (k0)); RR##3 = *(const u32x4*)(bp1 + (k0)); }
#define GWRITE(RR, buf) { bf16_t* dA = lds + (buf) * GT_BUF; bf16_t* dB = dA + 128 * GT_STRIDE; \
        *(u32x4*)(dA + r0 * GT_STRIDE + kc) = RR##0; *(u32x4*)(dA + (r0 + 64) * GT_STRIDE + kc) = RR##1; \
        *(u32x4*)(dB + r0 * GT_STRIDE + kc) = RR##2; *(u32x4*)(dB + (r0 + 64) * GT_STRIDE + kc) = RR##3; }
#define GCOMPUTE(buf) { const bf16_t* sA = lds + (buf) * GT_BUF; const bf16_t* sB = sA + 128 * GT_STRIDE; \
        _Pragma("unroll") for (int kk = 0; kk < 4; ++kk) { \
            bf16x8 a = *(const bf16x8*)(sA + arow * GT_STRIDE + kk * 16 + koff); \
            bf16x8 b0 = *(const bf16x8*)(sB + (wn * 64 + (lane & 31)) * GT_STRIDE + kk * 16 + koff); \
            bf16x8 b1 = *(const bf16x8*)(sB + (wn * 64 + 32 + (lane & 31)) * GT_STRIDE + kk * 16 + koff); \
            acc[0] = __builtin_amdgcn_mfma_f32_32x32x16_bf16(a, b0, acc[0], 0, 0, 0); \
            acc[1] = __builtin_amdgcn_mfma_f32_32x32x16_bf16(a, b1, acc[1], 0, 0, 0); } }
#define GSTEP_L(ks, RL, RW) { GLOAD(RL, ((ks) + 3) * 64); GCOMPUTE((ks) & 1); GWRITE(RW, ((ks) + 1) & 1); __syncthreads(); }
#define GSTEP_N(ks, RW)     { GCOMPUTE((ks) & 1); GWRITE(RW, ((ks) + 1) & 1); __syncthreads(); }

struct GemmRegs { u32x4 a0, a1, a2, a3, b0, b1, b2, b3, c0, c1, c2, c3; };
#define Ra0 R.a0
#define Ra1 R.a1
#define Ra2 R.a2
#define Ra3 R.a3
#define Rb0 R.b0
#define Rb1 R.b1
#define Rb2 R.b2
#define Rb3 R.b3
#define Rc0 R.c0
#define Rc1 R.c1
#define Rc2 R.c2
#define Rc3 R.c3
__device__ __forceinline__ void gemm_prefetch(const bf16_t* __restrict__ A, const bf16_t* __restrict__ Bt, int m0, int n0, GemmRegs& R) {
    const int tid = ltid();
    const int r0 = tid >> 3, kc = (tid & 7) * 8;
    const bf16_t* ap0 = A + (size_t)(m0 + r0) * 1024 + kc;
    const bf16_t* ap1 = A + (size_t)(m0 + r0 + 64) * 1024 + kc;
    const bf16_t* bp0 = Bt + (size_t)(n0 + r0) * 1024 + kc;
    const bf16_t* bp1 = Bt + (size_t)(n0 + r0 + 64) * 1024 + kc;
    GLOAD(Ra, 0); GLOAD(Rb, 64); GLOAD(Rc, 128);
}
__device__ __forceinline__ void gemm_mainloop(const bf16_t* __restrict__ A, const bf16_t* __restrict__ Bt, int m0, int n0,
                                              bf16_t* lds, f32x16 (&acc)[2], GemmRegs& R) {
    const int tid = ltid(), lane = tid & 63, w = tid >> 6;
    const int wm = w >> 1, wn = w & 1;
#pragma unroll
    for (int i = 0; i < 16; ++i) { acc[0][i] = 0.f; acc[1][i] = 0.f; }
    const int r0 = tid >> 3, kc = (tid & 7) * 8;
    const bf16_t* ap0 = A + (size_t)(m0 + r0) * 1024 + kc;
    const bf16_t* ap1 = A + (size_t)(m0 + r0 + 64) * 1024 + kc;
    const bf16_t* bp0 = Bt + (size_t)(n0 + r0) * 1024 + kc;
    const bf16_t* bp1 = Bt + (size_t)(n0 + r0 + 64) * 1024 + kc;
    GWRITE(Ra, 0);
    __syncthreads();
    const int arow = wm * 32 + (lane & 31), koff = (lane >> 5) * 8;
    GSTEP_L(0, Ra, Rb)  GSTEP_L(1, Rb, Rc)  GSTEP_L(2, Rc, Ra)
    GSTEP_L(3, Ra, Rb)  GSTEP_L(4, Rb, Rc)  GSTEP_L(5, Rc, Ra)
    GSTEP_L(6, Ra, Rb)  GSTEP_L(7, Rb, Rc)  GSTEP_L(8, Rc, Ra)
    GSTEP_L(9, Ra, Rb)  GSTEP_L(10, Rb, Rc) GSTEP_L(11, Rc, Ra)
    GSTEP_L(12, Ra, Rb) GSTEP_N(13, Rc)     GSTEP_N(14, Ra)
    { GCOMPUTE(1); __syncthreads(); }
}

#define G2_BUF (384 * GT_STRIDE)
struct Gemm2Regs { u32x4 a0, a1, a2, a3, a4, a5, b0, b1, b2, b3, b4, b5, c0, c1, c2, c3, c4, c5; };
#define G2LOAD(RR, k0) { R2.RR##0 = *(const u32x4*)(ap0 + (k0)); R2.RR##1 = *(const u32x4*)(ap0 + (size_t)64 * 1024 + (k0)); \
        R2.RR##2 = *(const u32x4*)(ap0 + (size_t)128 * 1024 + (k0)); R2.RR##3 = *(const u32x4*)(ap0 + (size_t)192 * 1024 + (k0)); \
        R2.RR##4 = *(const u32x4*)(bp0 + (k0)); R2.RR##5 = *(const u32x4*)(bp0 + (size_t)64 * 1024 + (k0)); }
#define G2WRITE(RR, buf) { bf16_t* dA = lds + (buf) * G2_BUF; bf16_t* dB = dA + 256 * GT_STRIDE; \
        *(u32x4*)(dA + r0 * GT_STRIDE + kc) = R2.RR##0; *(u32x4*)(dA + (r0 + 64) * GT_STRIDE + kc) = R2.RR##1; \
        *(u32x4*)(dA + (r0 + 128) * GT_STRIDE + kc) = R2.RR##2; *(u32x4*)(dA + (r0 + 192) * GT_STRIDE + kc) = R2.RR##3; \
        *(u32x4*)(dB + r0 * GT_STRIDE + kc) = R2.RR##4; *(u32x4*)(dB + (r0 + 64) * GT_STRIDE + kc) = R2.RR##5; }
#define G2COMPUTE(buf) { const bf16_t* sA = lds + (buf) * G2_BUF; const bf16_t* sB = sA + 256 * GT_STRIDE; \
        _Pragma("unroll") for (int kk = 0; kk < 4; ++kk) { \
            bf16x8 a0 = *(const bf16x8*)(sA + arow * GT_STRIDE + kk * 16 + koff); \
            bf16x8 a1 = *(const bf16x8*)(sA + (arow + 32) * GT_STRIDE + kk * 16 + koff); \
            bf16x8 b0 = *(const bf16x8*)(sB + brow * GT_STRIDE + kk * 16 + koff); \
            bf16x8 b1 = *(const bf16x8*)(sB + (brow + 32) * GT_STRIDE + kk * 16 + koff); \
            acc[0] = __builtin_amdgcn_mfma_f32_32x32x16_bf16(a0, b0, acc[0], 0, 0, 0); \
            acc[1] = __builtin_amdgcn_mfma_f32_32x32x16_bf16(a0, b1, acc[1], 0, 0, 0); \
            acc[2] = __builtin_amdgcn_mfma_f32_32x32x16_bf16(a1, b0, acc[2], 0, 0, 0); \
            acc[3] = __builtin_amdgcn_mfma_f32_32x32x16_bf16(a1, b1, acc[3], 0, 0, 0); } }
#define G2STEP_L(ks, RL, RW) { G2LOAD(RL, ((ks) + 3) * 64); G2COMPUTE((ks) & 1); G2WRITE(RW, ((ks) + 1) & 1); __syncthreads(); }
#define G2STEP_N(ks, RW)     { G2COMPUTE((ks) & 1); G2WRITE(RW, ((ks) + 1) & 1); __syncthreads(); }
__device__ __forceinline__ void gemm2_prefetch(const bf16_t* __restrict__ A, const bf16_t* __restrict__ Bt, int m0, int n0, Gemm2Regs& R2) {
    const int tid = ltid();
    const int r0 = tid >> 3, kc = (tid & 7) * 8;
    const bf16_t* ap0 = A + (size_t)(m0 + r0) * 1024 + kc;
    const bf16_t* bp0 = Bt + (size_t)(n0 + r0) * 1024 + kc;
    G2LOAD(a, 0); G2LOAD(b, 64); G2LOAD(c, 128);
}
__device__ __forceinline__ void gemm2_mainloop(const bf16_t* __restrict__ A, const bf16_t* __restrict__ Bt, int m0, int n0,
                                               bf16_t* lds, f32x16 (&acc)[4], Gemm2Regs& R2) {
    const int tid = ltid(), lane = tid & 63, w = tid >> 6;
    const int wm = w >> 1, wn = w & 1;
#pragma unroll
    for (int i = 0; i < 16; ++i) { acc[0][i] = 0.f; acc[1][i] = 0.f; acc[2][i] = 0.f; acc[3][i] = 0.f; }
    const int r0 = tid >> 3, kc = (tid & 7) * 8;
    const bf16_t* ap0 = A + (size_t)(m0 + r0) * 1024 + kc;
    const bf16_t* bp0 = Bt + (size_t)(n0 + r0) * 1024 + kc;
    G2WRITE(a, 0);
    __syncthreads();
    const int arow = wm * 64 + (lane & 31), brow = wn * 64 + (lane & 31), koff = (lane >> 5) * 8;
    G2STEP_L(0, a, b)  G2STEP_L(1, b, c)  G2STEP_L(2, c, a)
    G2STEP_L(3, a, b)  G2STEP_L(4, b, c)  G2STEP_L(5, c, a)
    G2STEP_L(6, a, b)  G2STEP_L(7, b, c)  G2STEP_L(8, c, a)
    G2STEP_L(9, a, b)  G2STEP_L(10, b, c) G2STEP_L(11, c, a)
    G2STEP_L(12, a, b) G2STEP_N(13, c)    G2STEP_N(14, a)
    { G2COMPUTE(1); __syncthreads(); }
}

#define ACC_ROW(wm, lane, r) ((wm) * 32 + ((r) & 3) + 8 * ((r) >> 2) + 4 * ((lane) >> 5))
#define ACC_COL(wn, lane, nt) ((wn) * 64 + (nt) * 32 + ((lane) & 31))

enum { EPI_RGIN = 0, EPI_GLAIN = 1, EPI_OUT = 2 };

__device__ __forceinline__ void phase_gemm(const Params& p, int l, int kind, float* ldsf, bool dry = false) {
    bf16_t* lds = (bf16_t*)ldsf;
    const int lane = ltid() & 63, w = ltid() >> 6, wm = w >> 1, wn = w & 1;
    const int jl = l >> 1;
    const bf16_t* A; const bf16_t* Bt; int ntn, N;
    float* PB = (float*)(p.ws + OFF_PB);
    float* X = (float*)(p.ws + OFF_X);
    if (kind == EPI_RGIN)       { A = (const bf16_t*)(p.ws + OFF_H); Bt = (const bf16_t*)(p.ws + OFF_RGWIN) + (size_t)jl * 2048 * 1024; ntn = 16; N = 2048; }
    else if (kind == EPI_GLAIN) { A = (const bf16_t*)(p.ws + OFF_H); Bt = (const bf16_t*)(p.ws + OFF_GLWIN) + (size_t)jl * 3200 * 1024; ntn = 25; N = 3104; }
    else { A = (const bf16_t*)(p.ws + OFF_Y); Bt = (l & 1) ? (const bf16_t*)(p.ws + OFF_GLWOUT) + (size_t)jl * 1024 * 1024 : (const bf16_t*)(p.ws + OFF_RGWOUT) + (size_t)jl * 1024 * 1024; ntn = 8; N = 1024; }
    const float* mods = (const float*)(p.ws + OFF_MODS) + (size_t)l * 3 * 6144;
    if (kind != EPI_RGIN) {
        const int ntn2 = (kind == EPI_GLAIN) ? 21 : ntn;
        const int ntiles2 = 24 * ntn2;
        Gemm2Regs R2;
        if ((int)blockIdx.x < ntiles2) gemm2_prefetch(A, Bt, ((int)blockIdx.x % 24) * 256, ((int)blockIdx.x / 24) * 128, R2);
#pragma unroll 1
        for (int t = blockIdx.x; t < ntiles2; t += gridDim.x) {
            const int m0 = (t % 24) * 256, n0 = (t / 24) * 128;
            f32x16 acc[4];
            gemm2_mainloop(A, Bt, m0, n0, lds, acc, R2);
            { const int tn = t + gridDim.x; if (tn < ntiles2) gemm2_prefetch(A, Bt, (tn % 24) * 256, (tn / 24) * 128, R2); }
            const int cnd = cond_of(m0);
#pragma unroll
            for (int q = 0; q < 4; ++q) {
                const int col = n0 + wn * 64 + (q & 1) * 32 + (lane & 31);
                const float gate = (kind == EPI_OUT) ? mods[cnd * 6144 + 2 * 1024 + col] : 0.f;
#pragma unroll
                for (int r = 0; r < 16; ++r) {
                    const int row = m0 + (w >> 1) * 64 + (q >> 1) * 32 + (r & 3) + 8 * (r >> 2) + 4 * (lane >> 5);
                    float v = acc[q][r];
                    if (kind == EPI_GLAIN) {
                        if (col < 512) v *= 0.08838834764831845f;
                        if (col < N) PB[(size_t)row * 3104 + col] = v;
                    } else {
                        float* Xo = dry ? PB : X;
                        Xo[(size_t)row * 1024 + col] = X[(size_t)row * 1024 + col] + gate * v;
                    }
                }
            }
        }
        if (kind == EPI_OUT) {
            if (!dry && gridDim.x == 256 && l < 3 && (int)blockIdx.x >= 192) {
#pragma unroll 1
                for (int k = 0; k < 3; ++k) setup_convert_unit(p, 256 + (l + 1) * 256 + ((int)blockIdx.x - 192) * 3 + k, true);
            }
            return;
        }
    }
    const int ntb = (kind == EPI_GLAIN) ? 21 : 0;
    const int ntiles = 48 * (ntn - ntb);
    GemmRegs R;
    if ((int)blockIdx.x < ntiles) gemm_prefetch(A, Bt, ((int)blockIdx.x % 48) * 128, (ntb + (int)blockIdx.x / 48) * 128, R);
#pragma unroll 1
    for (int t = blockIdx.x; t < ntiles; t += gridDim.x) {
        const int mt = t % 48, nt_ = ntb + t / 48;
        const int m0 = mt * 128, n0 = nt_ * 128;
        f32x16 acc[2];
        gemm_mainloop(A, Bt, m0, n0, lds, acc, R);
        { const int tn = t + gridDim.x; if (tn < ntiles) gemm_prefetch(A, Bt, (tn % 48) * 128, (ntb + tn / 48) * 128, R); }
#pragma unroll
        for (int nt = 0; nt < 2; ++nt) {
#pragma unroll
            for (int r = 0; r < 16; ++r) {
                const int row = m0 + ACC_ROW(wm, lane, r), col = n0 + ACC_COL(wn, lane, nt);
                float v = acc[nt][r];
                if (kind == EPI_RGIN) {
                    if (col < 1024) v = gelu_tanh(v);
                    PB[(size_t)row * 2048 + col] = v;
                } else if (kind == EPI_GLAIN) {
                    if (col < 512) v *= 0.08838834764831845f;
                    if (col < N) PB[(size_t)row * 3104 + col] = v;
                } else {
                    const float gate = mods[cond_of(row) * 6144 + 2 * 1024 + col];
                    float* Xo = dry ? PB : X;
                    Xo[(size_t)row * 1024 + col] = X[(size_t)row * 1024 + col] + gate * v;
                }
            }
        }
    }
}

__device__ __forceinline__ void phase_peerq(const Params& p, int l, float* ldsf) {
    bf16_t* lds = (bf16_t*)ldsf;
    const int tid = ltid(), lane = tid & 63, w = tid >> 6, wm = w >> 1, wn = w & 1;
    const bf16_t* A = (const bf16_t*)(p.ws + OFF_H);
    const bf16_t* Bt = (const bf16_t*)(p.ws + OFF_PWQ) + (size_t)l * 2048 * 1024;
    const bf16_t* PK = (const bf16_t*)(p.ws + OFF_PK) + (size_t)l * 262144;
    float* TK = (float*)(p.ws + OFF_TK);
    bf16_t* Qs = lds;
    float* Ss = ldsf + (128 * 136 * 2) / 4;
    GemmRegs R;
    if ((int)blockIdx.x < 768) gemm_prefetch(A, Bt, ((int)blockIdx.x % 48) * 128, ((int)blockIdx.x / 48) * 128, R);
#pragma unroll 1
    for (int t = blockIdx.x; t < 48 * 16; t += gridDim.x) {
        const int mt = t % 48, nt_ = t / 48;
        const int m0 = mt * 128, n0 = nt_ * 128;
        const int h = nt_ >> 1, side = nt_ & 1;
        f32x16 acc[2];
        gemm_mainloop(A, Bt, m0, n0, lds, acc, R);
        { const int tn = t + gridDim.x; if (tn < 768) gemm_prefetch(A, Bt, (tn % 48) * 128, (tn / 48) * 128, R); }
#pragma unroll
        for (int nt = 0; nt < 2; ++nt)
#pragma unroll
            for (int r = 0; r < 16; ++r)
                Qs[ACC_ROW(wm, lane, r) * 136 + ACC_COL(wn, lane, nt)] = (bf16_t)f2bf(acc[nt][r]);
        __syncthreads();
        const bf16_t* kp = PK + (size_t)(side * 8 + h) * 16384;
#pragma unroll
        for (int i = 0; i < 16; ++i) { acc[0][i] = 0.f; acc[1][i] = 0.f; }
#pragma unroll
        for (int kk = 0; kk < 8; ++kk) {
            bf16x8 a = *(const bf16x8*)(Qs + (wm * 32 + (lane & 31)) * 136 + kk * 16 + (lane >> 5) * 8);
            bf16x8 b0 = *(const bf16x8*)(kp + (wn * 64 + (lane & 31)) * 128 + kk * 16 + (lane >> 5) * 8);
            bf16x8 b1 = *(const bf16x8*)(kp + (wn * 64 + 32 + (lane & 31)) * 128 + kk * 16 + (lane >> 5) * 8);
            acc[0] = __builtin_amdgcn_mfma_f32_32x32x16_bf16(a, b0, acc[0], 0, 0, 0);
            acc[1] = __builtin_amdgcn_mfma_f32_32x32x16_bf16(a, b1, acc[1], 0, 0, 0);
        }
#pragma unroll
        for (int nt = 0; nt < 2; ++nt)
#pragma unroll
            for (int r = 0; r < 16; ++r)
                Ss[ACC_ROW(wm, lane, r) * 129 + ACC_COL(wn, lane, nt)] = acc[nt][r];
        __syncthreads();
        {
            const int row = tid & 127, part = tid >> 7;
            float v[16];
#pragma unroll
            for (int j = 0; j < 16; ++j) v[j] = -3.0e38f;
            const float* sr = Ss + row * 129 + part * 32;
#pragma unroll 4
            for (int n = 0; n < 32; ++n) {
                float x = __uint_as_float((__float_as_uint(sr[n]) & 0xffffff80u) | (unsigned)(part * 32 + n));
#pragma unroll
                for (int j = 15; j >= 1; --j) v[j] = __builtin_amdgcn_fmed3f(x, v[j - 1], v[j]);
                v[0] = fmaxf(x, v[0]);
            }
            float* mg = ldsf;
#define TOPK_MERGE() { \
                _Pragma("unroll") for (int j = 0; j < 16; ++j) v[j] = fmaxf(v[j], o[15 - j]); \
                _Pragma("unroll") for (int dd = 8; dd >= 1; dd >>= 1) { \
                    _Pragma("unroll") for (int i = 0; i < 16; ++i) { if ((i & dd) == 0) { const float hi_ = fmaxf(v[i], v[i + dd]), lo_ = fminf(v[i], v[i + dd]); v[i] = hi_; v[i + dd] = lo_; } } } }
            __syncthreads();
            if (part & 1) {
#pragma unroll
                for (int j = 0; j < 16; ++j) mg[((part >> 1) * 128 + row) * 17 + j] = v[j];
            }
            __syncthreads();
            if (!(part & 1)) {
                float o[16];
#pragma unroll
                for (int j = 0; j < 16; ++j) o[j] = mg[((part >> 1) * 128 + row) * 17 + j];
                TOPK_MERGE()
            }
            __syncthreads();
            if (part == 2) {
#pragma unroll
                for (int j = 0; j < 16; ++j) mg[row * 17 + j] = v[j];
            }
            __syncthreads();
            if (part == 0) {
                float o[16];
#pragma unroll
                for (int j = 0; j < 16; ++j) o[j] = mg[row * 17 + j];
                TOPK_MERGE()
                float4* og = (float4*)(TK + ((size_t)(m0 + row) * 16 + h * 2 + side) * 16);
                og[0] = make_float4(v[0], v[1], v[2], v[3]); og[1] = make_float4(v[4], v[5], v[6], v[7]);
                og[2] = make_float4(v[8], v[9], v[10], v[11]); og[3] = make_float4(v[12], v[13], v[14], v[15]);
            }
        }
        __syncthreads();
    }
}

__device__ __forceinline__ void conv_row(int l, int gw, int st, int& tab, int& r) {
    const int rid = 12288 + gw * 10 + st; tab = rid >> 14; r = (l + 1) * 16384 + (rid & 16383);
}
__device__ __forceinline__ void phase_peer_gather(const Params& p, int l, float* ldsf, bool dry = false) {
    const int tid = ltid(), lane = tid & 63, w = tid >> 6;
    int* eidL = (int*)ldsf;
    float* gateL = ldsf + 24 * 128;
    float* suL = ldsf + 48 * 128;
    float* wL = ldsf + 72 * 128 + w * 384;
    int* cntL = (int*)(ldsf + 96 * 128);
    int* baseL = cntL + 192 * 16;
    int* eidU = baseL + 24 * 16;
    float* gateU = (float*)(eidU + 24 * 128);
    const float* TK = (const float*)(p.ws + OFF_TK);
    float* X = (float*)(p.ws + OFF_X);
    bf16_t* H = (bf16_t*)(p.ws + OFF_H);
    float* Xw = dry ? (float*)(p.ws + OFF_PB) : X;
    bf16_t* Hw = dry ? (bf16_t*)(p.ws + OFF_PB + (size_t)TTOK * DM * 4) : H;
    float* Yw = dry ? (float*)(p.ws + OFF_PB) : p.out + OUT_Y;
    const unsigned char* PU = p.ws + OFF_PU + (size_t)l * 16384 * 1024;
    const unsigned char* PV = p.ws + OFF_PV + (size_t)l * 16384 * 1024;
    const float* SU = (const float*)(p.ws + OFF_SU) + l * 16384;
    const float* SV = (const float*)(p.ws + OFF_SV) + l * 16384;
    const float* mods = (const float*)(p.ws + OFF_MODS) + (size_t)l * 3 * 6144;
    for (int sg = blockIdx.x; sg < 256; sg += gridDim.x) {
        const int t0 = sg * 24;
        const bool defer = (l < 3) && (gridDim.x == 256) && !dry;
        f32x4 cv0, cv1, cv2, cv3;
        cv0 = cv1 = cv2 = cv3 = (f32x4){0.f, 0.f, 0.f, 0.f};
#define CONV_ISSUE(st_) { if (defer) { int tab_, r_; conv_row(l, (int)blockIdx.x * 8 + w, (st_), tab_, r_); \
            const float* src_ = p.in[tab_ ? I_PV : I_PU] + (size_t)r_ * 1024 + lane * 4; \
            cv0 = __builtin_nontemporal_load((const f32x4*)src_); cv1 = __builtin_nontemporal_load((const f32x4*)(src_ + 256)); \
            cv2 = __builtin_nontemporal_load((const f32x4*)(src_ + 512)); cv3 = __builtin_nontemporal_load((const f32x4*)(src_ + 768)); } }
#define CONV_Q(v_) ({ int pk_ = 0; pk_ = __builtin_amdgcn_cvt_pk_fp8_f32((v_)[0] * inv_, (v_)[1] * inv_, pk_, false); \
            pk_ = __builtin_amdgcn_cvt_pk_fp8_f32((v_)[2] * inv_, (v_)[3] * inv_, pk_, true); (unsigned)pk_; })
#define CONV_AM(v_) fmaxf(fmaxf(fabsf((v_)[0]), fabsf((v_)[1])), fmaxf(fabsf((v_)[2]), fabsf((v_)[3])))
#define CONV_FINISH(st_) { if (defer) { int tab_, r_; conv_row(l, (int)blockIdx.x * 8 + w, (st_), tab_, r_); \
            float am_ = fmaxf(fmaxf(CONV_AM(cv0), CONV_AM(cv1)), fmaxf(CONV_AM(cv2), CONV_AM(cv3))); \
            _Pragma("unroll") for (int o_ = 32; o_ >= 1; o_ >>= 1) am_ = fmaxf(am_, __shfl_xor(am_, o_)); \
            const float scale_ = am_ > 0.f ? am_ * (1.0f / 448.0f) : 1.0f; const float inv_ = 1.0f / scale_; \
            const u32x4 ov_ = {CONV_Q(cv0), CONV_Q(cv1), CONV_Q(cv2), CONV_Q(cv3)}; \
            __builtin_nontemporal_store(ov_, (u32x4*)(p.ws + (tab_ ? OFF_PV : OFF_PU) + (size_t)r_ * 1024 + lane * 16)); \
            if (lane == 0) ((float*)(p.ws + (tab_ ? OFF_SV : OFF_SU)))[r_] = scale_; } }
        f32x2 xf2[3][8];
#pragma unroll
        for (int tt = 0; tt < 3; ++tt) {
            const int tok = t0 + w + tt * 8;
#pragma unroll
            for (int q = 0; q < 4; ++q) {
                uint2 hv = *(const uint2*)(H + (size_t)tok * 1024 + q * 256 + lane * 4);
                xf2[tt][q * 2] = (f32x2){bflo(hv.x), bfhi(hv.x)}; xf2[tt][q * 2 + 1] = (f32x2){bflo(hv.y), bfhi(hv.y)};
            }
        }
        __syncthreads();
        const int ctl = tid >> 3, ch = tid & 7;
        if (tid < 192) {
            const float* tk = TK + ((size_t)(t0 + ctl) * 16 + ch * 2) * 16;
            float v1[16], v2[16];
#pragma unroll
            for (int j = 0; j < 4; ++j) {
                float4 a = *(const float4*)(tk + j * 4), b = *(const float4*)(tk + 16 + j * 4);
                v1[j * 4] = a.x; v1[j * 4 + 1] = a.y; v1[j * 4 + 2] = a.z; v1[j * 4 + 3] = a.w;
                v2[j * 4] = b.x; v2[j * 4 + 1] = b.y; v2[j * 4 + 2] = b.z; v2[j * 4 + 3] = b.w;
            }
            int* idxL = (int*)(gateU + 24 * 128) + tid * 32;
#pragma unroll
            for (int j = 0; j < 16; ++j) {
                idxL[j] = (int)(__float_as_uint(v1[j]) & 127u); idxL[16 + j] = (int)(__float_as_uint(v2[j]) & 127u);
                v1[j] = __uint_as_float(__float_as_uint(v1[j]) & 0xffffff80u);
                v2[j] = __uint_as_float(__float_as_uint(v2[j]) & 0xffffff80u);
            }
            float top[16];
#pragma unroll
            for (int j = 0; j < 16; ++j) top[j] = -3.0e38f;
#pragma unroll
            for (int a = 0; a < 16; ++a) {
#pragma unroll
                for (int b = 0; b < 16; ++b) {
                    if ((a + 1) * (b + 1) <= 16) {
                        float sm = v1[a] + v2[b];
                        float x = __uint_as_float((__float_as_uint(sm) & 0xffffff00u) | (unsigned)(a * 16 + b));
#pragma unroll
                        for (int j = 15; j >= 1; --j) top[j] = __builtin_amdgcn_fmed3f(x, top[j - 1], top[j]);
                        top[0] = fmaxf(x, top[0]);
                    }
                }
            }
            const float mx = __uint_as_float(__float_as_uint(top[0]) & 0xffffff00u);
            float gg[16]; float sum = 0.f;
#pragma unroll
            for (int j = 0; j < 16; ++j) {
                float sv = __uint_as_float(__float_as_uint(top[j]) & 0xffffff00u);
                gg[j] = __expf(sv - mx); sum += gg[j];
            }
            const float inv = 1.0f / sum;
            int* myc = cntL + tid * 16;
#pragma unroll
            for (int b = 0; b < 16; ++b) myc[b] = 0;
            int eu[16];
#pragma unroll
            for (int j = 0; j < 16; ++j) {
                const unsigned ab = __float_as_uint(top[j]) & 0xffu;
                const int e = idxL[ab >> 4] * 128 + idxL[16 + (ab & 15u)];
                const int b = e >> 10;
                const int r = myc[b]; myc[b] = r + 1;
                eu[j] = e | (r << 16);
            }
#pragma unroll
            for (int j = 0; j < 16; ++j) { eidU[ctl * 128 + ch * 16 + j] = eu[j]; }
#pragma unroll
            for (int j = 0; j < 16; ++j) gg[j] *= inv;
#pragma unroll
            for (int j = 0; j < 16; ++j) gateU[ctl * 128 + ch * 16 + j] = gg[j];
        }
        __syncthreads();
        if (tid < 384) {
            const int tl = tid >> 4, b = tid & 15;
            int run = 0;
#pragma unroll
            for (int hh = 0; hh < 8; ++hh) { int* c = cntL + (tl * 8 + hh) * 16 + b; const int v = *c; *c = run; run += v; }
            baseL[tl * 16 + b] = run;
        }
        __syncthreads();
        if (tid < 24) {
            int run = 0;
#pragma unroll
            for (int b = 0; b < 16; ++b) { const int v = baseL[tid * 16 + b]; baseL[tid * 16 + b] = run; run += v; }
        }
        __syncthreads();
        if (tid < 192) {
#pragma unroll 4
            for (int j = 0; j < 16; ++j) {
                const int pk = eidU[ctl * 128 + ch * 16 + j];
                const int e = pk & 0xffff, r = pk >> 16, b = e >> 10;
                const int pos = baseL[ctl * 16 + b] + cntL[tid * 16 + b] + r;
                eidL[ctl * 128 + pos] = e;
                gateL[ctl * 128 + pos] = gateU[ctl * 128 + ch * 16 + j] * SV[e];
                suL[ctl * 128 + pos] = SU[e];
            }
        }
        __syncthreads();
        int ecur[3][8];
#pragma unroll
        for (int tt = 0; tt < 3; ++tt)
#pragma unroll
            for (int j = 0; j < 8; ++j) ecur[tt][j] = __builtin_amdgcn_readfirstlane(eidL[(w + tt * 8) * 128 + j]);
#pragma unroll 1
        for (int bt = 0; bt < 16; ++bt) {
            u32x4 ua[3][8];
#pragma unroll
            for (int tt = 0; tt < 3; ++tt) {
#pragma unroll
                for (int j = 0; j < 8; ++j) ua[tt][j] = *(const u32x4*)(PU + (size_t)ecur[tt][j] * 1024 + lane * 16);
            }
            {
                const int bn = (bt + 1) & 15;
#pragma unroll
                for (int tt = 0; tt < 3; ++tt)
#pragma unroll
                    for (int j = 0; j < 8; ++j) ecur[tt][j] = __builtin_amdgcn_readfirstlane(eidL[(w + tt * 8) * 128 + bn * 8 + j]);
            }
#pragma unroll
            for (int tt = 0; tt < 3; ++tt) {
                const int tl = w + tt * 8;
                float pp[8];
#pragma unroll
                for (int j = 0; j < 8; ++j) {
                    f32x2 sv = {0.f, 0.f};
#pragma unroll
                    for (int q = 0; q < 4; ++q) {
                        f32x2 lo = __builtin_amdgcn_cvt_pk_f32_fp8((int)ua[tt][j][q], false);
                        f32x2 hi = __builtin_amdgcn_cvt_pk_f32_fp8((int)ua[tt][j][q], true);
                        sv = xf2[tt][q * 2] * lo + sv;
                        sv = xf2[tt][q * 2 + 1] * hi + sv;
                    }
                    pp[j] = sv[0] + sv[1];
                }
                float q4[4], q2[2], s1;
                {
                    const bool hi = (lane & 32) != 0;
#pragma unroll
                    for (int i = 0; i < 4; ++i) { float a = pp[2 * i], b = pp[2 * i + 1]; float send = hi ? a : b, keep = hi ? b : a; q4[i] = keep + __shfl_xor(send, 32); }
                }
                {
                    const bool hi = (lane & 16) != 0;
#pragma unroll
                    for (int i = 0; i < 2; ++i) { float a = q4[2 * i], b = q4[2 * i + 1]; float send = hi ? a : b, keep = hi ? b : a; q2[i] = keep + __shfl_xor(send, 16); }
                }
                {
                    const bool hi = (lane & 8) != 0;
                    float a = q2[0], b = q2[1]; float send = hi ? a : b, keep = hi ? b : a; s1 = keep + __shfl_xor(send, 8);
                }
                s1 += __shfl_xor(s1, 4); s1 += __shfl_xor(s1, 2); s1 += __shfl_xor(s1, 1);
                const int jj = ((lane >> 5) & 1) + 2 * ((lane >> 4) & 1) + 4 * ((lane >> 3) & 1);
                if ((lane & 7) == 0) wL[tt * 128 + bt * 8 + jj] = gateL[tl * 128 + bt * 8 + jj] * gelu_tanh(s1 * suL[tl * 128 + bt * 8 + jj]);
            }
        }
        f32x2 acc2[3][8];
#pragma unroll
        for (int tt = 0; tt < 3; ++tt)
#pragma unroll
            for (int j = 0; j < 8; ++j) acc2[tt][j] = (f32x2){0.f, 0.f};
        CONV_ISSUE(0)
#pragma unroll 1
        for (int bt = 0; bt < 16; ++bt) {
            u32x4 va[3][8];
#pragma unroll
            for (int tt = 0; tt < 3; ++tt) {
#pragma unroll
                for (int j = 0; j < 8; ++j) va[tt][j] = *(const u32x4*)(PV + (size_t)ecur[tt][j] * 1024 + lane * 16);
            }
            {
                const int bn = (bt + 1) & 15;
#pragma unroll
                for (int tt = 0; tt < 3; ++tt)
#pragma unroll
                    for (int j = 0; j < 8; ++j) ecur[tt][j] = __builtin_amdgcn_readfirstlane(eidL[(w + tt * 8) * 128 + bn * 8 + j]);
            }
#pragma unroll
            for (int tt = 0; tt < 3; ++tt) {
#pragma unroll
                for (int j = 0; j < 8; ++j) {
                    const float wj = wL[tt * 128 + bt * 8 + j];
                    const f32x2 wj2 = {wj, wj};
#pragma unroll
                    for (int q = 0; q < 4; ++q) {
                        f32x2 lo = __builtin_amdgcn_cvt_pk_f32_fp8((int)va[tt][j][q], false);
                        f32x2 hi = __builtin_amdgcn_cvt_pk_f32_fp8((int)va[tt][j][q], true);
                        acc2[tt][q * 2] = wj2 * lo + acc2[tt][q * 2];
                        acc2[tt][q * 2 + 1] = wj2 * hi + acc2[tt][q * 2 + 1];
                    }
                }
            }
            if (bt < 10) CONV_FINISH(bt)
            if (bt + 1 < 10) CONV_ISSUE(bt + 1)
        }
        int oz2 = 0; asm volatile("" : "+v"(oz2));
#pragma unroll
        for (int tt = 0; tt < 3; ++tt) {
            const int lane = (ltid() & 63) + oz2, w = (ltid() >> 6) + oz2;
            const int tok = t0 + w + tt * 8;
            float* xr = X + (size_t)tok * 1024;
            const float* m5 = mods + cond_of(tok) * 6144 + 5 * 1024;
            float x[16];
#pragma unroll
            for (int q = 0; q < 4; ++q) {
                float4 a = *(const float4*)(xr + q * 256 + lane * 4);
                float4 g = *(const float4*)(m5 + q * 256 + lane * 4);
                x[q * 4] = a.x + g.x * acc2[tt][q * 2][0]; x[q * 4 + 1] = a.y + g.y * acc2[tt][q * 2][1];
                x[q * 4 + 2] = a.z + g.z * acc2[tt][q * 2 + 1][0]; x[q * 4 + 3] = a.w + g.w * acc2[tt][q * 2 + 1][1];
            }
            float ss = 0.f;
#pragma unroll
            for (int j = 0; j < 16; ++j) ss += x[j] * x[j];
            ss = wave_sum(ss);
            const float rs = rsqrtf(ss * (1.0f / 1024.0f) + EPSV);
            if (l < 3) {
                float* xw = Xw + (size_t)tok * 1024;
                const float* modn = (const float*)(p.ws + OFF_MODS) + (size_t)(l + 1) * 3 * 6144 + cond_of(tok) * 6144;
                const float* g1 = p.in[I_N1G] + (l + 1) * 1024;
                bf16_t* hw = Hw + (size_t)tok * 1024;
#pragma unroll
                for (int q = 0; q < 4; ++q) {
                    const int d0 = q * 256 + lane * 4;
                    *(float4*)(xw + d0) = make_float4(x[q * 4], x[q * 4 + 1], x[q * 4 + 2], x[q * 4 + 3]);
                    float4 g = *(const float4*)(g1 + d0), sh = *(const float4*)(modn + d0), sc = *(const float4*)(modn + 1024 + d0);
                    float o0 = (x[q * 4] * rs * g.x) * (1.0f + sc.x) + sh.x, o1 = (x[q * 4 + 1] * rs * g.y) * (1.0f + sc.y) + sh.y;
                    float o2 = (x[q * 4 + 2] * rs * g.z) * (1.0f + sc.z) + sh.z, o3 = (x[q * 4 + 3] * rs * g.w) * (1.0f + sc.w) + sh.w;
                    *(uint2*)(hw + d0) = make_uint2(pack2(o0, o1), pack2(o2, o3));
                }
            } else {
                const float* g = p.in[I_FNG];
                float* yo = Yw + (size_t)tok * 1024;
#pragma unroll
                for (int q = 0; q < 4; ++q) {
                    const int d0 = q * 256 + lane * 4;
                    float4 g0 = *(const float4*)(g + d0);
                    *(float4*)(yo + d0) = make_float4(x[q * 4] * rs * g0.x, x[q * 4 + 1] * rs * g0.y, x[q * 4 + 2] * rs * g0.z, x[q * 4 + 3] * rs * g0.w);
                }
            }
        }
    }
}

#define RG_XS 68
#define RG_RS 257
__device__ __forceinline__ void rg_unit(const Params& p, int l, int seq, int n, int ct, float* lds) {
    const int tid0 = ltid(), lane0 = tid0 & 63, w0 = tid0 >> 6;
    const int jl = l >> 1;
    const int L = seq < 16 ? 256 : 1024;
    const int tokbase = seq < 16 ? seq * 256 : 4096 + (seq - 16) * 1024;
    const int nsteps = L >> 8;
    const int cbase = n * 64, obase = cbase + ct * 32;
    float* xr = lds;
    float* aS = lds + 256 * RG_XS;
    float* bS = aS + 32 * RG_RS;
    float* segA = bS + 32 * RG_RS;
    float* segB = segA + 512;
    bf16_t* wS = (bf16_t*)(segB + 512);
    const float* PB = (const float*)(p.ws + OFF_PB);
    float* HF = (float*)(p.ws + OFF_HF);
    bf16_t* Y = (bf16_t*)(p.ws + OFF_Y);
    const int cg0 = tid0 & 15, tr0 = tid0 >> 4;
    f32x4 cwv[4]; f32x4 cbv;
    {
        const float* cw = p.in[I_RGCW] + jl * 4096 + cbase + cg0 * 4;
#pragma unroll
        for (int j = 0; j < 4; ++j) cwv[j] = *(const f32x4*)(cw + j * 1024);
        cbv = *(const f32x4*)(p.in[I_RGCB] + jl * 1024 + cbase + cg0 * 4);
    }
    const int sc0 = tid0 & 31, sg0 = tid0 >> 5;
    f32x4 rw[11];
#define RG_ISSUE(pb_) { const int pos0_ = (pb_) + tr * 8 - 2; \
        _Pragma("unroll") for (int j = 0; j < 11; ++j) { const int pp_ = pos0_ + j; \
            f32x4 z_ = {0.f, 0.f, 0.f, 0.f}; if (pp_ >= 0 && pp_ < L) z_ = *(const f32x4*)(PB + (size_t)(tokbase + pp_) * 2048 + 1024 + cbase + cg * 4); rw[j] = z_; } }
    { const int tr = tr0, cg = cg0; RG_ISSUE(0) }
    float hfreg[16];
#pragma unroll
    for (int j = 0; j < 16; ++j) hfreg[j] = 0.f;
    __syncthreads();
#pragma unroll 1
    for (int d = 0; d < 2; ++d) {
        const int m = (jl * 2 + d) * 16 + n;
        const bf16_t* WT = (const bf16_t*)(p.ws + OFF_RGW) + (size_t)m * 2 * 4096;
        {
            const int g_ = tid0 >> 8, j_ = (tid0 >> 3) & 31, k8 = (tid0 & 7) * 8;
            *(u32x4*)(wS + (g_ * 32 + j_) * 72 + k8) = *(const u32x4*)(WT + g_ * 4096 + (ct * 32 + j_) * 64 + k8);
        }
        const int cch = obase + (lane0 & 31);
        const float bav = p.in[I_RGBA][(jl * 2 + d) * 1024 + cch];
        const float biv = p.in[I_RGBI][(jl * 2 + d) * 1024 + cch];
        const float spv = __logf(1.0f + __expf(-p.in[I_RGLAM][(jl * 2 + d) * 1024 + cch]));
        float hc = 0.f;
        if (seq >= 16) hc = p.in[I_SRG][(((seq - 16) * 2 + jl) * 2 + d) * 1024 + obase + sc0];
#pragma unroll 1
        for (int st = 0; st < nsteps; ++st) {
            const int pbase = d ? (L - 256 - st * 256) : st * 256;
            int oz = 0; asm volatile("" : "+v"(oz));
            const int lane = lane0 + oz, w = w0 + oz, tid = tid0 + oz;
            const int cg = tid & 15, tr = tid >> 4, sc = tid & 31, sg = tid >> 5, tt = tid >> 1, half = tid & 1;
            if (!(nsteps == 1 && d == 1)) {
#pragma unroll
                for (int t = 0; t < 8; ++t) {
                    f32x4 o = cbv + cwv[0] * rw[t] + cwv[1] * rw[t + 1] + cwv[2] * rw[t + 2] + cwv[3] * rw[t + 3];
                    *(f32x4*)(xr + (tr * 8 + t) * RG_XS + cg * 4) = o;
                }
                if (nsteps > 1) {
                    int nd = d, nst = st + 1;
                    if (nst == nsteps) { nd = d + 1; nst = 0; }
                    if (nd < 2) { const int npb = nd ? (L - 256 - nst * 256) : nst * 256; RG_ISSUE(npb) }
                }
            }
            __syncthreads();
            f32x16 accR, accI;
#pragma unroll
            for (int i = 0; i < 16; ++i) { accR[i] = 0.f; accI[i] = 0.f; }
#pragma unroll
            for (int kk = 0; kk < 4; ++kk) {
                const float* ap = xr + (w * 32 + (lane & 31)) * RG_XS + kk * 16 + (lane >> 5) * 8;
                const float4 x0 = *(const float4*)ap, x1 = *(const float4*)(ap + 4);
                union { bf16x8 v; unsigned u[4]; } af;
                af.u[0] = pack2(x0.x, x0.y); af.u[1] = pack2(x0.z, x0.w); af.u[2] = pack2(x1.x, x1.y); af.u[3] = pack2(x1.z, x1.w);
                const bf16x8 bRk = *(const bf16x8*)(wS + (lane & 31) * 72 + kk * 16 + (lane >> 5) * 8);
                const bf16x8 bIk = *(const bf16x8*)(wS + (32 + (lane & 31)) * 72 + kk * 16 + (lane >> 5) * 8);
                accR = __builtin_amdgcn_mfma_f32_32x32x16_bf16(af.v, bRk, accR, 0, 0, 0);
                accI = __builtin_amdgcn_mfma_f32_32x32x16_bf16(af.v, bIk, accI, 0, 0, 0);
            }
#pragma unroll
            for (int r = 0; r < 16; ++r) {
                const int row = w * 32 + (r & 3) + 8 * (r >> 2) + 4 * (lane >> 5);
                const float rg = sigmoidf_(accR[r] + bav);
                const float ig = sigmoidf_(accI[r] + biv);
                const float av = __expf(-8.0f * rg * spv);
                const float mult = sqrtf(fmaxf(1.0f - av * av, 0.f));
                const float xc = xr[row * RG_XS + ct * 32 + (lane & 31)];
                const int s_ = d ? 255 - row : row;
                aS[(lane & 31) * RG_RS + s_] = av;
                bS[(lane & 31) * RG_RS + s_] = mult * ig * xc;
            }
            const int tok = tokbase + pbase + tt;
            f32x4 gq[4], hq[4];
            if (d == 1) {
                const float* gp = PB + (size_t)tok * 2048 + obase + half * 16;
#pragma unroll
                for (int j = 0; j < 4; ++j) gq[j] = *(const f32x4*)(gp + j * 4);
                if (nsteps > 1) {
                    const float* hp = HF + (size_t)tok * 1024 + obase + half * 16;
#pragma unroll
                    for (int j = 0; j < 4; ++j) hq[j] = *(const f32x4*)(hp + j * 4);
                }
            }
            __syncthreads();
            {
                const int base = sc * RG_RS + sg * 16;
                float av[16], bv[16];
                float Aa = 1.f, Bb = 0.f;
#pragma unroll
                for (int i = 0; i < 16; ++i) { av[i] = aS[base + i]; bv[i] = bS[base + i]; Bb = av[i] * Bb + bv[i]; Aa *= av[i]; }
                segA[sg * 32 + sc] = Aa; segB[sg * 32 + sc] = Bb;
                __syncthreads();
                float hin = hc, hall = hc;
#pragma unroll
                for (int g = 0; g < 16; ++g) {
                    const float sa = segA[g * 32 + sc], sb = segB[g * 32 + sc];
                    hall = sa * hall + sb;
                    if (g < sg) hin = hall;
                }
                float hcur = hin;
#pragma unroll
                for (int i = 0; i < 16; ++i) { hcur = av[i] * hcur + bv[i]; bS[base + i] = hcur; }
                hc = hall;
            }
            __syncthreads();
            {
                const int s_ = d ? 255 - tt : tt;
                float hv[16];
#pragma unroll
                for (int j = 0; j < 16; ++j) hv[j] = bS[(half * 16 + j) * RG_RS + s_];
                if (d == 0) {
                    if (nsteps == 1) {
#pragma unroll
                        for (int j = 0; j < 16; ++j) hfreg[j] = hv[j];
                    } else {
                        float* hp = HF + (size_t)tok * 1024 + obase + half * 16;
#pragma unroll
                        for (int j = 0; j < 4; ++j) *(float4*)(hp + j * 4) = make_float4(hv[4 * j], hv[4 * j + 1], hv[4 * j + 2], hv[4 * j + 3]);
                    }
                } else {
                    float hf[16];
                    if (nsteps == 1) {
#pragma unroll
                        for (int j = 0; j < 16; ++j) hf[j] = hfreg[j];
                    } else {
#pragma unroll
                        for (int j = 0; j < 4; ++j) { hf[4 * j] = hq[j][0]; hf[4 * j + 1] = hq[j][1]; hf[4 * j + 2] = hq[j][2]; hf[4 * j + 3] = hq[j][3]; }
                    }
                    unsigned o[8];
#pragma unroll
                    for (int j = 0; j < 4; ++j) {
                        o[2 * j] = pack2(gq[j][0] * (hf[4 * j] + hv[4 * j]), gq[j][1] * (hf[4 * j + 1] + hv[4 * j + 1]));
                        o[2 * j + 1] = pack2(gq[j][2] * (hf[4 * j + 2] + hv[4 * j + 2]), gq[j][3] * (hf[4 * j + 3] + hv[4 * j + 3]));
                    }
                    bf16_t* yp = Y + (size_t)tok * 1024 + obase + half * 16;
                    *(uint4*)yp = make_uint4(o[0], o[1], o[2], o[3]);
                    *(uint4*)(yp + 8) = make_uint4(o[4], o[5], o[6], o[7]);
                }
            }
        }
        if (seq < 16 && sg0 == 0)
            p.out[OUT_RG + ((seq * 2 + jl) * 2 + d) * 1024 + obase + sc0] = hc;
    }
}

__device__ __forceinline__ void phase_rgscan(const Params& p, int l, float* lds) {
    const int b = blockIdx.x, G = gridDim.x;
    int u, stride, end;
    if (G == 256) { if (b < 64) { u = b; stride = 1024; end = 64; } else { u = 64 + (b - 64); stride = 192; end = 576; } }
    else { u = b; stride = G; end = 576; }
#pragma unroll 1
    for (; u < end; u += stride) {
        int seq, rest;
        if (u < 64) { seq = 16 + (u >> 5); rest = u & 31; } else { seq = (u - 64) >> 5; rest = (u - 64) & 31; }
        rg_unit(p, l, seq, rest >> 1, rest & 1, lds);
    }
}

__device__ __forceinline__ int gla_tok(int seq, int d, int sidx) {
    if (seq < 16) { int pp = d ? 255 - sidx : sidx; return seq * 256 + pp; }
    int pp = d ? 1023 - sidx : sidx;
    return 4096 + (seq - 16) * 1024 + ((pp & 15) << 6) + (pp >> 4);
}

__device__ __forceinline__ int gla_uidx(int seq, int c, int h, int d) {
    const int cg = seq < 16 ? seq * 4 + c : 64 + (seq - 16) * 16 + c;
    return (cg * 4 + h) * 2 + d;
}

__device__ __forceinline__ void gla_pre_unit(const Params& p, int l, int seq, int h, int d, int c, float* ldsf) {
    const int tid = ltid(), lane = tid & 63, w = tid >> 6;
    const int jl = l >> 1;
    float* zs = ldsf;
    float* tot = ldsf + 1024;
    float* gd = ldsf + 1536;
    bf16_t* qin = (bf16_t*)(ldsf + 1664);
    bf16_t* kin = qin + 64 * 136;
    bf16_t* kinT = kin + 64 * 136;
    bf16_t* att = kinT + 128 * 72;
    bf16_t* vT = att + 64 * 72;
    const float* PB = (const float*)(p.ws + OFF_PB);
    float* O = (float*)(p.ws + (d ? OFF_HB : OFF_HF));
    const int uidx = gla_uidx(seq, c, h, d);
    const int kk = tid & 127, ig = tid >> 7;
    const int dvv = tid & 63, i8 = tid >> 6;
    float4 zreg = make_float4(0.f, 0.f, 0.f, 0.f);
    float qreg[16], kreg[16];
    if (tid < 256) { const int tok_ = gla_tok(seq, d, c * 64 + (tid >> 2)); zreg = *(const float4*)(PB + (size_t)tok_ * 3104 + 3072 + d * 16 + (tid & 3) * 4); }
#pragma unroll
    for (int ii = 0; ii < 16; ++ii) {
        const int tok_ = gla_tok(seq, d, c * 64 + ig * 16 + ii);
        qreg[ii] = PB[(size_t)tok_ * 3104 + h * 128 + kk]; kreg[ii] = PB[(size_t)tok_ * 3104 + 512 + h * 128 + kk];
    }
    f32x2 wal2[8];
#pragma unroll
    for (int r = 0; r < 8; ++r) {
        wal2[r][0] = p.in[I_GLWAL][((size_t)(jl * 2 + d) * 16 + 2 * r) * 512 + h * 128 + kk];
        wal2[r][1] = p.in[I_GLWAL][((size_t)(jl * 2 + d) * 16 + 2 * r + 1) * 512 + h * 128 + kk];
    }
    const float bal = p.in[I_GLBAL][(jl * 2 + d) * 512 + h * 128 + kk];
    __syncthreads();
    if (tid < 256) *(float4*)(zs + (tid >> 2) * 16 + (tid & 3) * 4) = zreg;
    {
        float vreg[4][8];
#pragma unroll
        for (int ii = 0; ii < 8; ++ii) {
            const int tok_ = gla_tok(seq, d, c * 64 + i8 * 8 + ii);
#pragma unroll
            for (int g = 0; g < 4; ++g) vreg[g][ii] = PB[(size_t)tok_ * 3104 + 1024 + h * 256 + g * 64 + dvv];
        }
#pragma unroll
        for (int g = 0; g < 4; ++g)
            *(uint4*)(vT + (g * 64 + dvv) * 72 + i8 * 8) = make_uint4(pack2(vreg[g][0], vreg[g][1]), pack2(vreg[g][2], vreg[g][3]), pack2(vreg[g][4], vreg[g][5]), pack2(vreg[g][6], vreg[g][7]));
    }
    __syncthreads();
    float cum[16]; float run = 0.f;
#pragma unroll
    for (int ii = 0; ii < 16; ++ii) {
        const int i = ig * 16 + ii;
        const f32x4 z0 = *(const f32x4*)(zs + i * 16), z1 = *(const f32x4*)(zs + i * 16 + 4), z2 = *(const f32x4*)(zs + i * 16 + 8), z3 = *(const f32x4*)(zs + i * 16 + 12);
        f32x2 xa = z0.xy * wal2[0];
        xa = z0.zw * wal2[1] + xa; xa = z1.xy * wal2[2] + xa; xa = z1.zw * wal2[3] + xa;
        xa = z2.xy * wal2[4] + xa; xa = z2.zw * wal2[5] + xa; xa = z3.xy * wal2[6] + xa; xa = z3.zw * wal2[7] + xa;
        const float x = bal + xa[0] + xa[1];
        const float ls = fminf(x, 0.f) - __logf(1.0f + __expf(-fabsf(x)));
        run += ls * 0.0625f; cum[ii] = run;
    }
    tot[ig * 128 + kk] = run;
    __syncthreads();
    float off = 0.f, blast = 0.f;
#pragma unroll
    for (int g = 0; g < 4; ++g) { const float tv = tot[g * 128 + kk]; blast += tv; if (g < ig) off += tv; }
    if (ig == 0) { const float gv = __expf(blast); ((float*)(p.ws + OFF_GD))[(size_t)uidx * 128 + kk] = gv; }
    {
        unsigned kp[8];
#pragma unroll
        for (int ii = 0; ii < 16; ++ii) {
            const int i = ig * 16 + ii;
            const float bc = off + cum[ii];
            const unsigned qk = pack2(qreg[ii] * __expf(bc), kreg[ii] * __expf(-bc));
            const unsigned qb = qk & 0xffffu, kb = qk >> 16;
            qin[i * 136 + kk] = (bf16_t)qb;
            kin[i * 136 + kk] = (bf16_t)kb;
            if (ii & 1) kp[ii >> 1] |= kb << 16; else kp[ii >> 1] = kb;
        }
        *(uint4*)(kinT + kk * 72 + ig * 16) = make_uint4(kp[0], kp[1], kp[2], kp[3]);
        *(uint4*)(kinT + kk * 72 + ig * 16 + 8) = make_uint4(kp[4], kp[5], kp[6], kp[7]);
    }
    __syncthreads();
    {
        const uint4* qs = (const uint4*)qin;
        uint4* qg = (uint4*)(p.ws + OFF_QIN + (size_t)uidx * 64 * 136 * 2);
        for (int i = tid; i < 1088; i += NTHR) qg[i] = qs[i];
    }
    const int mt = w >> 1;
    const int l15 = lane & 15, l4 = lane >> 4;
#pragma unroll
    for (int nn = 0; nn < 2; ++nn) {
        const int nt = (w & 1) * 2 + nn;
        f32x4 acc = {0.f, 0.f, 0.f, 0.f};
        if (nt <= mt) {
#pragma unroll
            for (int ks = 0; ks < 4; ++ks) {
                bf16x8 a = *(const bf16x8*)(qin + (mt * 16 + l15) * 136 + ks * 32 + l4 * 8);
                bf16x8 b = *(const bf16x8*)(kin + (nt * 16 + l15) * 136 + ks * 32 + l4 * 8);
                acc = __builtin_amdgcn_mfma_f32_16x16x32_bf16(a, b, acc, 0, 0, 0);
            }
        }
#pragma unroll
        for (int r = 0; r < 4; ++r) {
            const int i = mt * 16 + l4 * 4 + r, j = nt * 16 + l15;
            att[i * 72 + j] = (bf16_t)f2bf(j <= i ? acc[r] : 0.f);
        }
    }
    {
        uint2* ug = (uint2*)(p.ws + OFF_UR) + ((size_t)uidx * 8 + w) * 16 * 64 + lane;
        const bf16x8 a0 = *(const bf16x8*)(kinT + (w * 16 + l15) * 72 + l4 * 8);
        const bf16x8 a1 = *(const bf16x8*)(kinT + (w * 16 + l15) * 72 + 32 + l4 * 8);
#pragma unroll 4
        for (int nt = 0; nt < 16; ++nt) {
            f32x4 acc = {0.f, 0.f, 0.f, 0.f};
            bf16x8 b0 = *(const bf16x8*)(vT + (nt * 16 + l15) * 72 + l4 * 8);
            bf16x8 b1 = *(const bf16x8*)(vT + (nt * 16 + l15) * 72 + 32 + l4 * 8);
            acc = __builtin_amdgcn_mfma_f32_16x16x32_bf16(a0, b0, acc, 0, 0, 0);
            acc = __builtin_amdgcn_mfma_f32_16x16x32_bf16(a1, b1, acc, 0, 0, 0);
            ug[nt * 64] = make_uint2(pack2(acc[0], acc[1]), pack2(acc[2], acc[3]));
        }
    }
    __syncthreads();
    {
        const bf16x8 a0 = *(const bf16x8*)(att + (mt * 16 + l15) * 72 + l4 * 8);
        const bf16x8 a1 = *(const bf16x8*)(att + (mt * 16 + l15) * 72 + 32 + l4 * 8);
        int tokr[4];
#pragma unroll
        for (int r = 0; r < 4; ++r) tokr[r] = gla_tok(seq, d, c * 64 + mt * 16 + l4 * 4 + r);
#pragma unroll 4
        for (int nn = 0; nn < 8; ++nn) {
            const int nt = (w & 1) * 8 + nn;
            f32x4 acc = {0.f, 0.f, 0.f, 0.f};
            bf16x8 b0 = *(const bf16x8*)(vT + (nt * 16 + l15) * 72 + l4 * 8);
            bf16x8 b1 = *(const bf16x8*)(vT + (nt * 16 + l15) * 72 + 32 + l4 * 8);
            acc = __builtin_amdgcn_mfma_f32_16x16x32_bf16(a0, b0, acc, 0, 0, 0);
            acc = __builtin_amdgcn_mfma_f32_16x16x32_bf16(a1, b1, acc, 0, 0, 0);
#pragma unroll
            for (int r = 0; r < 4; ++r) O[(size_t)tokr[r] * 1024 + h * 256 + nt * 16 + l15] = acc[r];
        }
    }
}

__device__ __forceinline__ void phase_gla_pre(const Params& p, int l, float* lds) {
#pragma unroll 1
    for (int u = blockIdx.x; u < 768; u += gridDim.x) {
        const int d = u & 1, h = (u >> 1) & 3, cg = u >> 3;
        int seq, c;
        if (cg < 64) { seq = cg >> 2; c = cg & 3; } else { seq = 16 + ((cg - 64) >> 4); c = (cg - 64) & 15; }
        gla_pre_unit(p, l, seq, h, d, c, lds);
    }
}

__device__ __forceinline__ void gla_scan_unit(const Params& p, int l, int seq, int h, int d, int e, float* ldsf, bool dry) {
    const int tid = ltid(), lane = tid & 63, w = tid >> 6;
    const int jl = l >> 1;
    const int nch = seq < 16 ? 4 : 16;
    bf16_t* ST = (bf16_t*)ldsf;
    float* O = (float*)(p.ws + (d ? OFF_HB : OFF_HF));
    float* Ow = dry ? (float*)(p.ws + WS_END) : O;
    const int kt = w, mt = w >> 1;
    const int l15 = lane & 15, l4 = lane >> 4;
    f32x4 S[4];
    __syncthreads();
#pragma unroll
    for (int nt = 0; nt < 4; ++nt) {
#pragma unroll
        for (int r = 0; r < 4; ++r) {
            const int k = kt * 16 + l4 * 4 + r, dv = nt * 16 + l15;
            float v = 0.f;
            if (seq >= 16) v = p.in[I_SGLA][((((size_t)((seq - 16) * 2 + jl) * 2 + d) * 4 + h) * 128 + k) * 256 + e * 64 + dv];
            S[nt][r] = v;
        }
        *(uint2*)(ST + (nt * 16 + l15) * 136 + kt * 16 + l4 * 4) = make_uint2(pack2(S[nt][0], S[nt][1]), pack2(S[nt][2], S[nt][3]));
    }
    bf16x8 aA[4], aB[4], aC[4];
    uint2 uA[4], uB[4], uC[4];
    f32x4 gA, gB, gC, oA[2], oB[2], oC[2];
#define GLB_LOAD(S_, c_) { const int ui_ = gla_uidx(seq, (c_), h, d); \
        const uint2* ug_ = (const uint2*)(p.ws + OFF_UR) + ((size_t)ui_ * 8 + kt) * 16 * 64 + lane; \
        _Pragma("unroll") for (int nt = 0; nt < 4; ++nt) u##S_[nt] = ug_[(e * 4 + nt) * 64]; \
        g##S_ = *(const f32x4*)((const float*)(p.ws + OFF_GD) + (size_t)ui_ * 128 + kt * 16 + l4 * 4); \
        const bf16_t* qg_ = (const bf16_t*)(p.ws + OFF_QIN) + (size_t)ui_ * 64 * 136 + (mt * 16 + l15) * 136 + l4 * 8; \
        _Pragma("unroll") for (int ks = 0; ks < 4; ++ks) a##S_[ks] = *(const bf16x8*)(qg_ + ks * 32); \
        _Pragma("unroll") for (int nn = 0; nn < 2; ++nn) { _Pragma("unroll") for (int r = 0; r < 4; ++r) { \
            const int tok_ = gla_tok(seq, d, (c_) * 64 + mt * 16 + l4 * 4 + r); \
            o##S_[nn][r] = O[(size_t)tok_ * 1024 + h * 256 + e * 64 + ((w & 1) * 2 + nn) * 16 + l15]; } } }
#define GLB_STEP(S_, cc_) if ((cc_) < nch) { \
        _Pragma("unroll") for (int nn = 0; nn < 2; ++nn) { \
            const int nt = (w & 1) * 2 + nn; \
            f32x4 acc = o##S_[nn]; \
            _Pragma("unroll") for (int ks = 0; ks < 4; ++ks) { \
                bf16x8 b = *(const bf16x8*)(ST + (nt * 16 + l15) * 136 + ks * 32 + l4 * 8); \
                acc = __builtin_amdgcn_mfma_f32_16x16x32_bf16(a##S_[ks], b, acc, 0, 0, 0); } \
            _Pragma("unroll") for (int r = 0; r < 4; ++r) { \
                const int tok_ = gla_tok(seq, d, (cc_) * 64 + mt * 16 + l4 * 4 + r); \
                Ow[(size_t)tok_ * 1024 + h * 256 + e * 64 + nt * 16 + l15] = acc[r]; } } \
        __syncthreads(); \
        _Pragma("unroll") for (int nt = 0; nt < 4; ++nt) { \
            { const uint2 uu_ = u##S_[nt]; const f32x4 uf_ = {bflo(uu_.x), bfhi(uu_.x), bflo(uu_.y), bfhi(uu_.y)}; S[nt] = g##S_ * (S[nt] + uf_); } \
            *(uint2*)(ST + (nt * 16 + l15) * 136 + kt * 16 + l4 * 4) = make_uint2(pack2(S[nt][0], S[nt][1]), pack2(S[nt][2], S[nt][3])); } \
        if ((cc_) + 3 < nch) GLB_LOAD(S_, (cc_) + 3) \
        __syncthreads(); }
    GLB_LOAD(A, 0) GLB_LOAD(B, 1) GLB_LOAD(C, 2)
    __syncthreads();
#pragma unroll
    for (int c = 0; c < 18; c += 3) {
        int oz = 0; asm volatile("" : "+v"(oz));
        const int lane_i = lane + oz, w_i = w + oz;
        {
            const int lane = lane_i, w = w_i, kt = w_i, mt = w_i >> 1, l15 = lane_i & 15, l4 = lane_i >> 4;
            GLB_STEP(A, c)
            GLB_STEP(B, c + 1)
            GLB_STEP(C, c + 2)
        }
    }
    if (seq < 16) {
#pragma unroll
        for (int nt = 0; nt < 4; ++nt)
#pragma unroll
            for (int r = 0; r < 4; ++r) {
                const int k = kt * 16 + l4 * 4 + r, dv = nt * 16 + l15;
                p.out[OUT_GLA + ((((size_t)(seq * 2 + jl) * 2 + d) * 4 + h) * 128 + k) * 256 + e * 64 + dv] = S[nt][r];
            }
    }
}

__device__ __forceinline__ void phase_gla(const Params& p, int l, float* lds, bool dry = false) {
    const int b = blockIdx.x, G = gridDim.x;
    int u, stride, end;
    if (G == 256) { if (b < 64) { u = b; stride = 1024; end = 64; } else { u = 64 + (b - 64); stride = 192; end = 576; } }
    else { u = b; stride = G; end = 576; }
#pragma unroll 1
    for (; u < end; u += stride) {
        int seq, rest;
        if (u < 64) { seq = 16 + (u >> 5); rest = u & 31; } else { seq = (u - 64) >> 5; rest = (u - 64) & 31; }
        gla_scan_unit(p, l, seq, rest >> 3, (rest >> 2) & 1, rest & 3, lds, dry);
    }
}

__device__ __forceinline__ void phase_gla_norm(const Params& p, int l) {
    const int lane = ltid() & 63, w = ltid() >> 6;
    const int jl = l >> 1;
    const float* OF = (const float*)(p.ws + OFF_HF);
    const float* OB = (const float*)(p.ws + OFF_HB);
    const float* PB = (const float*)(p.ws + OFF_PB);
    bf16_t* Y = (bf16_t*)(p.ws + OFF_Y);
    const float* ng = p.in[I_GLNG] + jl * 1024;
    for (int tok = blockIdx.x * 8 + w; tok < TTOK; tok += gridDim.x * 8) {
#pragma unroll
        for (int hh = 0; hh < 4; ++hh) {
            const int d0 = hh * 256 + lane * 4;
            float4 a = *(const float4*)(OF + (size_t)tok * 1024 + d0), b = *(const float4*)(OB + (size_t)tok * 1024 + d0);
            float o0 = a.x + b.x, o1 = a.y + b.y, o2 = a.z + b.z, o3 = a.w + b.w;
            float ss = wave_sum(o0 * o0 + o1 * o1 + o2 * o2 + o3 * o3);
            const float rs = rsqrtf(ss * (1.0f / 256.0f) + EPSV);
            float4 gn = *(const float4*)(ng + d0);
            float4 gg = *(const float4*)(PB + (size_t)tok * 3104 + 2048 + d0);
            float y0 = siluf_(gg.x) * (o0 * rs * gn.x), y1 = siluf_(gg.y) * (o1 * rs * gn.y);
            float y2 = siluf_(gg.z) * (o2 * rs * gn.z), y3 = siluf_(gg.w) * (o3 * rs * gn.w);
            *(uint2*)(Y + (size_t)tok * 1024 + d0) = make_uint2(pack2(y0, y1), pack2(y2, y3));
        }
    }
}

#define LDS_FLOATS 38400
#define NPHASE 34
#ifndef REP_MASK
#define REP_MASK 0
#endif

__device__ __forceinline__ bool phase_noop(int ph) {
    if (ph < 2) return false;
    const int l = (ph - 2) / 8, s = (ph - 2) % 8;
    return ((s == 2) || (s == 3)) && ((l & 1) == 0);
}

__global__ void __launch_bounds__(NTHR) hybrid_fwd(Params p) {
    __shared__ __attribute__((aligned(16))) float lds[LDS_FLOATS];
    __shared__ uint4 xb_words;
    if (threadIdx.x == 0) xb_words = make_uint4(0u, 0u, 0u, 0u);
    __syncthreads();
    XcdBarrier bar = xcd_barrier_post((unsigned*)(p.ws + OFF_BAR), (volatile LAS unsigned*)&xb_words);
    bool first = true;
    for (int ph = p.ph_lo; ph < p.ph_hi; ++ph) {
        if (phase_noop(ph)) continue;
        if (!first) xcd_barrier(bar);
        first = false;
        if (ph == 0) { for (int r = 0; r < 1 + ((REP_MASK >> 0) & 1); ++r) { if (r) __syncthreads(); phase_setup(p, lds); } }
        else if (ph == 1) phase_norm(p, 0, 0);
        else {
            const int l = (ph - 2) / 8, s = (ph - 2) % 8;
            const bool gla = (l & 1) != 0;
            if (s == 0 || s == 4) {
                const int kind = (s == 4) ? EPI_OUT : (gla ? EPI_GLAIN : EPI_RGIN);
                const int nrep = 1 + ((REP_MASK >> 2) & 1);
                for (int r = 0; r < nrep; ++r) { if (r) __syncthreads(); phase_gemm(p, l, kind, lds, (kind == EPI_OUT) && (r + 1 < nrep)); }
            } else switch (s) {
                case 1: if (gla) { for (int r = 0; r < 1 + ((REP_MASK >> 4) & 1); ++r) { if (r) __syncthreads(); phase_gla_pre(p, l, lds); } }
                        else { for (int r = 0; r < 1 + ((REP_MASK >> 3) & 1); ++r) { if (r) __syncthreads(); phase_rgscan(p, l, lds); } } break;
                case 2: { const int nrep = 1 + ((REP_MASK >> 5) & 1); for (int r = 0; r < nrep; ++r) { if (r) __syncthreads(); phase_gla(p, l, lds, r + 1 < nrep); } } break;
                case 3: phase_gla_norm(p, l); break;
                case 5: for (int r = 0; r < 1 + ((REP_MASK >> 1) & 1); ++r) phase_norm(p, l, 1); break;
                case 6: for (int r = 0; r < 1 + ((REP_MASK >> 6) & 1); ++r) { if (r) __syncthreads(); phase_peerq(p, l, lds); } break;
                case 7: { const int nrep = 1 + ((REP_MASK >> 7) & 1); for (int r = 0; r < nrep; ++r) { if (r) __syncthreads(); phase_peer_gather(p, l, lds, r + 1 < nrep); } } break;
            }
        }
    }
}

extern "C" void kernel_launch(void* const* d_in, const int* in_sizes, int n_in, void* d_out, int out_size, void* d_ws, size_t ws_size,
                              hipStream_t stream) {
    static int grid = 0;
    if (grid == 0) {
        int dev = 0, cus = 0, per_cu = 0;
        hipGetDevice(&dev);
        hipDeviceGetAttribute(&cus, hipDeviceAttributeMultiprocessorCount, dev);
        hipOccupancyMaxActiveBlocksPerMultiprocessor(&per_cu, (const void*)hybrid_fwd, NTHR, 0);
        (void)hipGetLastError();
        if (per_cu < 1) fprintf(stderr, "kernel_launch: occupancy query says %d blocks per CU\n", per_cu);
        grid = cus > 0 ? cus : 256;
        if (ws_size < WS_END) fprintf(stderr, "kernel_launch: workspace too small (%zu < %zu)\n", ws_size, (size_t)WS_END);
    }
    hipMemsetAsync((char*)d_ws + OFF_BAR, 0, 16384, stream);
    Params p{};
    for (int i = 0; i < 30; ++i) p.in[i] = (const float*)d_in[i];
    p.out = (float*)d_out; p.ws = (unsigned char*)d_ws;
#if MULTI_LAUNCH
    for (int ph = 0; ph < NPHASE; ++ph) {
        p.ph_lo = ph; p.ph_hi = ph + 1;
        hipLaunchKernelGGL(hybrid_fwd, dim3(grid), dim3(NTHR), 0, stream, p);
    }
#else
    p.ph_lo = 0; p.ph_hi = NPHASE;
    void* args[] = {&p};
    hipError_t e = hipLaunchCooperativeKernel((const void*)hybrid_fwd, dim3(grid), dim3(NTHR), args, 0, stream);
    if (e != hipSuccess) fprintf(stderr, "cooperative launch failed: %s (grid %d)\n", hipGetErrorString(e), grid);
#endif
}
```

```cpp
#include <hip/hip_runtime.h>
#include <stdint.h>
#include <stdio.h>

#ifndef MULTI_LAUNCH
#define MULTI_LAUNCH 0
#endif

typedef __attribute__((ext_vector_type(8))) short bf16x8;
typedef __attribute__((ext_vector_type(4))) float f32x4;
typedef __attribute__((ext_vector_type(16))) float f32x16;
typedef __attribute__((ext_vector_type(2))) __bf16 bf2_t;
typedef unsigned short bf16_t;
typedef unsigned u32x4 __attribute__((ext_vector_type(4)));

#define NTHR 512
#define TTOK 6144
#define DM 1024
#define EPSV 1e-6f

constexpr size_t AL(size_t x) { return (x + 255) & ~(size_t)255; }
constexpr size_t OFF_BAR   = 0;
constexpr size_t OFF_MODS  = 16384;
constexpr size_t OFF_X     = AL(OFF_MODS + (size_t)4 * 3 * 6144 * 4);
constexpr size_t OFF_H     = AL(OFF_X + (size_t)TTOK * DM * 4);
constexpr size_t OFF_Y     = AL(OFF_H + (size_t)TTOK * DM * 2);
constexpr size_t OFF_PB    = AL(OFF_Y + (size_t)TTOK * DM * 2);
constexpr size_t OFF_HF    = AL(OFF_PB + (size_t)TTOK * 3104 * 4);
constexpr size_t OFF_HB    = AL(OFF_HF + (size_t)TTOK * DM * 4);
constexpr size_t OFF_TK    = AL(OFF_HB + (size_t)TTOK * DM * 4);
constexpr size_t OFF_RGWIN = AL(OFF_TK + (size_t)TTOK * 256 * 4);
constexpr size_t OFF_RGWOUT= AL(OFF_RGWIN + (size_t)2 * 2048 * 1024 * 2);
constexpr size_t OFF_GLWIN = AL(OFF_RGWOUT + (size_t)2 * 1024 * 1024 * 2);
constexpr size_t OFF_GLWOUT= AL(OFF_GLWIN + (size_t)2 * 3200 * 1024 * 2);
constexpr size_t OFF_PWQ   = AL(OFF_GLWOUT + (size_t)2 * 1024 * 1024 * 2);
constexpr size_t OFF_PK    = AL(OFF_PWQ + (size_t)4 * 2048 * 1024 * 2);
constexpr size_t OFF_PU    = AL(OFF_PK + (size_t)4 * 2 * 8 * 128 * 128 * 2);
constexpr size_t OFF_PV    = AL(OFF_PU + (size_t)4 * 16384 * 1024);
constexpr size_t OFF_SU    = AL(OFF_PV + (size_t)4 * 16384 * 1024);
constexpr size_t OFF_SV    = AL(OFF_SU + (size_t)4 * 16384 * 4);
constexpr size_t OFF_RGW   = AL(OFF_SV + (size_t)4 * 16384 * 4);
constexpr size_t OFF_QIN   = AL(OFF_RGW + (size_t)2 * 2 * 16 * 2 * 4096 * 2);
constexpr size_t OFF_GD    = AL(OFF_QIN + (size_t)768 * 64 * 136 * 2);
constexpr size_t OFF_UR    = AL(OFF_GD + (size_t)768 * 128 * 4);
constexpr size_t WS_END    = AL(OFF_UR + (size_t)768 * 8 * 16 * 64 * 8);

constexpr size_t OUT_Y    = 0;
constexpr size_t OUT_RG   = (size_t)TTOK * DM;
constexpr size_t OUT_GLA  = OUT_RG + 16 * 2 * 2 * 1024;

struct Params {
    const float* in[30];
    float* out;
    unsigned char* ws;
    int ph_lo, ph_hi;
};

enum { I_XP = 0, I_XS, I_SRG, I_SGLA, I_C, I_CCTX, I_N1G, I_N2G, I_ADAW, I_ADAB, I_PWQ, I_PK1, I_PK2, I_PU, I_PV,
       I_RGWIN, I_RGCW, I_RGCB, I_RGWA, I_RGBA, I_RGWI, I_RGBI, I_RGLAM, I_RGWOUT, I_GLWIN, I_GLWAL, I_GLBAL, I_GLNG, I_GLWOUT, I_FNG };

typedef float f32x2 __attribute__((ext_vector_type(2)));
__device__ __forceinline__ unsigned pack2(float a, float b) {
    f32x2 v = {a, b};
    return __builtin_bit_cast(unsigned, __builtin_convertvector(v, bf2_t));
}
__device__ __forceinline__ unsigned f2bf(float f) { return pack2(f, 0.f) & 0xffffu; }
__device__ __forceinline__ float bflo(unsigned u) { return __uint_as_float(u << 16); }
__device__ __forceinline__ float bfhi(unsigned u) { return __uint_as_float(u & 0xffff0000u); }
__device__ __forceinline__ float sigmoidf_(float x) { return 1.0f / (1.0f + __expf(-x)); }
__device__ __forceinline__ float siluf_(float x) { return x * sigmoidf_(x); }
__device__ __forceinline__ float gelu_tanh(float x) {
    float u = 0.7978845608028654f * (x + 0.044715f * x * x * x);
    float t = __expf(2.0f * u);
    float th = 1.0f - 2.0f / (t + 1.0f);
    return 0.5f * x * (1.0f + th);
}
__device__ __forceinline__ int ltid() { int t = threadIdx.x; asm volatile("" : "+v"(t)); return t; }
__device__ __forceinline__ int cond_of(int tok) { return tok < 4096 ? 0 : 1 + ((tok - 4096) >> 10); }
__device__ __forceinline__ float wave_sum(float v) {
#pragma unroll
    for (int o = 32; o >= 1; o >>= 1) v += __shfl_xor(v, o);
    return v;
}

#define XB_TMO      128
#define XB_XCNT(j)  (256  + 64 * (j))
#define XB_XSUB(j)  (1280 + 64 * (j))
#define XB_XGEN(j)  (2304 + 64 * (j))
#define XB_TOP      3328
#define XB_TOPGEN   3392
#define XCD_BAR_WORDS 3456
#define XB_SPIN_CAP (1u << 22)
#define LAS __attribute__((address_space(3)))

__device__ __forceinline__ unsigned xb_ld(unsigned* p)              { return __hip_atomic_load(p, __ATOMIC_RELAXED, __HIP_MEMORY_SCOPE_AGENT); }
__device__ __forceinline__ unsigned xb_add(unsigned* p, unsigned v) { return __hip_atomic_fetch_add(p, v, __ATOMIC_RELAXED, __HIP_MEMORY_SCOPE_AGENT); }
__device__ __forceinline__ unsigned xb_xcc_id() { return (unsigned)__builtin_amdgcn_s_getreg((3 << 11) | 20) & 0xFu; }
#define XB_SPIN(cond, bar) do { unsigned _sp = 0; while (cond) { __builtin_amdgcn_s_sleep(1); \
    if ((++_sp & 255u) == 0u) { if (xb_ld(&(bar)[XB_TMO])) break; if (_sp > XB_SPIN_CAP) { atomicAdd(&(bar)[XB_TMO], 1u); break; } } } } while (0)

struct XcdBarrier { unsigned* bar; unsigned x; volatile LAS unsigned* st; };

__device__ __forceinline__ XcdBarrier xcd_barrier_post(unsigned* bar, volatile LAS unsigned* st) {
    XcdBarrier b; b.bar = bar; b.x = xb_xcc_id(); b.st = st;
    if (threadIdx.x == 0) (void)xb_add(&bar[XB_XCNT(b.x)], 1u);
    return b;
}
__device__ __forceinline__ void xcd_barrier_complete(unsigned* bar, unsigned x, unsigned& nloc, unsigned& nx) {
    const unsigned G = gridDim.x * gridDim.y * gridDim.z;
    unsigned sum, cnt, mine, sp = 0u;
    for (;;) {
        sum = 0u; cnt = 0u; mine = 0u;
#pragma unroll
        for (unsigned j = 0; j < 16; ++j) { const unsigned c = xb_ld(&bar[XB_XCNT(j)]); sum += c; cnt += (c > 0u) ? 1u : 0u; mine = (j == x) ? c : mine; }
        if (sum == G) break;
        __builtin_amdgcn_s_sleep(1);
        if ((++sp & 255u) == 0u) { if (xb_ld(&bar[XB_TMO])) break; if (sp > XB_SPIN_CAP) { atomicAdd(&bar[XB_TMO], 1u); break; } }
    }
    nloc = mine > 0u ? mine : 1u; nx = cnt > 0u ? cnt : 1u;
}
__device__ __forceinline__ void xcd_barrier(const XcdBarrier& b) {
    asm volatile("s_waitcnt vmcnt(0)" ::: "memory");
    __syncthreads();
    if (threadIdx.x == 0) {
        unsigned* bar = b.bar;
        __builtin_amdgcn_s_waitcnt(0);
        unsigned nloc = b.st[0], nx = b.st[1];
        if (nloc == 0u) { xcd_barrier_complete(bar, b.x, nloc, nx); b.st[0] = nloc; b.st[1] = nx; }
        const unsigned old = xb_add(&bar[XB_XSUB(b.x)], 1u);
        const unsigned gen = old / nloc;
        if (old + 1u == (gen + 1u) * nloc) {
            __builtin_amdgcn_fence(__ATOMIC_RELEASE, "agent");
            asm volatile("s_waitcnt vmcnt(0)" ::: "memory");
            const unsigned og = xb_add(&bar[XB_TOP], 1u);
            const unsigned tg = og / nx;
            if (og + 1u == (tg + 1u) * nx) xb_add(&bar[XB_TOPGEN], 1u);
            else XB_SPIN(xb_ld(&bar[XB_TOPGEN]) == tg, bar);
            __builtin_amdgcn_fence(__ATOMIC_ACQUIRE, "agent");
            xb_add(&bar[XB_XGEN(b.x)], 1u);
            asm volatile("s_waitcnt vmcnt(0)" ::: "memory");
        } else {
            XB_SPIN(xb_ld(&bar[XB_XGEN(b.x)]) == gen, bar);
            __builtin_amdgcn_fence(__ATOMIC_ACQUIRE, "agent");
            asm volatile("s_waitcnt vmcnt(0)" ::: "memory");
        }
    }
    __syncthreads();
}

__device__ __forceinline__ void setup_ada_unit(const Params& p, int a, float* lds) {
    const int tid = ltid();
    const int l = a / 48, jb = (a % 48) * 128;
    float* scond = lds;
    float* part = lds + 3072;
    for (int i = tid; i < 3072; i += NTHR) {
        int n = i >> 10, k = i & 1023;
        float c = (n == 0) ? p.in[I_CCTX][k] : p.in[I_C][(n - 1) * 1024 + k];
        scond[i] = siluf_(c);
    }
    __syncthreads();
    const int lane = tid & 63, kg = tid >> 6;
    const float* w = p.in[I_ADAW] + (size_t)l * 1024 * 6144 + jb + lane * 2;
    float a0x = 0.f, a0y = 0.f, a1x = 0.f, a1y = 0.f, a2x = 0.f, a2y = 0.f;
#pragma unroll 1
    for (int k0 = 0; k0 < 128; k0 += 32) {
        float2 wv[32];
#pragma unroll
        for (int kk = 0; kk < 32; ++kk) { const f32x2 t_ = __builtin_nontemporal_load((const f32x2*)(w + (size_t)(kg * 128 + k0 + kk) * 6144)); wv[kk] = make_float2(t_[0], t_[1]); }
#pragma unroll
        for (int kk = 0; kk < 32; ++kk) {
            const int k = kg * 128 + k0 + kk;
            const float s0 = scond[k], s1 = scond[1024 + k], s2 = scond[2048 + k];
            a0x += s0 * wv[kk].x; a0y += s0 * wv[kk].y; a1x += s1 * wv[kk].x; a1y += s1 * wv[kk].y; a2x += s2 * wv[kk].x; a2y += s2 * wv[kk].y;
        }
    }
    float* pp = part + kg * 384 + lane * 2;
    pp[0] = a0x; pp[1] = a0y; pp[128] = a1x; pp[129] = a1y; pp[256] = a2x; pp[257] = a2y;
    __syncthreads();
    if (tid < 384) {
        const int n = tid >> 7, c2 = tid & 127;
        float sm = p.in[I_ADAB][l * 6144 + jb + c2];
#pragma unroll
        for (int g = 0; g < 8; ++g) sm += part[g * 384 + n * 128 + c2];
        float* mods = (float*)(p.ws + OFF_MODS);
        mods[(l * 3 + n) * 6144 + jb + c2] = sm;
    }
    __syncthreads();
}

__device__ __forceinline__ void setup_transpose_unit(const Params& p, int u, float* lds) {
    const int tid = ltid();
    const float* src; bf16_t* dst; int N, tiles_n, t, dstride = 1024;
    const bool gates = u >= 1424;
    const int i = u * 4;
    if (gates)         { t = 0; N = 64; tiles_n = 1; dstride = 64; src = p.in[I_RGWA]; dst = (bf16_t*)(p.ws + OFF_RGW) + (size_t)(i - 5696) * 4096; }
    else if (i < 1024) { int m = i / 512;          t = i % 512;          N = 2048; tiles_n = 32; src = p.in[I_RGWIN] + (size_t)m * 1024 * 2048;  dst = (bf16_t*)(p.ws + OFF_RGWIN) + (size_t)m * 2048 * 1024; }
    else if (i < 1536) { int m = (i - 1024) / 256; t = (i - 1024) % 256; N = 1024; tiles_n = 16; src = p.in[I_RGWOUT] + (size_t)m * 1024 * 1024; dst = (bf16_t*)(p.ws + OFF_RGWOUT) + (size_t)m * 1024 * 1024; }
    else if (i < 3136) { int m = (i - 1536) / 800; t = (i - 1536) % 800; N = 3104; tiles_n = 50; src = p.in[I_GLWIN] + (size_t)m * 1024 * 3104;  dst = (bf16_t*)(p.ws + OFF_GLWIN) + (size_t)m * 3200 * 1024; }
    else if (i < 3648) { int m = (i - 3136) / 256; t = (i - 3136) % 256; N = 1024; tiles_n = 16; src = p.in[I_GLWOUT] + (size_t)m * 1024 * 1024; dst = (bf16_t*)(p.ws + OFF_GLWOUT) + (size_t)m * 1024 * 1024; }
    else               { int m = (i - 3648) / 512; t = (i - 3648) % 512; N = 2048; tiles_n = 32; src = p.in[I_PWQ] + (size_t)m * 1024 * 2048;    dst = (bf16_t*)(p.ws + OFF_PWQ) + (size_t)m * 2048 * 1024; }
    const int mg = (i - 5696) >> 1;
    {
        const int k = tid >> 3, nc = (tid & 7) * 8;
        f32x4 v0[4], v1[4];
#pragma unroll
        for (int q = 0; q < 4; ++q) {
            const int tq = t + q, kt = tq / tiles_n, nt = tq % tiles_n;
            const float* sq = gates ? p.in[(q & 1) ? I_RGWI : I_RGWA] + (size_t)(mg + (q >> 1)) * 4096 : src;
            const int n = nt * 64 + nc;
            f32x4 z = {0.f, 0.f, 0.f, 0.f};
            v0[q] = z; v1[q] = z;
            if (n < N) {
                const f32x4* s4 = (const f32x4*)(sq + (size_t)((gates ? 0 : kt) * 64 + k) * N + n);
                v0[q] = __builtin_nontemporal_load(s4); v1[q] = __builtin_nontemporal_load(s4 + 1);
            }
        }
#pragma unroll
        for (int q = 0; q < 4; ++q) {
            float* tp = lds + q * 4160 + k * 65 + nc;
#pragma unroll
            for (int j = 0; j < 4; ++j) { tp[j] = v0[q][j]; tp[4 + j] = v1[q][j]; }
        }
    }
    __syncthreads();
    {
        const int n = tid >> 3, kc = (tid & 7) * 8;
#pragma unroll
        for (int q = 0; q < 4; ++q) {
            const int tq = t + q, kt = gates ? 0 : tq / tiles_n, nt = gates ? 0 : tq % tiles_n;
            bf16_t* dq = gates ? dst + (size_t)q * 4096 : dst;
            const float* tile = lds + q * 4160;
            float x[8];
#pragma unroll
            for (int j = 0; j < 8; ++j) x[j] = tile[(kc + j) * 65 + n];
            uint4 o; o.x = pack2(x[0], x[1]); o.y = pack2(x[2], x[3]); o.z = pack2(x[4], x[5]); o.w = pack2(x[6], x[7]);
            *(uint4*)(dq + (size_t)(nt * 64 + n) * dstride + kt * 64 + kc) = o;
        }
    }
    __syncthreads();
}

__device__ __forceinline__ void setup_convert_unit(const Params& p, int i, bool force = false) {
    const int tid = ltid();
    if (i < 256) {
        int side = i >> 7, ii = i & 127;
        size_t e = (size_t)ii * 4096;
        int l = (int)(e / 131072); size_t rest = e % 131072;
        const float* src = p.in[side ? I_PK2 : I_PK1] + e;
        bf16_t* dst = (bf16_t*)(p.ws + OFF_PK) + (size_t)l * 262144 + (size_t)side * 131072 + rest;
        const float4* s4 = (const float4*)(src + tid * 8);
        float4 v0 = s4[0], v1 = s4[1];
        uint4 o; o.x = pack2(v0.x, v0.y); o.y = pack2(v0.z, v0.w); o.z = pack2(v1.x, v1.y); o.w = pack2(v1.z, v1.w);
        *(uint4*)(dst + tid * 8) = o;
        return;
    }
    i -= 256;
    if (!force && gridDim.x == 256 && (i & 1023) >= 256) return;
    const int tab = i >> 10;
    const int lane = tid & 63, w = tid >> 6;
    const float* src = p.in[tab ? I_PV : I_PU];
    unsigned char* dst = p.ws + (tab ? OFF_PV : OFF_PU);
    float* sc = (float*)(p.ws + (tab ? OFF_SV : OFF_SU));
    const size_t rowbase = (size_t)(i & 1023) * 64 + w * 8;
    f32x4 v[8][4];
#pragma unroll
    for (int rr = 0; rr < 8; ++rr) {
        const float* rp = src + (rowbase + rr) * 1024;
#pragma unroll
        for (int q = 0; q < 4; ++q) v[rr][q] = __builtin_nontemporal_load((const f32x4*)(rp + q * 256 + lane * 4));
    }
#pragma unroll
    for (int rr = 0; rr < 8; ++rr) {
        float am = 0.f;
#pragma unroll
        for (int q = 0; q < 4; ++q) am = fmaxf(am, fmaxf(fmaxf(fabsf(v[rr][q][0]), fabsf(v[rr][q][1])), fmaxf(fabsf(v[rr][q][2]), fabsf(v[rr][q][3]))));
#pragma unroll
        for (int o = 32; o >= 1; o >>= 1) am = fmaxf(am, __shfl_xor(am, o));
        const float scale = am > 0.f ? am * (1.0f / 448.0f) : 1.0f;
        const float inv = 1.0f / scale;
        unsigned o4[4];
#pragma unroll
        for (int q = 0; q < 4; ++q) {
            int pk = 0;
            pk = __builtin_amdgcn_cvt_pk_fp8_f32(v[rr][q][0] * inv, v[rr][q][1] * inv, pk, false);
            pk = __builtin_amdgcn_cvt_pk_fp8_f32(v[rr][q][2] * inv, v[rr][q][3] * inv, pk, true);
            o4[q] = (unsigned)pk;
        }
        const size_t row = rowbase + rr;
        { const u32x4 ov = {o4[0], o4[1], o4[2], o4[3]}; __builtin_nontemporal_store(ov, (u32x4*)(dst + row * 1024 + lane * 16)); }
        if (lane == 0) sc[row] = scale;
    }
}

__device__ __forceinline__ void setup_xinit_unit(const Params& p, int i) {
    const int tid = ltid();
    const int row = i * 4 + (tid >> 7), d0 = (tid & 127) * 8;
    float* X = (float*)(p.ws + OFF_X);
    float v[8];
    if (row < 4096) {
        const f32x4* s4 = (const f32x4*)(p.in[I_XP] + (size_t)row * 1024 + d0);
        const f32x4 a_ = __builtin_nontemporal_load(s4), b_ = __builtin_nontemporal_load(s4 + 1);
        const float4 a = make_float4(a_[0], a_[1], a_[2], a_[3]), b = make_float4(b_[0], b_[1], b_[2], b_[3]);
        v[0] = a.x; v[1] = a.y; v[2] = a.z; v[3] = a.w; v[4] = b.x; v[5] = b.y; v[6] = b.z; v[7] = b.w;
    } else {
        const f32x4* s4 = (const f32x4*)(p.in[I_XS] + (size_t)(row - 4096) * 1024 + d0);
        const f32x4 a_ = __builtin_nontemporal_load(s4), b_ = __builtin_nontemporal_load(s4 + 1);
        const float4 a = make_float4(a_[0], a_[1], a_[2], a_[3]), b = make_float4(b_[0], b_[1], b_[2], b_[3]);
        v[0] = a.x; v[1] = a.y; v[2] = a.z; v[3] = a.w; v[4] = b.x; v[5] = b.y; v[6] = b.z; v[7] = b.w;
        int n = (row - 4096) & 1023;
        float r = (float)(n >> 6), cc = (float)(n & 63);
#pragma unroll
        for (int j = 0; j < 8; ++j) {
            int d = d0 + j; int q = d >> 8, fi = d & 255;
            float freq = exp2f(-13.287712379549449f * ((float)fi * (1.0f / 256.0f)));
            float ang = ((q < 2) ? r : cc) * freq;
            v[j] += (q & 1) ? __cosf(ang) : __sinf(ang);
        }
    }
    float4* o4 = (float4*)(X + (size_t)row * 1024 + d0);
    o4[0] = make_float4(v[0], v[1], v[2], v[3]); o4[1] = make_float4(v[4], v[5], v[6], v[7]);
}

__device__ __forceinline__ void phase_setup(const Params& p, float* lds) {
    constexpr int NA = 192, NB = (5696 + 128) / 4, NC = 256 + 2048, ND = 1536;
    constexpr int total = NA + NB + NC + ND;
    for (int u = blockIdx.x; u < total; u += gridDim.x) {
        if (u < NA) setup_ada_unit(p, u, lds);
        else if (u < NA + NB) setup_transpose_unit(p, u - NA, lds);
        else if (u < NA + NB + NC) setup_convert_unit(p, u - NA - NB);
        else setup_xinit_unit(p, u - NA - NB - NC);
    }
}

__device__ __forceinline__ void premod_store(const float* x  , float ss, const float* g, const float* mrow, int shift_i, int scale_i,
                                             bf16_t* Hrow, int lane) {
    const float rs = rsqrtf(ss * (1.0f / 1024.0f) + EPSV);
    unsigned pk[8];
#pragma unroll
    for (int hf = 0; hf < 2; ++hf) {
        const int d0 = hf * 512 + lane * 8;
        float4 g0 = *(const float4*)(g + d0), g1 = *(const float4*)(g + d0 + 4);
        float4 s0 = *(const float4*)(mrow + shift_i * 1024 + d0), s1 = *(const float4*)(mrow + shift_i * 1024 + d0 + 4);
        float4 c0 = *(const float4*)(mrow + scale_i * 1024 + d0), c1 = *(const float4*)(mrow + scale_i * 1024 + d0 + 4);
        float gg[8] = {g0.x, g0.y, g0.z, g0.w, g1.x, g1.y, g1.z, g1.w};
        float sh[8] = {s0.x, s0.y, s0.z, s0.w, s1.x, s1.y, s1.z, s1.w};
        float sc[8] = {c0.x, c0.y, c0.z, c0.w, c1.x, c1.y, c1.z, c1.w};
        float o[8];
#pragma unroll
        for (int j = 0; j < 8; ++j) o[j] = (x[hf * 8 + j] * rs * gg[j]) * (1.0f + sc[j]) + sh[j];
#pragma unroll
        for (int j = 0; j < 4; ++j) pk[hf * 4 + j] = pack2(o[2 * j], o[2 * j + 1]);
    }
    *(uint4*)(Hrow + lane * 8) = make_uint4(pk[0], pk[1], pk[2], pk[3]);
    *(uint4*)(Hrow + 512 + lane * 8) = make_uint4(pk[4], pk[5], pk[6], pk[7]);
}

__device__ __forceinline__ void phase_norm(const Params& p, int l, int which  ) {
    const int lane = ltid() & 63, w = ltid() >> 6;
    const float* X = (const float*)(p.ws + OFF_X);
    bf16_t* H = (bf16_t*)(p.ws + OFF_H);
    const float* mods = (const float*)(p.ws + OFF_MODS) + (size_t)l * 3 * 6144;
    const float* g = p.in[which ? I_N2G : I_N1G] + l * 1024;
    for (int row = blockIdx.x * 8 + w; row < TTOK; row += gridDim.x * 8) {
        const float* xr = X + (size_t)row * 1024;
        float x[16];
        float4 a = *(const float4*)(xr + lane * 8), b = *(const float4*)(xr + lane * 8 + 4);
        float4 c = *(const float4*)(xr + 512 + lane * 8), d = *(const float4*)(xr + 512 + lane * 8 + 4);
        x[0] = a.x; x[1] = a.y; x[2] = a.z; x[3] = a.w; x[4] = b.x; x[5] = b.y; x[6] = b.z; x[7] = b.w;
        x[8] = c.x; x[9] = c.y; x[10] = c.z; x[11] = c.w; x[12] = d.x; x[13] = d.y; x[14] = d.z; x[15] = d.w;
        float ss = 0.f;
#pragma unroll
        for (int j = 0; j < 16; ++j) ss += x[j] * x[j];
        ss = wave_sum(ss);
        premod_store(x, ss, g, mods + cond_of(row) * 6144, which ? 3 : 0, which ? 4 : 1, H + (size_t)row * 1024, lane);
    }
}

#define GT_STRIDE 72
#define GT_BUF (2 * 128 * GT_STRIDE)

#define GLOAD(RR, k0) { RR##0 = *(const u32x4*)(ap0 + (k0)); RR##1 = *(const u32x4*)(ap1 + (k0)); RR##2 = *(const u32x4*)(bp0 + (k0)); RR##3 = *(const u32x4*)(bp1 + (k0)); }
#define GWRITE(RR, buf) { bf16_t* dA = lds + (buf) * GT_BUF; bf16_t* dB = dA + 128 * GT_STRIDE; \
        *(u32x4*)(dA + r0 * GT_STRIDE + kc) = RR##0; *(u32x4*)(dA + (r0 + 64) * GT_STRIDE + kc) = RR##1; \
        *(u32x4*)(dB + r0 * GT_STRIDE + kc) = RR##2; *(u32x4*)(dB + (r0 + 64) * GT_STRIDE + kc) = RR##3; }
#define GCOMPUTE(buf) { const bf16_t* sA = lds + (buf) * GT_BUF; const bf16_t* sB = sA + 128 * GT_STRIDE; \
        _Pragma("unroll") for (int kk = 0; kk < 4; ++kk) { \
            bf16x8 a = *(const bf16x8*)(sA + arow * GT_STRIDE + kk * 16 + koff); \
            bf16x8 b0 = *(const bf16x8*)(sB + (wn * 64 + (lane & 31)) * GT_STRIDE + kk * 16 + koff); \
            bf16x8 b1 = *(const bf16x8*)(sB + (wn * 64 + 32 + (lane & 31)) * GT_STRIDE + kk * 16 + koff); \
            acc[0] = __builtin_amdgcn_mfma_f32_32x32x16_bf16(a, b0, acc[0], 0, 0, 0); \
            acc[1] = __builtin_amdgcn_mfma_f32_32x32x16_bf16(a, b1, acc[1], 0, 0, 0); } }
#define GSTEP_L(ks, RL, RW) { GLOAD(RL, ((ks) + 3) * 64); GCOMPUTE((ks) & 1); GWRITE(RW, ((ks) + 1) & 1); __syncthreads(); }
#define GSTEP_N(ks, RW)     { GCOMPUTE((ks) & 1); GWRITE(RW, ((ks) + 1) & 1); __syncthreads(); }

struct GemmRegs { u32x4 a0, a1, a2, a3, b0, b1, b2, b3, c0, c1, c2, c3; };
#define Ra0 R.a0
#define Ra1 R.a1
#define Ra2 R.a2
#define Ra3 R.a3
#define Rb0 R.b0
#define Rb1 R.b1
#define Rb2 R.b2
#define Rb3 R.b3
#define Rc0 R.c0
#define Rc1 R.c1
#define Rc2 R.c2
#define Rc3 R.c3
__device__ __forceinline__ void gemm_prefetch(const bf16_t* __restrict__ A, const bf16_t* __restrict__ Bt, int m0, int n0, GemmRegs& R) {
    const int tid = ltid();
    const int r0 = tid >> 3, kc = (tid & 7) * 8;
    const bf16_t* ap0 = A + (size_t)(m0 + r0) * 1024 + kc;
    const bf16_t* ap1 = A + (size_t)(m0 + r0 + 64) * 1024 + kc;
    const bf16_t* bp0 = Bt + (size_t)(n0 + r0) * 1024 + kc;
    const bf16_t* bp1 = Bt + (size_t)(n0 + r0 + 64) * 1024 + kc;
    GLOAD(Ra, 0); GLOAD(Rb, 64); GLOAD(Rc, 128);
}
__device__ __forceinline__ void gemm_mainloop(const bf16_t* __restrict__ A, const bf16_t* __restrict__ Bt, int m0, int n0,
                                              bf16_t* lds, f32x16 (&acc)[2], GemmRegs& R) {
    const int tid = ltid(), lane = tid & 63, w = tid >> 6;
    const int wm = w >> 1, wn = w & 1;
#pragma unroll
    for (int i = 0; i < 16; ++i) { acc[0][i] = 0.f; acc[1][i] = 0.f; }
    const int r0 = tid >> 3, kc = (tid & 7) * 8;
    const bf16_t* ap0 = A + (size_t)(m0 + r0) * 1024 + kc;
    const bf16_t* ap1 = A + (size_t)(m0 + r0 + 64) * 1024 + kc;
    const bf16_t* bp0 = Bt + (size_t)(n0 + r0) * 1024 + kc;
    const bf16_t* bp1 = Bt + (size_t)(n0 + r0 + 64) * 1024 + kc;
    GWRITE(Ra, 0);
    __syncthreads();
    const int arow = wm * 32 + (lane & 31), koff = (lane >> 5) * 8;
    GSTEP_L(0, Ra, Rb)  GSTEP_L(1, Rb, Rc)  GSTEP_L(2, Rc, Ra)
    GSTEP_L(3, Ra, Rb)  GSTEP_L(4, Rb, Rc)  GSTEP_L(5, Rc, Ra)
    GSTEP_L(6, Ra, Rb)  GSTEP_L(7, Rb, Rc)  GSTEP_L(8, Rc, Ra)
    GSTEP_L(9, Ra, Rb)  GSTEP_L(10, Rb, Rc) GSTEP_L(11, Rc, Ra)
    GSTEP_L(12, Ra, Rb) GSTEP_N(13, Rc)     GSTEP_N(14, Ra)
    { GCOMPUTE(1); __syncthreads(); }
}

#define G2_BUF (384 * GT_STRIDE)
struct Gemm2Regs { u32x4 a0, a1, a2, a3, a4, a5, b0, b1, b2, b3, b4, b5, c0, c1, c2, c3, c4, c5; };
#define G2LOAD(RR, k0) { R2.RR##0 = *(const u32x4*)(ap0 + (k0)); R2.RR##1 = *(const u32x4*)(ap0 + (size_t)64 * 1024 + (k0)); \
        R2.RR##2 = *(const u32x4*)(ap0 + (size_t)128 * 1024 + (k0)); R2.RR##3 = *(const u32x4*)(ap0 + (size_t)192 * 1024 + (k0)); \
        R2.RR##4 = *(const u32x4*)(bp0 + (k0)); R2.RR##5 = *(const u32x4*)(bp0 + (size_t)64 * 1024 + (k0)); }
#define G2WRITE(RR, buf) { bf16_t* dA = lds + (buf) * G2_BUF; bf16_t* dB = dA + 256 * GT_STRIDE; \
        *(u32x4*)(dA + r0 * GT_STRIDE + kc) = R2.RR##0; *(u32x4*)(dA + (r0 + 64) * GT_STRIDE + kc) = R2.RR##1; \
        *(u32x4*)(dA + (r0 + 128) * GT_STRIDE + kc) = R2.RR##2; *(u32x4*)(dA + (r0 + 192) * GT_STRIDE + kc) = R2.RR##3; \
        *(u32x4*)(dB + r0 * GT_STRIDE + kc) = R2.RR##4; *(u32x4*)(dB + (r0 + 64) * GT_STRIDE + kc) = R2.RR##5; }
#define G2COMPUTE(buf) { const bf16_t* sA = lds + (buf) * G2_BUF; const bf16_t* sB = sA + 256 * GT_STRIDE; \
        _Pragma("unroll") for (int kk = 0; kk < 4; ++kk) { \
            bf16x8 a0 = *(const bf16x8*)(sA + arow * GT_STRIDE + kk * 16 + koff); \
            bf16x8 a1 = *(const bf16x8*)(sA + (arow + 32) * GT_STRIDE + kk * 16 + koff); \
            bf16x8 b0 = *(const bf16x8*)(sB + brow * GT_STRIDE + kk * 16 + koff); \
            bf16x8 b1 = *(const bf16x8*)(sB + (brow + 32) * GT_STRIDE + kk * 16 + koff); \
            acc[0] = __builtin_amdgcn_mfma_f32_32x32x16_bf16(a0, b0, acc[0], 0, 0, 0); \
            acc[1] = __builtin_amdgcn_mfma_f32_32x32x16_bf16(a0, b1, acc[1], 0, 0, 0); \
            acc[2] = __builtin_amdgcn_mfma_f32_32x32x16_bf16(a1, b0, acc[2], 0, 0, 0); \
            acc[3] = __builtin_amdgcn_mfma_f32_32x32x16_bf16(a1, b1, acc[3], 0, 0, 0); } }
#define G2STEP_L(ks, RL, RW) { G2LOAD(RL, ((ks) + 3) * 64); G2COMPUTE((ks) & 1); G2WRITE(RW, ((ks) + 1) & 1); __syncthreads(); }
#define G2STEP_N(ks, RW)     { G2COMPUTE((ks) & 1); G2WRITE(RW, ((ks) + 1) & 1); __syncthreads(); }
__device__ __forceinline__ void gemm2_prefetch(const bf16_t* __restrict__ A, const bf16_t* __restrict__ Bt, int m0, int n0, Gemm2Regs& R2) {
    const int tid = ltid();
    const int r0 = tid >> 3, kc = (tid & 7) * 8;
    const bf16_t* ap0 = A + (size_t)(m0 + r0) * 1024 + kc;
    const bf16_t* bp0 = Bt + (size_t)(n0 + r0) * 1024 + kc;
    G2LOAD(a, 0); G2LOAD(b, 64); G2LOAD(c, 128);
}
__device__ __forceinline__ void gemm2_mainloop(const bf16_t* __restrict__ A, const bf16_t* __restrict__ Bt, int m0, int n0,
                                               bf16_t* lds, f32x16 (&acc)[4], Gemm2Regs& R2) {
    const int tid = ltid(), lane = tid & 63, w = tid >> 6;
    const int wm = w >> 1, wn = w & 1;
#pragma unroll
    for (int i = 0; i < 16; ++i) { acc[0][i] = 0.f; acc[1][i] = 0.f; acc[2][i] = 0.f; acc[3][i] = 0.f; }
    const int r0 = tid >> 3, kc = (tid & 7) * 8;
    const bf16_t* ap0 = A + (size_t)(m0 + r0) * 1024 + kc;
    const bf16_t* bp0 = Bt + (size_t)(n0 + r0) * 1024 + kc;
    G2WRITE(a, 0);
    __syncthreads();
    const int arow = wm * 64 + (lane & 31), brow = wn * 64 + (lane & 31), koff = (lane >> 5) * 8;
    G2STEP_L(0, a, b)  G2STEP_L(1, b, c)  G2STEP_L(2, c, a)
    G2STEP_L(3, a, b)  G2STEP_L(4, b, c)  G2STEP_L(5, c, a)
    G2STEP_L(6, a, b)  G2STEP_L(7, b, c)  G2STEP_L(8, c, a)
    G2STEP_L(9, a, b)  G2STEP_L(10, b, c) G2STEP_L(11, c, a)
    G2STEP_L(12, a, b) G2STEP_N(13, c)    G2STEP_N(14, a)
    { G2COMPUTE(1); __syncthreads(); }
}

#define ACC_ROW(wm, lane, r) ((wm) * 32 + ((r) & 3) + 8 * ((r) >> 2) + 4 * ((lane) >> 5))
#define ACC_COL(wn, lane, nt) ((wn) * 64 + (nt) * 32 + ((lane) & 31))

enum { EPI_RGIN = 0, EPI_GLAIN = 1, EPI_OUT = 2 };

__device__ __forceinline__ void phase_gemm(const Params& p, int l, int kind, float* ldsf, bool dry = false) {
    bf16_t* lds = (bf16_t*)ldsf;
    const int lane = ltid() & 63, w = ltid() >> 6, wm = w >> 1, wn = w & 1;
    const int jl = l >> 1;
    const bf16_t* A; const bf16_t* Bt; int ntn, N;
    float* PB = (float*)(p.ws + OFF_PB);
    float* X = (float*)(p.ws + OFF_X);
    if (kind == EPI_RGIN)       { A = (const bf16_t*)(p.ws + OFF_H); Bt = (const bf16_t*)(p.ws + OFF_RGWIN) + (size_t)jl * 2048 * 1024; ntn = 16; N = 2048; }
    else if (kind == EPI_GLAIN) { A = (const bf16_t*)(p.ws + OFF_H); Bt = (const bf16_t*)(p.ws + OFF_GLWIN) + (size_t)jl * 3200 * 1024; ntn = 25; N = 3104; }
    else { A = (const bf16_t*)(p.ws + OFF_Y); Bt = (l & 1) ? (const bf16_t*)(p.ws + OFF_GLWOUT) + (size_t)jl * 1024 * 1024 : (const bf16_t*)(p.ws + OFF_RGWOUT) + (size_t)jl * 1024 * 1024; ntn = 8; N = 1024; }
    const float* mods = (const float*)(p.ws + OFF_MODS) + (size_t)l * 3 * 6144;
    if (kind != EPI_RGIN) {
        const int ntn2 = (kind == EPI_GLAIN) ? 21 : ntn;
        const int ntiles2 = 24 * ntn2;
        Gemm2Regs R2;
        if ((int)blockIdx.x < ntiles2) gemm2_prefetch(A, Bt, ((int)blockIdx.x % 24) * 256, ((int)blockIdx.x / 24) * 128, R2);
#pragma unroll 1
        for (int t = blockIdx.x; t < ntiles2; t += gridDim.x) {
            const int m0 = (t % 24) * 256, n0 = (t / 24) * 128;
            f32x16 acc[4];
            gemm2_mainloop(A, Bt, m0, n0, lds, acc, R2);
            { const int tn = t + gridDim.x; if (tn < ntiles2) gemm2_prefetch(A, Bt, (tn % 24) * 256, (tn / 24) * 128, R2); }
            const int cnd = cond_of(m0);
#pragma unroll
            for (int q = 0; q < 4; ++q) {
                const int col = n0 + wn * 64 + (q & 1) * 32 + (lane & 31);
                const float gate = (kind == EPI_OUT) ? mods[cnd * 6144 + 2 * 1024 + col] : 0.f;
#pragma unroll
                for (int r = 0; r < 16; ++r) {
                    const int row = m0 + (w >> 1) * 64 + (q >> 1) * 32 + (r & 3) + 8 * (r >> 2) + 4 * (lane >> 5);
                    float v = acc[q][r];
                    if (kind == EPI_GLAIN) {
                        if (col < 512) v *= 0.08838834764831845f;
                        if (col < N) PB[(size_t)row * 3104 + col] = v;
                    } else {
                        float* Xo = dry ? PB : X;
                        Xo[(size_t)row * 1024 + col] = X[(size_t)row * 1024 + col] + gate * v;
                    }
                }
            }
        }
        if (kind == EPI_OUT) {
            if (!dry && gridDim.x == 256 && l < 3 && (int)blockIdx.x >= 192) {
#pragma unroll 1
                for (int k = 0; k < 4; ++k) setup_convert_unit(p, 256 + (l + 1) * 256 + ((int)blockIdx.x - 192) * 4 + k, true);
            }
            return;
        }
    }
    const int ntb = (kind == EPI_GLAIN) ? 21 : 0;
    const int ntiles = 48 * (ntn - ntb);
    GemmRegs R;
    if ((int)blockIdx.x < ntiles) gemm_prefetch(A, Bt, ((int)blockIdx.x % 48) * 128, (ntb + (int)blockIdx.x / 48) * 128, R);
#pragma unroll 1
    for (int t = blockIdx.x; t < ntiles; t += gridDim.x) {
        const int mt = t % 48, nt_ = ntb + t / 48;
        const int m0 = mt * 128, n0 = nt_ * 128;
        f32x16 acc[2];
        gemm_mainloop(A, Bt, m0, n0, lds, acc, R);
        { const int tn = t + gridDim.x; if (tn < ntiles) gemm_prefetch(A, Bt, (tn % 48) * 128, (ntb + tn / 48) * 128, R); }
#pragma unroll
        for (int nt = 0; nt < 2; ++nt) {
#pragma unroll
            for (int r = 0; r < 16; ++r) {
                const int row = m0 + ACC_ROW(wm, lane, r), col = n0 + ACC_COL(wn, lane, nt);
                float v = acc[nt][r];
                if (kind == EPI_RGIN) {
                    if (col < 1024) v = gelu_tanh(v);
                    PB[(size_t)row * 2048 + col] = v;
                } else if (kind == EPI_GLAIN) {
                    if (col < 512) v *= 0.08838834764831845f;
                    if (col < N) PB[(size_t)row * 3104 + col] = v;
                } else {
                    const float gate = mods[cond_of(row) * 6144 + 2 * 1024 + col];
                    float* Xo = dry ? PB : X;
                    Xo[(size_t)row * 1024 + col] = X[(size_t)row * 1024 + col] + gate * v;
                }
            }
        }
    }
}

__device__ __forceinline__ void phase_peerq(const Params& p, int l, float* ldsf) {
    bf16_t* lds = (bf16_t*)ldsf;
    const int tid = ltid(), lane = tid & 63, w = tid >> 6, wm = w >> 1, wn = w & 1;
    const bf16_t* A = (const bf16_t*)(p.ws + OFF_H);
    const bf16_t* Bt = (const bf16_t*)(p.ws + OFF_PWQ) + (size_t)l * 2048 * 1024;
    const bf16_t* PK = (const bf16_t*)(p.ws + OFF_PK) + (size_t)l * 262144;
    float* TK = (float*)(p.ws + OFF_TK);
    bf16_t* Qs = lds;
    float* Ss = ldsf + (128 * 136 * 2) / 4;
    GemmRegs R;
    if ((int)blockIdx.x < 768) gemm_prefetch(A, Bt, ((int)blockIdx.x % 48) * 128, ((int)blockIdx.x / 48) * 128, R);
#pragma unroll 1
    for (int t = blockIdx.x; t < 48 * 16; t += gridDim.x) {
        const int mt = t % 48, nt_ = t / 48;
        const int m0 = mt * 128, n0 = nt_ * 128;
        const int h = nt_ >> 1, side = nt_ & 1;
        f32x16 acc[2];
        gemm_mainloop(A, Bt, m0, n0, lds, acc, R);
        { const int tn = t + gridDim.x; if (tn < 768) gemm_prefetch(A, Bt, (tn % 48) * 128, (tn / 48) * 128, R); }
#pragma unroll
        for (int nt = 0; nt < 2; ++nt)
#pragma unroll
            for (int r = 0; r < 16; ++r)
                Qs[ACC_ROW(wm, lane, r) * 136 + ACC_COL(wn, lane, nt)] = (bf16_t)f2bf(acc[nt][r]);
        __syncthreads();
        const bf16_t* kp = PK + (size_t)(side * 8 + h) * 16384;
#pragma unroll
        for (int i = 0; i < 16; ++i) { acc[0][i] = 0.f; acc[1][i] = 0.f; }
#pragma unroll
        for (int kk = 0; kk < 8; ++kk) {
            bf16x8 a = *(const bf16x8*)(Qs + (wm * 32 + (lane & 31)) * 136 + kk * 16 + (lane >> 5) * 8);
            bf16x8 b0 = *(const bf16x8*)(kp + (wn * 64 + (lane & 31)) * 128 + kk * 16 + (lane >> 5) * 8);
            bf16x8 b1 = *(const bf16x8*)(kp + (wn * 64 + 32 + (lane & 31)) * 128 + kk * 16 + (lane >> 5) * 8);
            acc[0] = __builtin_amdgcn_mfma_f32_32x32x16_bf16(a, b0, acc[0], 0, 0, 0);
            acc[1] = __builtin_amdgcn_mfma_f32_32x32x16_bf16(a, b1, acc[1], 0, 0, 0);
        }
#pragma unroll
        for (int nt = 0; nt < 2; ++nt)
#pragma unroll
            for (int r = 0; r < 16; ++r)
                Ss[ACC_ROW(wm, lane, r) * 129 + ACC_COL(wn, lane, nt)] = acc[nt][r];
        __syncthreads();
        {
            const int row = tid & 127, part = tid >> 7;
            float v[16];
#pragma unroll
            for (int j = 0; j < 16; ++j) v[j] = -3.0e38f;
            const float* sr = Ss + row * 129 + part * 32;
#pragma unroll 4
            for (int n = 0; n < 32; ++n) {
                float x = __uint_as_float((__float_as_uint(sr[n]) & 0xffffff80u) | (unsigned)(part * 32 + n));
#pragma unroll
                for (int j = 15; j >= 1; --j) v[j] = __builtin_amdgcn_fmed3f(x, v[j - 1], v[j]);
                v[0] = fmaxf(x, v[0]);
            }
            float* mg = ldsf;
#define TOPK_MERGE() { \
                _Pragma("unroll") for (int j = 0; j < 16; ++j) v[j] = fmaxf(v[j], o[15 - j]); \
                _Pragma("unroll") for (int dd = 8; dd >= 1; dd >>= 1) { \
                    _Pragma("unroll") for (int i = 0; i < 16; ++i) { if ((i & dd) == 0) { const float hi_ = fmaxf(v[i], v[i + dd]), lo_ = fminf(v[i], v[i + dd]); v[i] = hi_; v[i + dd] = lo_; } } } }
            __syncthreads();
            if (part & 1) {
#pragma unroll
                for (int j = 0; j < 16; ++j) mg[((part >> 1) * 128 + row) * 17 + j] = v[j];
            }
            __syncthreads();
            if (!(part & 1)) {
                float o[16];
#pragma unroll
                for (int j = 0; j < 16; ++j) o[j] = mg[((part >> 1) * 128 + row) * 17 + j];
                TOPK_MERGE()
            }
            __syncthreads();
            if (part == 2) {
#pragma unroll
                for (int j = 0; j < 16; ++j) mg[row * 17 + j] = v[j];
            }
            __syncthreads();
            if (part == 0) {
                float o[16];
#pragma unroll
                for (int j = 0; j < 16; ++j) o[j] = mg[row * 17 + j];
                TOPK_MERGE()
                float4* og = (float4*)(TK + ((size_t)(m0 + row) * 16 + h * 2 + side) * 16);
                og[0] = make_float4(v[0], v[1], v[2], v[3]); og[1] = make_float4(v[4], v[5], v[6], v[7]);
                og[2] = make_float4(v[8], v[9], v[10], v[11]); og[3] = make_float4(v[12], v[13], v[14], v[15]);
            }
        }
        __syncthreads();
    }
}

__device__ __forceinline__ void conv_row(int l, int gw, int st, int& tab, int& r) {
    const int rid = 16384 + gw * 8 + st; tab = rid >> 14; r = (l + 1) * 16384 + (rid & 16383);
}
__device__ __forceinline__ void phase_peer_gather(const Params& p, int l, float* ldsf, bool dry = false) {
    const int tid = ltid(), lane = tid & 63, w = tid >> 6;
    int* eidL = (int*)ldsf;
    float* gateL = ldsf + 24 * 128;
    float* suL = ldsf + 48 * 128;
    float* wL = ldsf + 72 * 128 + w * 384;
    int* cntL = (int*)(ldsf + 96 * 128);
    int* baseL = cntL + 192 * 16;
    int* eidU = baseL + 24 * 16;
    float* gateU = (float*)(eidU + 24 * 128);
    const float* TK = (const float*)(p.ws + OFF_TK);
    float* X = (float*)(p.ws + OFF_X);
    bf16_t* H = (bf16_t*)(p.ws + OFF_H);
    float* Xw = dry ? (float*)(p.ws + OFF_PB) : X;
    bf16_t* Hw = dry ? (bf16_t*)(p.ws + OFF_PB + (size_t)TTOK * DM * 4) : H;
    float* Yw = dry ? (float*)(p.ws + OFF_PB) : p.out + OUT_Y;
    const unsigned char* PU = p.ws + OFF_PU + (size_t)l * 16384 * 1024;
    const unsigned char* PV = p.ws + OFF_PV + (size_t)l * 16384 * 1024;
    const float* SU = (const float*)(p.ws + OFF_SU) + l * 16384;
    const float* SV = (const float*)(p.ws + OFF_SV) + l * 16384;
    const float* mods = (const float*)(p.ws + OFF_MODS) + (size_t)l * 3 * 6144;
    for (int sg = blockIdx.x; sg < 256; sg += gridDim.x) {
        const int t0 = sg * 24;
        const bool defer = (l == 1) && (gridDim.x == 256) && !dry;
        f32x4 cv0, cv1, cv2, cv3;
        cv0 = cv1 = cv2 = cv3 = (f32x4){0.f, 0.f, 0.f, 0.f};
#define CONV_ISSUE(st_) { if (defer) { int tab_, r_; conv_row(l, (int)blockIdx.x * 8 + w, (st_), tab_, r_); \
            const float* src_ = p.in[tab_ ? I_PV : I_PU] + (size_t)r_ * 1024 + lane * 4; \
            cv0 = __builtin_nontemporal_load((const f32x4*)src_); cv1 = __builtin_nontemporal_load((const f32x4*)(src_ + 256)); \
            cv2 = __builtin_nontemporal_load((const f32x4*)(src_ + 512)); cv3 = __builtin_nontemporal_load((const f32x4*)(src_ + 768)); } }
#define CONV_Q(v_) ({ int pk_ = 0; pk_ = __builtin_amdgcn_cvt_pk_fp8_f32((v_)[0] * inv_, (v_)[1] * inv_, pk_, false); \
            pk_ = __builtin_amdgcn_cvt_pk_fp8_f32((v_)[2] * inv_, (v_)[3] * inv_, pk_, true); (unsigned)pk_; })
#define CONV_AM(v_) fmaxf(fmaxf(fabsf((v_)[0]), fabsf((v_)[1])), fmaxf(fabsf((v_)[2]), fabsf((v_)[3])))
#define CONV_FINISH(st_) { if (defer) { int tab_, r_; conv_row(l, (int)blockIdx.x * 8 + w, (st_), tab_, r_); \
            float am_ = fmaxf(fmaxf(CONV_AM(cv0), CONV_AM(cv1)), fmaxf(CONV_AM(cv2), CONV_AM(cv3))); \
            _Pragma("unroll") for (int o_ = 32; o_ >= 1; o_ >>= 1) am_ = fmaxf(am_, __shfl_xor(am_, o_)); \
            const float scale_ = am_ > 0.f ? am_ * (1.0f / 448.0f) : 1.0f; const float inv_ = 1.0f / scale_; \
            const u32x4 ov_ = {CONV_Q(cv0), CONV_Q(cv1), CONV_Q(cv2), CONV_Q(cv3)}; \
            __builtin_nontemporal_store(ov_, (u32x4*)(p.ws + (tab_ ? OFF_PV : OFF_PU) + (size_t)r_ * 1024 + lane * 16)); \
            if (lane == 0) ((float*)(p.ws + (tab_ ? OFF_SV : OFF_SU)))[r_] = scale_; } }
        f32x2 xf2[3][8];
#pragma unroll
        for (int tt = 0; tt < 3; ++tt) {
            const int tok = t0 + w + tt * 8;
#pragma unroll
            for (int q = 0; q < 4; ++q) {
                uint2 hv = *(const uint2*)(H + (size_t)tok * 1024 + q * 256 + lane * 4);
                xf2[tt][q * 2] = (f32x2){bflo(hv.x), bfhi(hv.x)}; xf2[tt][q * 2 + 1] = (f32x2){bflo(hv.y), bfhi(hv.y)};
            }
        }
        __syncthreads();
        const int ctl = tid >> 3, ch = tid & 7;
        if (tid < 192) {
            const float* tk = TK + ((size_t)(t0 + ctl) * 16 + ch * 2) * 16;
            float v1[16], v2[16];
#pragma unroll
            for (int j = 0; j < 4; ++j) {
                float4 a = *(const float4*)(tk + j * 4), b = *(const float4*)(tk + 16 + j * 4);
                v1[j * 4] = a.x; v1[j * 4 + 1] = a.y; v1[j * 4 + 2] = a.z; v1[j * 4 + 3] = a.w;
                v2[j * 4] = b.x; v2[j * 4 + 1] = b.y; v2[j * 4 + 2] = b.z; v2[j * 4 + 3] = b.w;
            }
            int* idxL = (int*)(gateU + 24 * 128) + tid * 32;
#pragma unroll
            for (int j = 0; j < 16; ++j) {
                idxL[j] = (int)(__float_as_uint(v1[j]) & 127u); idxL[16 + j] = (int)(__float_as_uint(v2[j]) & 127u);
                v1[j] = __uint_as_float(__float_as_uint(v1[j]) & 0xffffff80u);
                v2[j] = __uint_as_float(__float_as_uint(v2[j]) & 0xffffff80u);
            }
            float top[16];
#pragma unroll
            for (int j = 0; j < 16; ++j) top[j] = -3.0e38f;
#pragma unroll
            for (int a = 0; a < 16; ++a) {
#pragma unroll
                for (int b = 0; b < 16; ++b) {
                    if ((a + 1) * (b + 1) <= 16) {
                        float sm = v1[a] + v2[b];
                        float x = __uint_as_float((__float_as_uint(sm) & 0xffffff00u) | (unsigned)(a * 16 + b));
#pragma unroll
                        for (int j = 15; j >= 1; --j) top[j] = __builtin_amdgcn_fmed3f(x, top[j - 1], top[j]);
                        top[0] = fmaxf(x, top[0]);
                    }
                }
            }
            const float mx = __uint_as_float(__float_as_uint(top[0]) & 0xffffff00u);
            float gg[16]; float sum = 0.f;
#pragma unroll
            for (int j = 0; j < 16; ++j) {
                float sv = __uint_as_float(__float_as_uint(top[j]) & 0xffffff00u);
                gg[j] = __expf(sv - mx); sum += gg[j];
            }
            const float inv = 1.0f / sum;
            int* myc = cntL + tid * 16;
#pragma unroll
            for (int b = 0; b < 16; ++b) myc[b] = 0;
            int eu[16];
#pragma unroll
            for (int j = 0; j < 16; ++j) {
                const unsigned ab = __float_as_uint(top[j]) & 0xffu;
                const int e = idxL[ab >> 4] * 128 + idxL[16 + (ab & 15u)];
                const int b = e >> 10;
                const int r = myc[b]; myc[b] = r + 1;
                eu[j] = e | (r << 16);
            }
#pragma unroll
            for (int j = 0; j < 16; ++j) { eidU[ctl * 128 + ch * 16 + j] = eu[j]; }
#pragma unroll
            for (int j = 0; j < 16; ++j) gg[j] *= inv;
#pragma unroll
            for (int j = 0; j < 16; ++j) gateU[ctl * 128 + ch * 16 + j] = gg[j];
        }
        __syncthreads();
        if (tid < 384) {
            const int tl = tid >> 4, b = tid & 15;
            int run = 0;
#pragma unroll
            for (int hh = 0; hh < 8; ++hh) { int* c = cntL + (tl * 8 + hh) * 16 + b; const int v = *c; *c = run; run += v; }
            baseL[tl * 16 + b] = run;
        }
        __syncthreads();
        if (tid < 24) {
            int run = 0;
#pragma unroll
            for (int b = 0; b < 16; ++b) { const int v = baseL[tid * 16 + b]; baseL[tid * 16 + b] = run; run += v; }
        }
        __syncthreads();
        if (tid < 192) {
#pragma unroll 4
            for (int j = 0; j < 16; ++j) {
                const int pk = eidU[ctl * 128 + ch * 16 + j];
                const int e = pk & 0xffff, r = pk >> 16, b = e >> 10;
                const int pos = baseL[ctl * 16 + b] + cntL[tid * 16 + b] + r;
                eidL[ctl * 128 + pos] = e;
                gateL[ctl * 128 + pos] = gateU[ctl * 128 + ch * 16 + j] * SV[e];
                suL[ctl * 128 + pos] = SU[e];
            }
        }
        __syncthreads();
        int ecur[3][8];
#pragma unroll
        for (int tt = 0; tt < 3; ++tt)
#pragma unroll
            for (int j = 0; j < 8; ++j) ecur[tt][j] = __builtin_amdgcn_readfirstlane(eidL[(w + tt * 8) * 128 + j]);
#pragma unroll 1
        for (int bt = 0; bt < 16; ++bt) {
            u32x4 ua[3][8];
#pragma unroll
            for (int tt = 0; tt < 3; ++tt) {
#pragma unroll
                for (int j = 0; j < 8; ++j) ua[tt][j] = *(const u32x4*)(PU + (size_t)ecur[tt][j] * 1024 + lane * 16);
            }
            {
                const int bn = (bt + 1) & 15;
#pragma unroll
                for (int tt = 0; tt < 3; ++tt)
#pragma unroll
                    for (int j = 0; j < 8; ++j) ecur[tt][j] = __builtin_amdgcn_readfirstlane(eidL[(w + tt * 8) * 128 + bn * 8 + j]);
            }
#pragma unroll
            for (int tt = 0; tt < 3; ++tt) {
                const int tl = w + tt * 8;
                float pp[8];
#pragma unroll
                for (int j = 0; j < 8; ++j) {
                    f32x2 sv = {0.f, 0.f};
#pragma unroll
                    for (int q = 0; q < 4; ++q) {
                        f32x2 lo = __builtin_amdgcn_cvt_pk_f32_fp8((int)ua[tt][j][q], false);
                        f32x2 hi = __builtin_amdgcn_cvt_pk_f32_fp8((int)ua[tt][j][q], true);
                        sv = xf2[tt][q * 2] * lo + sv;
                        sv = xf2[tt][q * 2 + 1] * hi + sv;
                    }
                    pp[j] = sv[0] + sv[1];
                }
                float q4[4], q2[2], s1;
                {
                    const bool hi = (lane & 32) != 0;
#pragma unroll
                    for (int i = 0; i < 4; ++i) { float a = pp[2 * i], b = pp[2 * i + 1]; float send = hi ? a : b, keep = hi ? b : a; q4[i] = keep + __shfl_xor(send, 32); }
                }
                {
                    const bool hi = (lane & 16) != 0;
#pragma unroll
                    for (int i = 0; i < 2; ++i) { float a = q4[2 * i], b = q4[2 * i + 1]; float send = hi ? a : b, keep = hi ? b : a; q2[i] = keep + __shfl_xor(send, 16); }
                }
                {
                    const bool hi = (lane & 8) != 0;
                    float a = q2[0], b = q2[1]; float send = hi ? a : b, keep = hi ? b : a; s1 = keep + __shfl_xor(send, 8);
                }
                s1 += __shfl_xor(s1, 4); s1 += __shfl_xor(s1, 2); s1 += __shfl_xor(s1, 1);
                const int jj = ((lane >> 5) & 1) + 2 * ((lane >> 4) & 1) + 4 * ((lane >> 3) & 1);
                if ((lane & 7) == 0) wL[tt * 128 + bt * 8 + jj] = gateL[tl * 128 + bt * 8 + jj] * gelu_tanh(s1 * suL[tl * 128 + bt * 8 + jj]);
            }
        }
        f32x2 acc2[3][8];
#pragma unroll
        for (int tt = 0; tt < 3; ++tt)
#pragma unroll
            for (int j = 0; j < 8; ++j) acc2[tt][j] = (f32x2){0.f, 0.f};
        CONV_ISSUE(0)
#pragma unroll 1
        for (int bt = 0; bt < 16; ++bt) {
            u32x4 va[3][8];
#pragma unroll
            for (int tt = 0; tt < 3; ++tt) {
#pragma unroll
                for (int j = 0; j < 8; ++j) va[tt][j] = *(const u32x4*)(PV + (size_t)ecur[tt][j] * 1024 + lane * 16);
            }
            {
                const int bn = (bt + 1) & 15;
#pragma unroll
                for (int tt = 0; tt < 3; ++tt)
#pragma unroll
                    for (int j = 0; j < 8; ++j) ecur[tt][j] = __builtin_amdgcn_readfirstlane(eidL[(w + tt * 8) * 128 + bn * 8 + j]);
            }
#pragma unroll
            for (int tt = 0; tt < 3; ++tt) {
#pragma unroll
                for (int j = 0; j < 8; ++j) {
                    const float wj = wL[tt * 128 + bt * 8 + j];
                    const f32x2 wj2 = {wj, wj};
#pragma unroll
                    for (int q = 0; q < 4; ++q) {
                        f32x2 lo = __builtin_amdgcn_cvt_pk_f32_fp8((int)va[tt][j][q], false);
                        f32x2 hi = __builtin_amdgcn_cvt_pk_f32_fp8((int)va[tt][j][q], true);
                        acc2[tt][q * 2] = wj2 * lo + acc2[tt][q * 2];
                        acc2[tt][q * 2 + 1] = wj2 * hi + acc2[tt][q * 2 + 1];
                    }
                }
            }
            if (bt < 8) CONV_FINISH(bt)
            if (bt + 1 < 8) CONV_ISSUE(bt + 1)
        }
        int oz2 = 0; asm volatile("" : "+v"(oz2));
#pragma unroll
        for (int tt = 0; tt < 3; ++tt) {
            const int lane = (ltid() & 63) + oz2, w = (ltid() >> 6) + oz2;
            const int tok = t0 + w + tt * 8;
            float* xr = X + (size_t)tok * 1024;
            const float* m5 = mods + cond_of(tok) * 6144 + 5 * 1024;
            float x[16];
#pragma unroll
            for (int q = 0; q < 4; ++q) {
                float4 a = *(const float4*)(xr + q * 256 + lane * 4);
                float4 g = *(const float4*)(m5 + q * 256 + lane * 4);
                x[q * 4] = a.x + g.x * acc2[tt][q * 2][0]; x[q * 4 + 1] = a.y + g.y * acc2[tt][q * 2][1];
                x[q * 4 + 2] = a.z + g.z * acc2[tt][q * 2 + 1][0]; x[q * 4 + 3] = a.w + g.w * acc2[tt][q * 2 + 1][1];
            }
            float ss = 0.f;
#pragma unroll
            for (int j = 0; j < 16; ++j) ss += x[j] * x[j];
            ss = wave_sum(ss);
            const float rs = rsqrtf(ss * (1.0f / 1024.0f) + EPSV);
            if (l < 3) {
                float* xw = Xw + (size_t)tok * 1024;
                const float* modn = (const float*)(p.ws + OFF_MODS) + (size_t)(l + 1) * 3 * 6144 + cond_of(tok) * 6144;
                const float* g1 = p.in[I_N1G] + (l + 1) * 1024;
                bf16_t* hw = Hw + (size_t)tok * 1024;
#pragma unroll
                for (int q = 0; q < 4; ++q) {
                    const int d0 = q * 256 + lane * 4;
                    *(float4*)(xw + d0) = make_float4(x[q * 4], x[q * 4 + 1], x[q * 4 + 2], x[q * 4 + 3]);
                    float4 g = *(const float4*)(g1 + d0), sh = *(const float4*)(modn + d0), sc = *(const float4*)(modn + 1024 + d0);
                    float o0 = (x[q * 4] * rs * g.x) * (1.0f + sc.x) + sh.x, o1 = (x[q * 4 + 1] * rs * g.y) * (1.0f + sc.y) + sh.y;
                    float o2 = (x[q * 4 + 2] * rs * g.z) * (1.0f + sc.z) + sh.z, o3 = (x[q * 4 + 3] * rs * g.w) * (1.0f + sc.w) + sh.w;
                    *(uint2*)(hw + d0) = make_uint2(pack2(o0, o1), pack2(o2, o3));
                }
            } else {
                const float* g = p.in[I_FNG];
                float* yo = Yw + (size_t)tok * 1024;
#pragma unroll
                for (int q = 0; q < 4; ++q) {
                    const int d0 = q * 256 + lane * 4;
                    float4 g0 = *(const float4*)(g + d0);
                    *(float4*)(yo + d0) = make_float4(x[q * 4] * rs * g0.x, x[q * 4 + 1] * rs * g0.y, x[q * 4 + 2] * rs * g0.z, x[q * 4 + 3] * rs * g0.w);
                }
            }
        }
    }
}

#define RG_XS 68
#define RG_RS 257
__device__ __forceinline__ void rg_unit(const Params& p, int l, int seq, int n, int ct, float* lds) {
    const int tid0 = ltid(), lane0 = tid0 & 63, w0 = tid0 >> 6;
    const int jl = l >> 1;
    const int L = seq < 16 ? 256 : 1024;
    const int tokbase = seq < 16 ? seq * 256 : 4096 + (seq - 16) * 1024;
    const int nsteps = L >> 8;
    const int cbase = n * 64, obase = cbase + ct * 32;
    float* xr = lds;
    float* aS = lds + 256 * RG_XS;
    float* bS = aS + 32 * RG_RS;
    float* segA = bS + 32 * RG_RS;
    float* segB = segA + 512;
    bf16_t* wS = (bf16_t*)(segB + 512);
    const float* PB = (const float*)(p.ws + OFF_PB);
    float* HF = (float*)(p.ws + OFF_HF);
    bf16_t* Y = (bf16_t*)(p.ws + OFF_Y);
    const int cg0 = tid0 & 15, tr0 = tid0 >> 4;
    f32x4 cwv[4]; f32x4 cbv;
    {
        const float* cw = p.in[I_RGCW] + jl * 4096 + cbase + cg0 * 4;
#pragma unroll
        for (int j = 0; j < 4; ++j) cwv[j] = *(const f32x4*)(cw + j * 1024);
        cbv = *(const f32x4*)(p.in[I_RGCB] + jl * 1024 + cbase + cg0 * 4);
    }
    const int sc0 = tid0 & 31, sg0 = tid0 >> 5;
    f32x4 rw[11];
#define RG_ISSUE(pb_) { const int pos0_ = (pb_) + tr * 8 - 2; \
        _Pragma("unroll") for (int j = 0; j < 11; ++j) { const int pp_ = pos0_ + j; \
            f32x4 z_ = {0.f, 0.f, 0.f, 0.f}; if (pp_ >= 0 && pp_ < L) z_ = *(const f32x4*)(PB + (size_t)(tokbase + pp_) * 2048 + 1024 + cbase + cg * 4); rw[j] = z_; } }
    { const int tr = tr0, cg = cg0; RG_ISSUE(0) }
    float hfreg[16];
#pragma unroll
    for (int j = 0; j < 16; ++j) hfreg[j] = 0.f;
    __syncthreads();
#pragma unroll 1
    for (int d = 0; d < 2; ++d) {
        const int m = (jl * 2 + d) * 16 + n;
        const bf16_t* WT = (const bf16_t*)(p.ws + OFF_RGW) + (size_t)m * 2 * 4096;
        {
            const int g_ = tid0 >> 8, j_ = (tid0 >> 3) & 31, k8 = (tid0 & 7) * 8;
            *(u32x4*)(wS + (g_ * 32 + j_) * 72 + k8) = *(const u32x4*)(WT + g_ * 4096 + (ct * 32 + j_) * 64 + k8);
        }
        const int cch = obase + (lane0 & 31);
        const float bav = p.in[I_RGBA][(jl * 2 + d) * 1024 + cch];
        const float biv = p.in[I_RGBI][(jl * 2 + d) * 1024 + cch];
        const float spv = __logf(1.0f + __expf(-p.in[I_RGLAM][(jl * 2 + d) * 1024 + cch]));
        float hc = 0.f;
        if (seq >= 16) hc = p.in[I_SRG][(((seq - 16) * 2 + jl) * 2 + d) * 1024 + obase + sc0];
#pragma unroll 1
        for (int st = 0; st < nsteps; ++st) {
            const int pbase = d ? (L - 256 - st * 256) : st * 256;
            int oz = 0; asm volatile("" : "+v"(oz));
            const int lane = lane0 + oz, w = w0 + oz, tid = tid0 + oz;
            const int cg = tid & 15, tr = tid >> 4, sc = tid & 31, sg = tid >> 5, tt = tid >> 1, half = tid & 1;
            if (!(nsteps == 1 && d == 1)) {
#pragma unroll
                for (int t = 0; t < 8; ++t) {
                    f32x4 o = cbv + cwv[0] * rw[t] + cwv[1] * rw[t + 1] + cwv[2] * rw[t + 2] + cwv[3] * rw[t + 3];
                    *(f32x4*)(xr + (tr * 8 + t) * RG_XS + cg * 4) = o;
                }
                if (nsteps > 1) {
                    int nd = d, nst = st + 1;
                    if (nst == nsteps) { nd = d + 1; nst = 0; }
                    if (nd < 2) { const int npb = nd ? (L - 256 - nst * 256) : nst * 256; RG_ISSUE(npb) }
                }
            }
            __syncthreads();
            f32x16 accR, accI;
#pragma unroll
            for (int i = 0; i < 16; ++i) { accR[i] = 0.f; accI[i] = 0.f; }
#pragma unroll
            for (int kk = 0; kk < 4; ++kk) {
                const float* ap = xr + (w * 32 + (lane & 31)) * RG_XS + kk * 16 + (lane >> 5) * 8;
                const float4 x0 = *(const float4*)ap, x1 = *(const float4*)(ap + 4);
                union { bf16x8 v; unsigned u[4]; } af;
                af.u[0] = pack2(x0.x, x0.y); af.u[1] = pack2(x0.z, x0.w); af.u[2] = pack2(x1.x, x1.y); af.u[3] = pack2(x1.z, x1.w);
                const bf16x8 bRk = *(const bf16x8*)(wS + (lane & 31) * 72 + kk * 16 + (lane >> 5) * 8);
                const bf16x8 bIk = *(const bf16x8*)(wS + (32 + (lane & 31)) * 72 + kk * 16 + (lane >> 5) * 8);
                accR = __builtin_amdgcn_mfma_f32_32x32x16_bf16(af.v, bRk, accR, 0, 0, 0);
                accI = __builtin_amdgcn_mfma_f32_32x32x16_bf16(af.v, bIk, accI, 0, 0, 0);
            }
#pragma unroll
            for (int r = 0; r < 16; ++r) {
                const int row = w * 32 + (r & 3) + 8 * (r >> 2) + 4 * (lane >> 5);
                const float rg = sigmoidf_(accR[r] + bav);
                const float ig = sigmoidf_(accI[r] + biv);
                const float av = __expf(-8.0f * rg * spv);
                const float mult = sqrtf(fmaxf(1.0f - av * av, 0.f));
                const float xc = xr[row * RG_XS + ct * 32 + (lane & 31)];
                const int s_ = d ? 255 - row : row;
                aS[(lane & 31) * RG_RS + s_] = av;
                bS[(lane & 31) * RG_RS + s_] = mult * ig * xc;
            }
            const int tok = tokbase + pbase + tt;
            f32x4 gq[4], hq[4];
            if (d == 1) {
                const float* gp = PB + (size_t)tok * 2048 + obase + half * 16;
#pragma unroll
                for (int j = 0; j < 4; ++j) gq[j] = *(const f32x4*)(gp + j * 4);
                if (nsteps > 1) {
                    const float* hp = HF + (size_t)tok * 1024 + obase + half * 16;
#pragma unroll
                    for (int j = 0; j < 4; ++j) hq[j] = *(const f32x4*)(hp + j * 4);
                }
            }
            __syncthreads();
            {
                const int base = sc * RG_RS + sg * 16;
                float av[16], bv[16];
                float Aa = 1.f, Bb = 0.f;
#pragma unroll
                for (int i = 0; i < 16; ++i) { av[i] = aS[base + i]; bv[i] = bS[base + i]; Bb = av[i] * Bb + bv[i]; Aa *= av[i]; }
                segA[sg * 32 + sc] = Aa; segB[sg * 32 + sc] = Bb;
                __syncthreads();
                float hin = hc, hall = hc;
#pragma unroll
                for (int g = 0; g < 16; ++g) {
                    const float sa = segA[g * 32 + sc], sb = segB[g * 32 + sc];
                    hall = sa * hall + sb;
                    if (g < sg) hin = hall;
                }
                float hcur = hin;
#pragma unroll
                for (int i = 0; i < 16; ++i) { hcur = av[i] * hcur + bv[i]; bS[base + i] = hcur; }
                hc = hall;
            }
            __syncthreads();
            {
                const int s_ = d ? 255 - tt : tt;
                float hv[16];
#pragma unroll
                for (int j = 0; j < 16; ++j) hv[j] = bS[(half * 16 + j) * RG_RS + s_];
                if (d == 0) {
                    if (nsteps == 1) {
#pragma unroll
                        for (int j = 0; j < 16; ++j) hfreg[j] = hv[j];
                    } else {
                        float* hp = HF + (size_t)tok * 1024 + obase + half * 16;
#pragma unroll
                        for (int j = 0; j < 4; ++j) *(float4*)(hp + j * 4) = make_float4(hv[4 * j], hv[4 * j + 1], hv[4 * j + 2], hv[4 * j + 3]);
                    }
                } else {
                    float hf[16];
                    if (nsteps == 1) {
#pragma unroll
                        for (int j = 0; j < 16; ++j) hf[j] = hfreg[j];
                    } else {
#pragma unroll
                        for (int j = 0; j < 4; ++j) { hf[4 * j] = hq[j][0]; hf[4 * j + 1] = hq[j][1]; hf[4 * j + 2] = hq[j][2]; hf[4 * j + 3] = hq[j][3]; }
                    }
                    unsigned o[8];
#pragma unroll
                    for (int j = 0; j < 4; ++j) {
                        o[2 * j] = pack2(gq[j][0] * (hf[4 * j] + hv[4 * j]), gq[j][1] * (hf[4 * j + 1] + hv[4 * j + 1]));
                        o[2 * j + 1] = pack2(gq[j][2] * (hf[4 * j + 2] + hv[4 * j + 2]), gq[j][3] * (hf[4 * j + 3] + hv[4 * j + 3]));
                    }
                    bf16_t* yp = Y + (size_t)tok * 1024 + obase + half * 16;
                    *(uint4*)yp = make_uint4(o[0], o[1], o[2], o[3]);
                    *(uint4*)(yp + 8) = make_uint4(o[4], o[5], o[6], o[7]);
                }
            }
        }
        if (seq < 16 && sg0 == 0)
            p.out[OUT_RG + ((seq * 2 + jl) * 2 + d) * 1024 + obase + sc0] = hc;
    }
}

__device__ __forceinline__ void phase_rgscan(const Params& p, int l, float* lds) {
    const int b = blockIdx.x, G = gridDim.x;
    int u, stride, end;
    if (G == 256) { if (b < 64) { u = b; stride = 1024; end = 64; } else { u = 64 + (b - 64); stride = 192; end = 576; } }
    else { u = b; stride = G; end = 576; }
#pragma unroll 1
    for (; u < end; u += stride) {
        int seq, rest;
        if (u < 64) { seq = 16 + (u >> 5); rest = u & 31; } else { seq = (u - 64) >> 5; rest = (u - 64) & 31; }
        rg_unit(p, l, seq, rest >> 1, rest & 1, lds);
    }
    if (G == 256 && b >= 192 && l < 3) {
#pragma unroll 1
        for (int k = 0; k < 4; ++k) setup_convert_unit(p, 256 + 1024 + (l + 1) * 256 + (b - 192) * 4 + k, true);
    }
}

__device__ __forceinline__ int gla_tok(int seq, int d, int sidx) {
    if (seq < 16) { int pp = d ? 255 - sidx : sidx; return seq * 256 + pp; }
    int pp = d ? 1023 - sidx : sidx;
    return 4096 + (seq - 16) * 1024 + ((pp & 15) << 6) + (pp >> 4);
}

__device__ __forceinline__ int gla_uidx(int seq, int c, int h, int d) {
    const int cg = seq < 16 ? seq * 4 + c : 64 + (seq - 16) * 16 + c;
    return (cg * 4 + h) * 2 + d;
}

__device__ __forceinline__ void gla_pre_unit(const Params& p, int l, int seq, int h, int d, int c, float* ldsf) {
    const int tid = ltid(), lane = tid & 63, w = tid >> 6;
    const int jl = l >> 1;
    float* zs = ldsf;
    float* tot = ldsf + 1024;
    float* gd = ldsf + 1536;
    bf16_t* qin = (bf16_t*)(ldsf + 1664);
    bf16_t* kin = qin + 64 * 136;
    bf16_t* kinT = kin + 64 * 136;
    bf16_t* att = kinT + 128 * 72;
    bf16_t* vT = att + 64 * 72;
    const float* PB = (const float*)(p.ws + OFF_PB);
    float* O = (float*)(p.ws + (d ? OFF_HB : OFF_HF));
    const int uidx = gla_uidx(seq, c, h, d);
    const int kk = tid & 127, ig = tid >> 7;
    const int dvv = tid & 63, i8 = tid >> 6;
    float4 zreg = make_float4(0.f, 0.f, 0.f, 0.f);
    float qreg[16], kreg[16];
    if (tid < 256) { const int tok_ = gla_tok(seq, d, c * 64 + (tid >> 2)); zreg = *(const float4*)(PB + (size_t)tok_ * 3104 + 3072 + d * 16 + (tid & 3) * 4); }
#pragma unroll
    for (int ii = 0; ii < 16; ++ii) {
        const int tok_ = gla_tok(seq, d, c * 64 + ig * 16 + ii);
        qreg[ii] = PB[(size_t)tok_ * 3104 + h * 128 + kk]; kreg[ii] = PB[(size_t)tok_ * 3104 + 512 + h * 128 + kk];
    }
    f32x2 wal2[8];
#pragma unroll
    for (int r = 0; r < 8; ++r) {
        wal2[r][0] = p.in[I_GLWAL][((size_t)(jl * 2 + d) * 16 + 2 * r) * 512 + h * 128 + kk];
        wal2[r][1] = p.in[I_GLWAL][((size_t)(jl * 2 + d) * 16 + 2 * r + 1) * 512 + h * 128 + kk];
    }
    const float bal = p.in[I_GLBAL][(jl * 2 + d) * 512 + h * 128 + kk];
    __syncthreads();
    if (tid < 256) *(float4*)(zs + (tid >> 2) * 16 + (tid & 3) * 4) = zreg;
    {
        float vreg[4][8];
#pragma unroll
        for (int ii = 0; ii < 8; ++ii) {
            const int tok_ = gla_tok(seq, d, c * 64 + i8 * 8 + ii);
#pragma unroll
            for (int g = 0; g < 4; ++g) vreg[g][ii] = PB[(size_t)tok_ * 3104 + 1024 + h * 256 + g * 64 + dvv];
        }
#pragma unroll
        for (int g = 0; g < 4; ++g)
            *(uint4*)(vT + (g * 64 + dvv) * 72 + i8 * 8) = make_uint4(pack2(vreg[g][0], vreg[g][1]), pack2(vreg[g][2], vreg[g][3]), pack2(vreg[g][4], vreg[g][5]), pack2(vreg[g][6], vreg[g][7]));
    }
    __syncthreads();
    float cum[16]; float run = 0.f;
#pragma unroll
    for (int ii = 0; ii < 16; ++ii) {
        const int i = ig * 16 + ii;
        const f32x4 z0 = *(const f32x4*)(zs + i * 16), z1 = *(const f32x4*)(zs + i * 16 + 4), z2 = *(const f32x4*)(zs + i * 16 + 8), z3 = *(const f32x4*)(zs + i * 16 + 12);
        f32x2 xa = z0.xy * wal2[0];
        xa = z0.zw * wal2[1] + xa; xa = z1.xy * wal2[2] + xa; xa = z1.zw * wal2[3] + xa;
        xa = z2.xy * wal2[4] + xa; xa = z2.zw * wal2[5] + xa; xa = z3.xy * wal2[6] + xa; xa = z3.zw * wal2[7] + xa;
        const float x = bal + xa[0] + xa[1];
        const float ls = fminf(x, 0.f) - __logf(1.0f + __expf(-fabsf(x)));
        run += ls * 0.0625f; cum[ii] = run;
    }
    tot[ig * 128 + kk] = run;
    __syncthreads();
    float off = 0.f, blast = 0.f;
#pragma unroll
    for (int g = 0; g < 4; ++g) { const float tv = tot[g * 128 + kk]; blast += tv; if (g < ig) off += tv; }
    if (ig == 0) { const float gv = __expf(blast); ((float*)(p.ws + OFF_GD))[(size_t)uidx * 128 + kk] = gv; }
    {
        unsigned kp[8];
#pragma unroll
        for (int ii = 0; ii < 16; ++ii) {
            const int i = ig * 16 + ii;
            const float bc = off + cum[ii];
            const unsigned qk = pack2(qreg[ii] * __expf(bc), kreg[ii] * __expf(-bc));
            const unsigned qb = qk & 0xffffu, kb = qk >> 16;
            qin[i * 136 + kk] = (bf16_t)qb;
            kin[i * 136 + kk] = (bf16_t)kb;
            if (ii & 1) kp[ii >> 1] |= kb << 16; else kp[ii >> 1] = kb;
        }
        *(uint4*)(kinT + kk * 72 + ig * 16) = make_uint4(kp[0], kp[1], kp[2], kp[3]);
        *(uint4*)(kinT + kk * 72 + ig * 16 + 8) = make_uint4(kp[4], kp[5], kp[6], kp[7]);
    }
    __syncthreads();
    {
        const uint4* qs = (const uint4*)qin;
        uint4* qg = (uint4*)(p.ws + OFF_QIN + (size_t)uidx * 64 * 136 * 2);
        for (int i = tid; i < 1088; i += NTHR) qg[i] = qs[i];
    }
    const int mt = w >> 1;
    const int l15 = lane & 15, l4 = lane >> 4;
#pragma unroll
    for (int nn = 0; nn < 2; ++nn) {
        const int nt = (w & 1) * 2 + nn;
        f32x4 acc = {0.f, 0.f, 0.f, 0.f};
        if (nt <= mt) {
#pragma unroll
            for (int ks = 0; ks < 4; ++ks) {
                bf16x8 a = *(const bf16x8*)(qin + (mt * 16 + l15) * 136 + ks * 32 + l4 * 8);
                bf16x8 b = *(const bf16x8*)(kin + (nt * 16 + l15) * 136 + ks * 32 + l4 * 8);
                acc = __builtin_amdgcn_mfma_f32_16x16x32_bf16(a, b, acc, 0, 0, 0);
            }
        }
#pragma unroll
        for (int r = 0; r < 4; ++r) {
            const int i = mt * 16 + l4 * 4 + r, j = nt * 16 + l15;
            att[i * 72 + j] = (bf16_t)f2bf(j <= i ? acc[r] : 0.f);
        }
    }
    {
        uint2* ug = (uint2*)(p.ws + OFF_UR) + ((size_t)uidx * 8 + w) * 16 * 64 + lane;
        const bf16x8 a0 = *(const bf16x8*)(kinT + (w * 16 + l15) * 72 + l4 * 8);
        const bf16x8 a1 = *(const bf16x8*)(kinT + (w * 16 + l15) * 72 + 32 + l4 * 8);
#pragma unroll 4
        for (int nt = 0; nt < 16; ++nt) {
            f32x4 acc = {0.f, 0.f, 0.f, 0.f};
            bf16x8 b0 = *(const bf16x8*)(vT + (nt * 16 + l15) * 72 + l4 * 8);
            bf16x8 b1 = *(const bf16x8*)(vT + (nt * 16 + l15) * 72 + 32 + l4 * 8);
            acc = __builtin_amdgcn_mfma_f32_16x16x32_bf16(a0, b0, acc, 0, 0, 0);
            acc = __builtin_amdgcn_mfma_f32_16x16x32_bf16(a1, b1, acc, 0, 0, 0);
            ug[nt * 64] = make_uint2(pack2(acc[0], acc[1]), pack2(acc[2], acc[3]));
        }
    }
    __syncthreads();
    {
        const bf16x8 a0 = *(const bf16x8*)(att + (mt * 16 + l15) * 72 + l4 * 8);
        const bf16x8 a1 = *(const bf16x8*)(att + (mt * 16 + l15) * 72 + 32 + l4 * 8);
        int tokr[4];
#pragma unroll
        for (int r = 0; r < 4; ++r) tokr[r] = gla_tok(seq, d, c * 64 + mt * 16 + l4 * 4 + r);
#pragma unroll 4
        for (int nn = 0; nn < 8; ++nn) {
            const int nt = (w & 1) * 8 + nn;
            f32x4 acc = {0.f, 0.f, 0.f, 0.f};
            bf16x8 b0 = *(const bf16x8*)(vT + (nt * 16 + l15) * 72 + l4 * 8);
            bf16x8 b1 = *(const bf16x8*)(vT + (nt * 16 + l15) * 72 + 32 + l4 * 8);
            acc = __builtin_amdgcn_mfma_f32_16x16x32_bf16(a0, b0, acc, 0, 0, 0);
            acc = __builtin_amdgcn_mfma_f32_16x16x32_bf16(a1, b1, acc, 0, 0, 0);
#pragma unroll
            for (int r = 0; r < 4; ++r) O[(size_t)tokr[r] * 1024 + h * 256 + nt * 16 + l15] = acc[r];
        }
    }
}

__device__ __forceinline__ void phase_gla_pre(const Params& p, int l, float* lds) {
#pragma unroll 1
    for (int u = blockIdx.x; u < 768; u += gridDim.x) {
        const int d = u & 1, h = (u >> 1) & 3, cg = u >> 3;
        int seq, c;
        if (cg < 64) { seq = cg >> 2; c = cg & 3; } else { seq = 16 + ((cg - 64) >> 4); c = (cg - 64) & 15; }
        gla_pre_unit(p, l, seq, h, d, c, lds);
    }
}

__device__ __forceinline__ void gla_scan_unit(const Params& p, int l, int seq, int h, int d, int e, float* ldsf, bool dry) {
    const int tid = ltid(), lane = tid & 63, w = tid >> 6;
    const int jl = l >> 1;
    const int nch = seq < 16 ? 4 : 16;
    bf16_t* ST = (bf16_t*)ldsf;
    float* O = (float*)(p.ws + (d ? OFF_HB : OFF_HF));
    float* Ow = dry ? (float*)(p.ws + WS_END) : O;
    const int kt = w, mt = w >> 1;
    const int l15 = lane & 15, l4 = lane >> 4;
    f32x4 S[4];
    __syncthreads();
#pragma unroll
    for (int nt = 0; nt < 4; ++nt) {
#pragma unroll
        for (int r = 0; r < 4; ++r) {
            const int k = kt * 16 + l4 * 4 + r, dv = nt * 16 + l15;
            float v = 0.f;
            if (seq >= 16) v = p.in[I_SGLA][((((size_t)((seq - 16) * 2 + jl) * 2 + d) * 4 + h) * 128 + k) * 256 + e * 64 + dv];
            S[nt][r] = v;
        }
        *(uint2*)(ST + (nt * 16 + l15) * 136 + kt * 16 + l4 * 4) = make_uint2(pack2(S[nt][0], S[nt][1]), pack2(S[nt][2], S[nt][3]));
    }
    bf16x8 aA[4], aB[4], aC[4];
    uint2 uA[4], uB[4], uC[4];
    f32x4 gA, gB, gC, oA[2], oB[2], oC[2];
#define GLB_LOAD(S_, c_) { const int ui_ = gla_uidx(seq, (c_), h, d); \
        const uint2* ug_ = (const uint2*)(p.ws + OFF_UR) + ((size_t)ui_ * 8 + kt) * 16 * 64 + lane; \
        _Pragma("unroll") for (int nt = 0; nt < 4; ++nt) u##S_[nt] = ug_[(e * 4 + nt) * 64]; \
        g##S_ = *(const f32x4*)((const float*)(p.ws + OFF_GD) + (size_t)ui_ * 128 + kt * 16 + l4 * 4); \
        const bf16_t* qg_ = (const bf16_t*)(p.ws + OFF_QIN) + (size_t)ui_ * 64 * 136 + (mt * 16 + l15) * 136 + l4 * 8; \
        _Pragma("unroll") for (int ks = 0; ks < 4; ++ks) a##S_[ks] = *(const bf16x8*)(qg_ + ks * 32); \
        _Pragma("unroll") for (int nn = 0; nn < 2; ++nn) { _Pragma("unroll") for (int r = 0; r < 4; ++r) { \
            const int tok_ = gla_tok(seq, d, (c_) * 64 + mt * 16 + l4 * 4 + r); \
            o##S_[nn][r] = O[(size_t)tok_ * 1024 + h * 256 + e * 64 + ((w & 1) * 2 + nn) * 16 + l15]; } } }
#define GLB_STEP(S_, cc_) if ((cc_) < nch) { \
        _Pragma("unroll") for (int nn = 0; nn < 2; ++nn) { \
            const int nt = (w & 1) * 2 + nn; \
            f32x4 acc = o##S_[nn]; \
            _Pragma("unroll") for (int ks = 0; ks < 4; ++ks) { \
                bf16x8 b = *(const bf16x8*)(ST + (nt * 16 + l15) * 136 + ks * 32 + l4 * 8); \
                acc = __builtin_amdgcn_mfma_f32_16x16x32_bf16(a##S_[ks], b, acc, 0, 0, 0); } \
            _Pragma("unroll") for (int r = 0; r < 4; ++r) { \
                const int tok_ = gla_tok(seq, d, (cc_) * 64 + mt * 16 + l4 * 4 + r); \
                Ow[(size_t)tok_ * 1024 + h * 256 + e * 64 + nt * 16 + l15] = acc[r]; } } \
        __syncthreads(); \
        _Pragma("unroll") for (int nt = 0; nt < 4; ++nt) { \
            { const uint2 uu_ = u##S_[nt]; const f32x4 uf_ = {bflo(uu_.x), bfhi(uu_.x), bflo(uu_.y), bfhi(uu_.y)}; S[nt] = g##S_ * (S[nt] + uf_); } \
            *(uint2*)(ST + (nt * 16 + l15) * 136 + kt * 16 + l4 * 4) = make_uint2(pack2(S[nt][0], S[nt][1]), pack2(S[nt][2], S[nt][3])); } \
        if ((cc_) + 3 < nch) GLB_LOAD(S_, (cc_) + 3) \
        __syncthreads(); }
    GLB_LOAD(A, 0) GLB_LOAD(B, 1) GLB_LOAD(C, 2)
    __syncthreads();
#pragma unroll
    for (int c = 0; c < 18; c += 3) {
        int oz = 0; asm volatile("" : "+v"(oz));
        const int lane_i = lane + oz, w_i = w + oz;
        {
            const int lane = lane_i, w = w_i, kt = w_i, mt = w_i >> 1, l15 = lane_i & 15, l4 = lane_i >> 4;
            GLB_STEP(A, c)
            GLB_STEP(B, c + 1)
            GLB_STEP(C, c + 2)
        }
    }
    if (seq < 16) {
#pragma unroll
        for (int nt = 0; nt < 4; ++nt)
#pragma unroll
            for (int r = 0; r < 4; ++r) {
                const int k = kt * 16 + l4 * 4 + r, dv = nt * 16 + l15;
                p.out[OUT_GLA + ((((size_t)(seq * 2 + jl) * 2 + d) * 4 + h) * 128 + k) * 256 + e * 64 + dv] = S[nt][r];
            }
    }
}

__device__ __forceinline__ void phase_gla(const Params& p, int l, float* lds, bool dry = false) {
    const int b = blockIdx.x, G = gridDim.x;
    int u, stride, end;
    if (G == 256) { if (b < 64) { u = b; stride = 1024; end = 64; } else { u = 64 + (b - 64); stride = 192; end = 576; } }
    else { u = b; stride = G; end = 576; }
#pragma unroll 1
    for (; u < end; u += stride) {
        int seq, rest;
        if (u < 64) { seq = 16 + (u >> 5); rest = u & 31; } else { seq = (u - 64) >> 5; rest = (u - 64) & 31; }
        gla_scan_unit(p, l, seq, rest >> 3, (rest >> 2) & 1, rest & 3, lds, dry);
    }
}

__device__ __forceinline__ void phase_gla_norm(const Params& p, int l) {
    const int lane = ltid() & 63, w = ltid() >> 6;
    const int jl = l >> 1;
    const float* OF = (const float*)(p.ws + OFF_HF);
    const float* OB = (const float*)(p.ws + OFF_HB);
    const float* PB = (const float*)(p.ws + OFF_PB);
    bf16_t* Y = (bf16_t*)(p.ws + OFF_Y);
    const float* ng = p.in[I_GLNG] + jl * 1024;
    for (int tok = blockIdx.x * 8 + w; tok < TTOK; tok += gridDim.x * 8) {
#pragma unroll
        for (int hh = 0; hh < 4; ++hh) {
            const int d0 = hh * 256 + lane * 4;
            float4 a = *(const float4*)(OF + (size_t)tok * 1024 + d0), b = *(const float4*)(OB + (size_t)tok * 1024 + d0);
            float o0 = a.x + b.x, o1 = a.y + b.y, o2 = a.z + b.z, o3 = a.w + b.w;
            float ss = wave_sum(o0 * o0 + o1 * o1 + o2 * o2 + o3 * o3);
            const float rs = rsqrtf(ss * (1.0f / 256.0f) + EPSV);
            float4 gn = *(const float4*)(ng + d0);
            float4 gg = *(const float4*)(PB + (size_t)tok * 3104 + 2048 + d0);
            float y0 = siluf_(gg.x) * (o0 * rs * gn.x), y1 = siluf_(gg.y) * (o1 * rs * gn.y);
            float y2 = siluf_(gg.z) * (o2 * rs * gn.z), y3 = siluf_(gg.w) * (o3 * rs * gn.w);
            *(uint2*)(Y + (size_t)tok * 1024 + d0) = make_uint2(pack2(y0, y1), pack2(y2, y3));
        }
    }
}

#define LDS_FLOATS 38400
#define NPHASE 34
#ifndef REP_MASK
#define REP_MASK 0
#endif

__device__ __forceinline__ bool phase_noop(int ph) {
    if (ph < 2) return false;
    const int l = (ph - 2) / 8, s = (ph - 2) % 8;
    return ((s == 2) || (s == 3)) && ((l & 1) == 0);
}

__global__ void __launch_bounds__(NTHR) hybrid_fwd(Params p) {
    __shared__ __attribute__((aligned(16))) float lds[LDS_FLOATS];
    __shared__ uint4 xb_words;
    if (threadIdx.x == 0) xb_words = make_uint4(0u, 0u, 0u, 0u);
    __syncthreads();
    XcdBarrier bar = xcd_barrier_post((unsigned*)(p.ws + OFF_BAR), (volatile LAS unsigned*)&xb_words);
    bool first = true;
    for (int ph = p.ph_lo; ph < p.ph_hi; ++ph) {
        if (phase_noop(ph)) continue;
        if (!first) xcd_barrier(bar);
        first = false;
        if (ph == 0) { for (int r = 0; r < 1 + ((REP_MASK >> 0) & 1); ++r) { if (r) __syncthreads(); phase_setup(p, lds); } }
        else if (ph == 1) phase_norm(p, 0, 0);
        else {
            const int l = (ph - 2) / 8, s = (ph - 2) % 8;
            const bool gla = (l & 1) != 0;
            if (s == 0 || s == 4) {
                const int kind = (s == 4) ? EPI_OUT : (gla ? EPI_GLAIN : EPI_RGIN);
                const int nrep = 1 + ((REP_MASK >> 2) & 1);
                for (int r = 0; r < nrep; ++r) { if (r) __syncthreads(); phase_gemm(p, l, kind, lds, (kind == EPI_OUT) && (r + 1 < nrep)); }
            } else switch (s) {
                case 1: if (gla) { for (int r = 0; r < 1 + ((REP_MASK >> 4) & 1); ++r) { if (r) __syncthreads(); phase_gla_pre(p, l, lds); } }
                        else { for (int r = 0; r < 1 + ((REP_MASK >> 3) & 1); ++r) { if (r) __syncthreads(); phase_rgscan(p, l, lds); } } break;
                case 2: { const int nrep = 1 + ((REP_MASK >> 5) & 1); for (int r = 0; r < nrep; ++r) { if (r) __syncthreads(); phase_gla(p, l, lds, r + 1 < nrep); } } break;
                case 3: phase_gla_norm(p, l); break;
                case 5: for (int r = 0; r < 1 + ((REP_MASK >> 1) & 1); ++r) phase_norm(p, l, 1); break;
                case 6: for (int r = 0; r < 1 + ((REP_MASK >> 6) & 1); ++r) { if (r) __syncthreads(); phase_peerq(p, l, lds); } break;
                case 7: { const int nrep = 1 + ((REP_MASK >> 7) & 1); for (int r = 0; r < nrep; ++r) { if (r) __syncthreads(); phase_peer_gather(p, l, lds, r + 1 < nrep); } } break;
            }
        }
    }
}

extern "C" void kernel_launch(void* const* d_in, const int* in_sizes, int n_in, void* d_out, int out_size, void* d_ws, size_t ws_size,
                              hipStream_t stream) {
    static int grid = 0;
    if (grid == 0) {
        int dev = 0, cus = 0, per_cu = 0;
        hipGetDevice(&dev);
        hipDeviceGetAttribute(&cus, hipDeviceAttributeMultiprocessorCount, dev);
        hipOccupancyMaxActiveBlocksPerMultiprocessor(&per_cu, (const void*)hybrid_fwd, NTHR, 0);
        (void)hipGetLastError();
        if (per_cu < 1) fprintf(stderr, "kernel_launch: occupancy query says %d blocks per CU\n", per_cu);
        grid = cus > 0 ? cus : 256;
        if (ws_size < WS_END) fprintf(stderr, "kernel_launch: workspace too small (%zu < %zu)\n", ws_size, (size_t)WS_END);
    }
    hipMemsetAsync((char*)d_ws + OFF_BAR, 0, 16384, stream);
    Params p{};
    for (int i = 0; i < 30; ++i) p.in[i] = (const float*)d_in[i];
    p.out = (float*)d_out; p.ws = (unsigned char*)d_ws;
#if MULTI_LAUNCH
    for (int ph = 0; ph < NPHASE; ++ph) {
        p.ph_lo = ph; p.ph_hi = ph + 1;
        hipLaunchKernelGGL(hybrid_fwd, dim3(grid), dim3(NTHR), 0, stream, p);
    }
#else
    p.ph_lo = 0; p.ph_hi = NPHASE;
    void* args[] = {&p};
    hipError_t e = hipLaunchCooperativeKernel((const void*)hybrid_fwd, dim3(grid), dim3(NTHR), args, 0, stream);
    if (e != hipSuccess) fprintf(stderr, "cooperative launch failed: %s (grid %d)\n", hipGetErrorString(e), grid);
#endif
}
```

```cpp
#include <hip/hip_runtime.h>
#include <stdint.h>
#include <stdio.h>

#ifndef MULTI_LAUNCH
#define MULTI_LAUNCH 0
#endif

typedef __attribute__((ext_vector_type(8))) short bf16x8;
typedef __attribute__((ext_vector_type(4))) float f32x4;
typedef __attribute__((ext_vector_type(16))) float f32x16;
typedef __attribute__((ext_vector_type(2))) __bf16 bf2_t;
typedef unsigned short bf16_t;
typedef unsigned u32x4 __attribute__((ext_vector_type(4)));

#define NTHR 512
#define TTOK 6144
#define DM 1024
#define EPSV 1e-6f

constexpr size_t AL(size_t x) { return (x + 255) & ~(size_t)255; }
constexpr size_t OFF_BAR   = 0;
constexpr size_t OFF_MODS  = 16384;
constexpr size_t OFF_X     = AL(OFF_MODS + (size_t)4 * 3 * 6144 * 4);
constexpr size_t OFF_H     = AL(OFF_X + (size_t)TTOK * DM * 4);
constexpr size_t OFF_Y     = AL(OFF_H + (size_t)TTOK * DM * 2);
constexpr size_t OFF_PB    = AL(OFF_Y + (size_t)TTOK * DM * 2);
constexpr size_t OFF_HF    = AL(OFF_PB + (size_t)TTOK * 3104 * 4);
constexpr size_t OFF_HB    = AL(OFF_HF + (size_t)TTOK * DM * 4);
constexpr size_t OFF_TK    = AL(OFF_HB + (size_t)TTOK * DM * 4);
constexpr size_t OFF_RGWIN = AL(OFF_TK + (size_t)TTOK * 256 * 4);
constexpr size_t OFF_RGWOUT= AL(OFF_RGWIN + (size_t)2 * 2048 * 1024 * 2);
constexpr size_t OFF_GLWIN = AL(OFF_RGWOUT + (size_t)2 * 1024 * 1024 * 2);
constexpr size_t OFF_GLWOUT= AL(OFF_GLWIN + (size_t)2 * 3200 * 1024 * 2);
constexpr size_t OFF_PWQ   = AL(OFF_GLWOUT + (size_t)2 * 1024 * 1024 * 2);
constexpr size_t OFF_PK    = AL(OFF_PWQ + (size_t)4 * 2048 * 1024 * 2);
constexpr size_t OFF_PU    = AL(OFF_PK + (size_t)4 * 2 * 8 * 128 * 128 * 2);
constexpr size_t OFF_PV    = AL(OFF_PU + (size_t)4 * 16384 * 1024);
constexpr size_t OFF_SU    = AL(OFF_PV + (size_t)4 * 16384 * 1024);
constexpr size_t OFF_SV    = AL(OFF_SU + (size_t)4 * 16384 * 4);
constexpr size_t OFF_RGW   = AL(OFF_SV + (size_t)4 * 16384 * 4);
constexpr size_t OFF_QIN   = AL(OFF_RGW + (size_t)2 * 2 * 16 * 2 * 4096 * 2);
constexpr size_t OFF_GD    = AL(OFF_QIN + (size_t)768 * 64 * 136 * 2);
constexpr size_t OFF_UR    = AL(OFF_GD + (size_t)768 * 128 * 4);
constexpr size_t WS_END    = AL(OFF_UR + (size_t)768 * 8 * 16 * 64 * 8);

constexpr size_t OUT_Y    = 0;
constexpr size_t OUT_RG   = (size_t)TTOK * DM;
constexpr size_t OUT_GLA  = OUT_RG + 16 * 2 * 2 * 1024;

struct Params {
    const float* in[30];
    float* out;
    unsigned char* ws;
    int ph_lo, ph_hi;
};

enum { I_XP = 0, I_XS, I_SRG, I_SGLA, I_C, I_CCTX, I_N1G, I_N2G, I_ADAW, I_ADAB, I_PWQ, I_PK1, I_PK2, I_PU, I_PV,
       I_RGWIN, I_RGCW, I_RGCB, I_RGWA, I_RGBA, I_RGWI, I_RGBI, I_RGLAM, I_RGWOUT, I_GLWIN, I_GLWAL, I_GLBAL, I_GLNG, I_GLWOUT, I_FNG };

typedef float f32x2 __attribute__((ext_vector_type(2)));
__device__ __forceinline__ unsigned pack2(float a, float b) {
    f32x2 v = {a, b};
    return __builtin_bit_cast(unsigned, __builtin_convertvector(v, bf2_t));
}
__device__ __forceinline__ unsigned f2bf(float f) { return pack2(f, 0.f) & 0xffffu; }
__device__ __forceinline__ float bflo(unsigned u) { return __uint_as_float(u << 16); }
__device__ __forceinline__ float bfhi(unsigned u) { return __uint_as_float(u & 0xffff0000u); }
__device__ __forceinline__ float sigmoidf_(float x) { return 1.0f / (1.0f + __expf(-x)); }
__device__ __forceinline__ float siluf_(float x) { return x * sigmoidf_(x); }
__device__ __forceinline__ float gelu_tanh(float x) {
    float u = 0.7978845608028654f * (x + 0.044715f * x * x * x);
    float t = __expf(2.0f * u);
    float th = 1.0f - 2.0f / (t + 1.0f);
    return 0.5f * x * (1.0f + th);
}
__device__ __forceinline__ int ltid() { int t = threadIdx.x; asm volatile("" : "+v"(t)); return t; }
__device__ __forceinline__ int cond_of(int tok) { return tok < 4096 ? 0 : 1 + ((tok - 4096) >> 10); }
__device__ __forceinline__ float wave_sum(float v) {
#pragma unroll
    for (int o = 32; o >= 1; o >>= 1) v += __shfl_xor(v, o);
    return v;
}

#define XB_TMO      128
#define XB_XCNT(j)  (256  + 64 * (j))
#define XB_XSUB(j)  (1280 + 64 * (j))
#define XB_XGEN(j)  (2304 + 64 * (j))
#define XB_TOP      3328
#define XB_TOPGEN   3392
#define XCD_BAR_WORDS 3456
#define XB_SPIN_CAP (1u << 22)
#define LAS __attribute__((address_space(3)))

__device__ __forceinline__ unsigned xb_ld(unsigned* p)              { return __hip_atomic_load(p, __ATOMIC_RELAXED, __HIP_MEMORY_SCOPE_AGENT); }
__device__ __forceinline__ unsigned xb_add(unsigned* p, unsigned v) { return __hip_atomic_fetch_add(p, v, __ATOMIC_RELAXED, __HIP_MEMORY_SCOPE_AGENT); }
__device__ __forceinline__ unsigned xb_xcc_id() { return (unsigned)__builtin_amdgcn_s_getreg((3 << 11) | 20) & 0xFu; }
#define XB_SPIN(cond, bar) do { unsigned _sp = 0; while (cond) { __builtin_amdgcn_s_sleep(1); \
    if ((++_sp & 255u) == 0u) { if (xb_ld(&(bar)[XB_TMO])) break; if (_sp > XB_SPIN_CAP) { atomicAdd(&(bar)[XB_TMO], 1u); break; } } } } while (0)

struct XcdBarrier { unsigned* bar; unsigned x; volatile LAS unsigned* st; };

__device__ __forceinline__ XcdBarrier xcd_barrier_post(unsigned* bar, volatile LAS unsigned* st) {
    XcdBarrier b; b.bar = bar; b.x = xb_xcc_id(); b.st = st;
    if (threadIdx.x == 0) (void)xb_add(&bar[XB_XCNT(b.x)], 1u);
    return b;
}
__device__ __forceinline__ void xcd_barrier_complete(unsigned* bar, unsigned x, unsigned& nloc, unsigned& nx) {
    const unsigned G = gridDim.x * gridDim.y * gridDim.z;
    unsigned sum, cnt, mine, sp = 0u;
    for (;;) {
        sum = 0u; cnt = 0u; mine = 0u;
#pragma unroll
        for (unsigned j = 0; j < 16; ++j) { const unsigned c = xb_ld(&bar[XB_XCNT(j)]); sum += c; cnt += (c > 0u) ? 1u : 0u; mine = (j == x) ? c : mine; }
        if (sum == G) break;
        __builtin_amdgcn_s_sleep(1);
        if ((++sp & 255u) == 0u) { if (xb_ld(&bar[XB_TMO])) break; if (sp > XB_SPIN_CAP) { atomicAdd(&bar[XB_TMO], 1u); break; } }
    }
    nloc = mine > 0u ? mine : 1u; nx = cnt > 0u ? cnt : 1u;
}
__device__ __forceinline__ void xcd_barrier(const XcdBarrier& b) {
    asm volatile("s_waitcnt vmcnt(0)" ::: "memory");
    __syncthreads();
    if (threadIdx.x == 0) {
        unsigned* bar = b.bar;
        __builtin_amdgcn_s_waitcnt(0);
        unsigned nloc = b.st[0], nx = b.st[1];
        if (nloc == 0u) { xcd_barrier_complete(bar, b.x, nloc, nx); b.st[0] = nloc; b.st[1] = nx; }
        const unsigned old = xb_add(&bar[XB_XSUB(b.x)], 1u);
        const unsigned gen = old / nloc;
        if (old + 1u == (gen + 1u) * nloc) {
            __builtin_amdgcn_fence(__ATOMIC_RELEASE, "agent");
            asm volatile("s_waitcnt vmcnt(0)" ::: "memory");
            const unsigned og = xb_add(&bar[XB_TOP], 1u);
            const unsigned tg = og / nx;
            if (og + 1u == (tg + 1u) * nx) xb_add(&bar[XB_TOPGEN], 1u);
            else XB_SPIN(xb_ld(&bar[XB_TOPGEN]) == tg, bar);
            __builtin_amdgcn_fence(__ATOMIC_ACQUIRE, "agent");
            xb_add(&bar[XB_XGEN(b.x)], 1u);
            asm volatile("s_waitcnt vmcnt(0)" ::: "memory");
        } else {
            XB_SPIN(xb_ld(&bar[XB_XGEN(b.x)]) == gen, bar);
            __builtin_amdgcn_fence(__ATOMIC_ACQUIRE, "agent");
            asm volatile("s_waitcnt vmcnt(0)" ::: "memory");
        }
    }
    __syncthreads();
}

__device__ __forceinline__ void setup_ada_unit(const Params& p, int a, float* lds) {
    const int tid = ltid();
    const int l = a / 48, jb = (a % 48) * 128;
    float* scond = lds;
    float* part = lds + 3072;
    for (int i = tid; i < 3072; i += NTHR) {
        int n = i >> 10, k = i & 1023;
        float c = (n == 0) ? p.in[I_CCTX][k] : p.in[I_C][(n - 1) * 1024 + k];
        scond[i] = siluf_(c);
    }
    __syncthreads();
    const int lane = tid & 63, kg = tid >> 6;
    const float* w = p.in[I_ADAW] + (size_t)l * 1024 * 6144 + jb + lane * 2;
    float a0x = 0.f, a0y = 0.f, a1x = 0.f, a1y = 0.f, a2x = 0.f, a2y = 0.f;
#pragma unroll 1
    for (int k0 = 0; k0 < 128; k0 += 32) {
        float2 wv[32];
#pragma unroll
        for (int kk = 0; kk < 32; ++kk) { const f32x2 t_ = __builtin_nontemporal_load((const f32x2*)(w + (size_t)(kg * 128 + k0 + kk) * 6144)); wv[kk] = make_float2(t_[0], t_[1]); }
#pragma unroll
        for (int kk = 0; kk < 32; ++kk) {
            const int k = kg * 128 + k0 + kk;
            const float s0 = scond[k], s1 = scond[1024 + k], s2 = scond[2048 + k];
            a0x += s0 * wv[kk].x; a0y += s0 * wv[kk].y; a1x += s1 * wv[kk].x; a1y += s1 * wv[kk].y; a2x += s2 * wv[kk].x; a2y += s2 * wv[kk].y;
        }
    }
    float* pp = part + kg * 384 + lane * 2;
    pp[0] = a0x; pp[1] = a0y; pp[128] = a1x; pp[129] = a1y; pp[256] = a2x; pp[257] = a2y;
    __syncthreads();
    if (tid < 384) {
        const int n = tid >> 7, c2 = tid & 127;
        float sm = p.in[I_ADAB][l * 6144 + jb + c2];
#pragma unroll
        for (int g = 0; g < 8; ++g) sm += part[g * 384 + n * 128 + c2];
        float* mods = (float*)(p.ws + OFF_MODS);
        mods[(l * 3 + n) * 6144 + jb + c2] = sm;
    }
    __syncthreads();
}

__device__ __forceinline__ void setup_transpose_unit(const Params& p, int u, float* lds) {
    const int tid = ltid();
    const float* src; bf16_t* dst; int N, tiles_n, t, dstride = 1024;
    const bool gates = u >= 1424;
    const int i = u * 4;
    if (gates)         { t = 0; N = 64; tiles_n = 1; dstride = 64; src = p.in[I_RGWA]; dst = (bf16_t*)(p.ws + OFF_RGW) + (size_t)(i - 5696) * 4096; }
    else if (i < 1024) { int m = i / 512;          t = i % 512;          N = 2048; tiles_n = 32; src = p.in[I_RGWIN] + (size_t)m * 1024 * 2048;  dst = (bf16_t*)(p.ws + OFF_RGWIN) + (size_t)m * 2048 * 1024; }
    else if (i < 1536) { int m = (i - 1024) / 256; t = (i - 1024) % 256; N = 1024; tiles_n = 16; src = p.in[I_RGWOUT] + (size_t)m * 1024 * 1024; dst = (bf16_t*)(p.ws + OFF_RGWOUT) + (size_t)m * 1024 * 1024; }
    else if (i < 3136) { int m = (i - 1536) / 800; t = (i - 1536) % 800; N = 3104; tiles_n = 50; src = p.in[I_GLWIN] + (size_t)m * 1024 * 3104;  dst = (bf16_t*)(p.ws + OFF_GLWIN) + (size_t)m * 3200 * 1024; }
    else if (i < 3648) { int m = (i - 3136) / 256; t = (i - 3136) % 256; N = 1024; tiles_n = 16; src = p.in[I_GLWOUT] + (size_t)m * 1024 * 1024; dst = (bf16_t*)(p.ws + OFF_GLWOUT) + (size_t)m * 1024 * 1024; }
    else               { int m = (i - 3648) / 512; t = (i - 3648) % 512; N = 2048; tiles_n = 32; src = p.in[I_PWQ] + (size_t)m * 1024 * 2048;    dst = (bf16_t*)(p.ws + OFF_PWQ) + (size_t)m * 2048 * 1024; }
    const int mg = (i - 5696) >> 1;
    {
        const int k = tid >> 3, nc = (tid & 7) * 8;
        f32x4 v0[4], v1[4];
#pragma unroll
        for (int q = 0; q < 4; ++q) {
            const int tq = t + q, kt = tq / tiles_n, nt = tq % tiles_n;
            const float* sq = gates ? p.in[(q & 1) ? I_RGWI : I_RGWA] + (size_t)(mg + (q >> 1)) * 4096 : src;
            const int n = nt * 64 + nc;
            f32x4 z = {0.f, 0.f, 0.f, 0.f};
            v0[q] = z; v1[q] = z;
            if (n < N) {
                const f32x4* s4 = (const f32x4*)(sq + (size_t)((gates ? 0 : kt) * 64 + k) * N + n);
                v0[q] = __builtin_nontemporal_load(s4); v1[q] = __builtin_nontemporal_load(s4 + 1);
            }
        }
#pragma unroll
        for (int q = 0; q < 4; ++q) {
            float* tp = lds + q * 4160 + k * 65 + nc;
#pragma unroll
            for (int j = 0; j < 4; ++j) { tp[j] = v0[q][j]; tp[4 + j] = v1[q][j]; }
        }
    }
    __syncthreads();
    {
        const int n = tid >> 3, kc = (tid & 7) * 8;
#pragma unroll
        for (int q = 0; q < 4; ++q) {
            const int tq = t + q, kt = gates ? 0 : tq / tiles_n, nt = gates ? 0 : tq % tiles_n;
            bf16_t* dq = gates ? dst + (size_t)q * 4096 : dst;
            const float* tile = lds + q * 4160;
            float x[8];
#pragma unroll
            for (int j = 0; j < 8; ++j) x[j] = tile[(kc + j) * 65 + n];
            uint4 o; o.x = pack2(x[0], x[1]); o.y = pack2(x[2], x[3]); o.z = pack2(x[4], x[5]); o.w = pack2(x[6], x[7]);
            *(uint4*)(dq + (size_t)(nt * 64 + n) * dstride + kt * 64 + kc) = o;
        }
    }
    __syncthreads();
}

__device__ __forceinline__ void setup_convert_unit(const Params& p, int i, bool force = false) {
    const int tid = ltid();
    if (i < 256) {
        int side = i >> 7, ii = i & 127;
        size_t e = (size_t)ii * 4096;
        int l = (int)(e / 131072); size_t rest = e % 131072;
        const float* src = p.in[side ? I_PK2 : I_PK1] + e;
        bf16_t* dst = (bf16_t*)(p.ws + OFF_PK) + (size_t)l * 262144 + (size_t)side * 131072 + rest;
        const float4* s4 = (const float4*)(src + tid * 8);
        float4 v0 = s4[0], v1 = s4[1];
        uint4 o; o.x = pack2(v0.x, v0.y); o.y = pack2(v0.z, v0.w); o.z = pack2(v1.x, v1.y); o.w = pack2(v1.z, v1.w);
        *(uint4*)(dst + tid * 8) = o;
        return;
    }
    i -= 256;
    if (!force && gridDim.x == 256) return;
    const int tab = i >> 10;
    const int lane = tid & 63, w = tid >> 6;
    const float* src = p.in[tab ? I_PV : I_PU];
    unsigned char* dst = p.ws + (tab ? OFF_PV : OFF_PU);
    float* sc = (float*)(p.ws + (tab ? OFF_SV : OFF_SU));
    const size_t rowbase = (size_t)(i & 1023) * 64 + w * 8;
    f32x4 v[8][4];
#pragma unroll
    for (int rr = 0; rr < 8; ++rr) {
        const float* rp = src + (rowbase + rr) * 1024;
#pragma unroll
        for (int q = 0; q < 4; ++q) v[rr][q] = __builtin_nontemporal_load((const f32x4*)(rp + q * 256 + lane * 4));
    }
#pragma unroll
    for (int rr = 0; rr < 8; ++rr) {
        float am = 0.f;
#pragma unroll
        for (int q = 0; q < 4; ++q) am = fmaxf(am, fmaxf(fmaxf(fabsf(v[rr][q][0]), fabsf(v[rr][q][1])), fmaxf(fabsf(v[rr][q][2]), fabsf(v[rr][q][3]))));
#pragma unroll
        for (int o = 32; o >= 1; o >>= 1) am = fmaxf(am, __shfl_xor(am, o));
        const float scale = am > 0.f ? am * (1.0f / 448.0f) : 1.0f;
        const float inv = 1.0f / scale;
        unsigned o4[4];
#pragma unroll
        for (int q = 0; q < 4; ++q) {
            int pk = 0;
            pk = __builtin_amdgcn_cvt_pk_fp8_f32(v[rr][q][0] * inv, v[rr][q][1] * inv, pk, false);
            pk = __builtin_amdgcn_cvt_pk_fp8_f32(v[rr][q][2] * inv, v[rr][q][3] * inv, pk, true);
            o4[q] = (unsigned)pk;
        }
        const size_t row = rowbase + rr;
        { const u32x4 ov = {o4[0], o4[1], o4[2], o4[3]}; __builtin_nontemporal_store(ov, (u32x4*)(dst + row * 1024 + lane * 16)); }
        if (lane == 0) sc[row] = scale;
    }
}

__device__ __forceinline__ void setup_xinit_unit(const Params& p, int i) {
    const int tid = ltid();
    const int row = i * 4 + (tid >> 7), d0 = (tid & 127) * 8;
    float* X = (float*)(p.ws + OFF_X);
    float v[8];
    if (row < 4096) {
        const f32x4* s4 = (const f32x4*)(p.in[I_XP] + (size_t)row * 1024 + d0);
        const f32x4 a_ = __builtin_nontemporal_load(s4), b_ = __builtin_nontemporal_load(s4 + 1);
        const float4 a = make_float4(a_[0], a_[1], a_[2], a_[3]), b = make_float4(b_[0], b_[1], b_[2], b_[3]);
        v[0] = a.x; v[1] = a.y; v[2] = a.z; v[3] = a.w; v[4] = b.x; v[5] = b.y; v[6] = b.z; v[7] = b.w;
    } else {
        const f32x4* s4 = (const f32x4*)(p.in[I_XS] + (size_t)(row - 4096) * 1024 + d0);
        const f32x4 a_ = __builtin_nontemporal_load(s4), b_ = __builtin_nontemporal_load(s4 + 1);
        const float4 a = make_float4(a_[0], a_[1], a_[2], a_[3]), b = make_float4(b_[0], b_[1], b_[2], b_[3]);
        v[0] = a.x; v[1] = a.y; v[2] = a.z; v[3] = a.w; v[4] = b.x; v[5] = b.y; v[6] = b.z; v[7] = b.w;
        int n = (row - 4096) & 1023;
        float r = (float)(n >> 6), cc = (float)(n & 63);
#pragma unroll
        for (int j = 0; j < 8; ++j) {
            int d = d0 + j; int q = d >> 8, fi = d & 255;
            float freq = exp2f(-13.287712379549449f * ((float)fi * (1.0f / 256.0f)));
            float ang = ((q < 2) ? r : cc) * freq;
            v[j] += (q & 1) ? __cosf(ang) : __sinf(ang);
        }
    }
    float4* o4 = (float4*)(X + (size_t)row * 1024 + d0);
    o4[0] = make_float4(v[0], v[1], v[2], v[3]); o4[1] = make_float4(v[4], v[5], v[6], v[7]);
}

__device__ __forceinline__ void phase_setup(const Params& p, float* lds) {
    constexpr int NA = 192, NB = (5696 + 128) / 4, NC = 256 + 2048, ND = 1536;
    constexpr int total = NA + NB + NC + ND;
    for (int u = blockIdx.x; u < total; u += gridDim.x) {
        if (u < NA) setup_ada_unit(p, u, lds);
        else if (u < NA + NB) setup_transpose_unit(p, u - NA, lds);
        else if (u < NA + NB + NC) setup_convert_unit(p, u - NA - NB);
        else setup_xinit_unit(p, u - NA - NB - NC);
    }
}

__device__ __forceinline__ void premod_store(const float* x  , float ss, const float* g, const float* mrow, int shift_i, int scale_i,
                                             bf16_t* Hrow, int lane) {
    const float rs = rsqrtf(ss * (1.0f / 1024.0f) + EPSV);
    unsigned pk[8];
#pragma unroll
    for (int hf = 0; hf < 2; ++hf) {
        const int d0 = hf * 512 + lane * 8;
        float4 g0 = *(const float4*)(g + d0), g1 = *(const float4*)(g + d0 + 4);
        float4 s0 = *(const float4*)(mrow + shift_i * 1024 + d0), s1 = *(const float4*)(mrow + shift_i * 1024 + d0 + 4);
        float4 c0 = *(const float4*)(mrow + scale_i * 1024 + d0), c1 = *(const float4*)(mrow + scale_i * 1024 + d0 + 4);
        float gg[8] = {g0.x, g0.y, g0.z, g0.w, g1.x, g1.y, g1.z, g1.w};
        float sh[8] = {s0.x, s0.y, s0.z, s0.w, s1.x, s1.y, s1.z, s1.w};
        float sc[8] = {c0.x, c0.y, c0.z, c0.w, c1.x, c1.y, c1.z, c1.w};
        float o[8];
#pragma unroll
        for (int j = 0; j < 8; ++j) o[j] = (x[hf * 8 + j] * rs * gg[j]) * (1.0f + sc[j]) + sh[j];
#pragma unroll
        for (int j = 0; j < 4; ++j) pk[hf * 4 + j] = pack2(o[2 * j], o[2 * j + 1]);
    }
    *(uint4*)(Hrow + lane * 8) = make_uint4(pk[0], pk[1], pk[2], pk[3]);
    *(uint4*)(Hrow + 512 + lane * 8) = make_uint4(pk[4], pk[5], pk[6], pk[7]);
}

__device__ __forceinline__ void phase_norm(const Params& p, int l, int which  ) {
    const int lane = ltid() & 63, w = ltid() >> 6;
    const float* X = (const float*)(p.ws + OFF_X);
    bf16_t* H = (bf16_t*)(p.ws + OFF_H);
    const float* mods = (const float*)(p.ws + OFF_MODS) + (size_t)l * 3 * 6144;
    const float* g = p.in[which ? I_N2G : I_N1G] + l * 1024;
    for (int row = blockIdx.x * 8 + w; row < TTOK; row += gridDim.x * 8) {
        const float* xr = X + (size_t)row * 1024;
        float x[16];
        float4 a = *(const float4*)(xr + lane * 8), b = *(const float4*)(xr + lane * 8 + 4);
        float4 c = *(const float4*)(xr + 512 + lane * 8), d = *(const float4*)(xr + 512 + lane * 8 + 4);
        x[0] = a.x; x[1] = a.y; x[2] = a.z; x[3] = a.w; x[4] = b.x; x[5] = b.y; x[6] = b.z; x[7] = b.w;
        x[8] = c.x; x[9] = c.y; x[10] = c.z; x[11] = c.w; x[12] = d.x; x[13] = d.y; x[14] = d.z; x[15] = d.w;
        float ss = 0.f;
#pragma unroll
        for (int j = 0; j < 16; ++j) ss += x[j] * x[j];
        ss = wave_sum(ss);
        premod_store(x, ss, g, mods + cond_of(row) * 6144, which ? 3 : 0, which ? 4 : 1, H + (size_t)row * 1024, lane);
    }
}

#define GT_STRIDE 72
#define GT_BUF (2 * 128 * GT_STRIDE)

#define GLOAD(RR, k0) { RR##0 = *(const u32x4*)(ap0 + (k0)); RR##1 = *(const u32x4*)(ap1 + (k0)); RR##2 = *(const u32x4*)(bp0 + (k0)); RR##3 = *(const u32x4*)(bp1 + (k0)); }
#define GWRITE(RR, buf) { bf16_t* dA = lds + (buf) * GT_BUF; bf16_t* dB = dA + 128 * GT_STRIDE; \
        *(u32x4*)(dA + r0 * GT_STRIDE + kc) = RR##0; *(u32x4*)(dA + (r0 + 64) * GT_STRIDE + kc) = RR##1; \
        *(u32x4*)(dB + r0 * GT_STRIDE + kc) = RR##2; *(u32x4*)(dB + (r0 + 64) * GT_STRIDE + kc) = RR##3; }
#define GCOMPUTE(buf) { const bf16_t* sA = lds + (buf) * GT_BUF; const bf16_t* sB = sA + 128 * GT_STRIDE; \
        _Pragma("unroll") for (int kk = 0; kk < 4; ++kk) { \
            bf16x8 a = *(const bf16x8*)(sA + arow * GT_STRIDE + kk * 16 + koff); \
            bf16x8 b0 = *(const bf16x8*)(sB + (wn * 64 + (lane & 31)) * GT_STRIDE + kk * 16 + koff); \
            bf16x8 b1 = *(const bf16x8*)(sB + (wn * 64 + 32 + (lane & 31)) * GT_STRIDE + kk * 16 + koff); \
            acc[0] = __builtin_amdgcn_mfma_f32_32x32x16_bf16(a, b0, acc[0], 0, 0, 0); \
            acc[1] = __builtin_amdgcn_mfma_f32_32x32x16_bf16(a, b1, acc[1], 0, 0, 0); } }
#define GSTEP_L(ks, RL, RW) { GLOAD(RL, ((ks) + 3) * 64); GCOMPUTE((ks) & 1); GWRITE(RW, ((ks) + 1) & 1); __syncthreads(); }
#define GSTEP_N(ks, RW)     { GCOMPUTE((ks) & 1); GWRITE(RW, ((ks) + 1) & 1); __syncthreads(); }

struct GemmRegs { u32x4 a0, a1, a2, a3, b0, b1, b2, b3, c0, c1, c2, c3; };
#define Ra0 R.a0
#define Ra1 R.a1
#define Ra2 R.a2
#define Ra3 R.a3
#define Rb0 R.b0
#define Rb1 R.b1
#define Rb2 R.b2
#define Rb3 R.b3
#define Rc0 R.c0
#define Rc1 R.c1
#define Rc2 R.c2
#define Rc3 R.c3
__device__ __forceinline__ void gemm_prefetch(const bf16_t* __restrict__ A, const bf16_t* __restrict__ Bt, int m0, int n0, GemmRegs& R) {
    const int tid = ltid();
    const int r0 = tid >> 3, kc = (tid & 7) * 8;
    const bf16_t* ap0 = A + (size_t)(m0 + r0) * 1024 + kc;
    const bf16_t* ap1 = A + (size_t)(m0 + r0 + 64) * 1024 + kc;
    const bf16_t* bp0 = Bt + (size_t)(n0 + r0) * 1024 + kc;
    const bf16_t* bp1 = Bt + (size_t)(n0 + r0 + 64) * 1024 + kc;
    GLOAD(Ra, 0); GLOAD(Rb, 64); GLOAD(Rc, 128);
}
__device__ __forceinline__ void gemm_mainloop(const bf16_t* __restrict__ A, const bf16_t* __restrict__ Bt, int m0, int n0,
                                              bf16_t* lds, f32x16 (&acc)[2], GemmRegs& R) {
    const int tid = ltid(), lane = tid & 63, w = tid >> 6;
    const int wm = w >> 1, wn = w & 1;
#pragma unroll
    for (int i = 0; i < 16; ++i) { acc[0][i] = 0.f; acc[1][i] = 0.f; }
    const int r0 = tid >> 3, kc = (tid & 7) * 8;
    const bf16_t* ap0 = A + (size_t)(m0 + r0) * 1024 + kc;
    const bf16_t* ap1 = A + (size_t)(m0 + r0 + 64) * 1024 + kc;
    const bf16_t* bp0 = Bt + (size_t)(n0 + r0) * 1024 + kc;
    const bf16_t* bp1 = Bt + (size_t)(n0 + r0 + 64) * 1024 + kc;
    GWRITE(Ra, 0);
    __syncthreads();
    const int arow = wm * 32 + (lane & 31), koff = (lane >> 5) * 8;
    GSTEP_L(0, Ra, Rb)  GSTEP_L(1, Rb, Rc)  GSTEP_L(2, Rc, Ra)
    GSTEP_L(3, Ra, Rb)  GSTEP_L(4, Rb, Rc)  GSTEP_L(5, Rc, Ra)
    GSTEP_L(6, Ra, Rb)  GSTEP_L(7, Rb, Rc)  GSTEP_L(8, Rc, Ra)
    GSTEP_L(9, Ra, Rb)  GSTEP_L(10, Rb, Rc) GSTEP_L(11, Rc, Ra)
    GSTEP_L(12, Ra, Rb) GSTEP_N(13, Rc)     GSTEP_N(14, Ra)
    { GCOMPUTE(1); __syncthreads(); }
}

#define G2_BUF (384 * GT_STRIDE)
struct Gemm2Regs { u32x4 a0, a1, a2, a3, a4, a5, b0, b1, b2, b3, b4, b5, c0, c1, c2, c3, c4, c5; };
#define G2LOAD(RR, k0) { R2.RR##0 = *(const u32x4*)(ap0 + (k0)); R2.RR##1 = *(const u32x4*)(ap0 + (size_t)64 * 1024 + (k0)); \
        R2.RR##2 = *(const u32x4*)(ap0 + (size_t)128 * 1024 + (k0)); R2.RR##3 = *(const u32x4*)(ap0 + (size_t)192 * 1024 + (k0)); \
        R2.RR##4 = *(const u32x4*)(bp0 + (k0)); R2.RR##5 = *(const u32x4*)(bp0 + (size_t)64 * 1024 + (k0)); }
#define G2WRITE(RR, buf) { bf16_t* dA = lds + (buf) * G2_BUF; bf16_t* dB = dA + 256 * GT_STRIDE; \
        *(u32x4*)(dA + r0 * GT_STRIDE + kc) = R2.RR##0; *(u32x4*)(dA + (r0 + 64) * GT_STRIDE + kc) = R2.RR##1; \
        *(u32x4*)(dA + (r0 + 128) * GT_STRIDE + kc) = R2.RR##2; *(u32x4*)(dA + (r0 + 192) * GT_STRIDE + kc) = R2.RR##3; \
        *(u32x4*)(dB + r0 * GT_STRIDE + kc) = R2.RR##4; *(u32x4*)(dB + (r0 + 64) * GT_STRIDE + kc) = R2.RR##5; }
#define G2COMPUTE(buf) { const bf16_t* sA = lds + (buf) * G2_BUF; const bf16_t* sB = sA + 256 * GT_STRIDE; \
        _Pragma("unroll") for (int kk = 0; kk < 4; ++kk) { \
            bf16x8 a0 = *(const bf16x8*)(sA + arow * GT_STRIDE + kk * 16 + koff); \
            bf16x8 a1 = *(const bf16x8*)(sA + (arow + 32) * GT_STRIDE + kk * 16 + koff); \
            bf16x8 b0 = *(const bf16x8*)(sB + brow * GT_STRIDE + kk * 16 + koff); \
            bf16x8 b1 = *(const bf16x8*)(sB + (brow + 32) * GT_STRIDE + kk * 16 + koff); \
            acc[0] = __builtin_amdgcn_mfma_f32_32x32x16_bf16(a0, b0, acc[0], 0, 0, 0); \
            acc[1] = __builtin_amdgcn_mfma_f32_32x32x16_bf16(a0, b1, acc[1], 0, 0, 0); \
            acc[2] = __builtin_amdgcn_mfma_f32_32x32x16_bf16(a1, b0, acc[2], 0, 0, 0); \
            acc[3] = __builtin_amdgcn_mfma_f32_32x32x16_bf16(a1, b1, acc[3], 0, 0, 0); } }
#define G2STEP_L(ks, RL, RW) { G2LOAD(RL, ((ks) + 3) * 64); G2COMPUTE((ks) & 1); G2WRITE(RW, ((ks) + 1) & 1); __syncthreads(); }
#define G2STEP_N(ks, RW)     { G2COMPUTE((ks) & 1); G2WRITE(RW, ((ks) + 1) & 1); __syncthreads(); }
__device__ __forceinline__ void gemm2_prefetch(const bf16_t* __restrict__ A, const bf16_t* __restrict__ Bt, int m0, int n0, Gemm2Regs& R2) {
    const int tid = ltid();
    const int r0 = tid >> 3, kc = (tid & 7) * 8;
    const bf16_t* ap0 = A + (size_t)(m0 + r0) * 1024 + kc;
    const bf16_t* bp0 = Bt + (size_t)(n0 + r0) * 1024 + kc;
    G2LOAD(a, 0); G2LOAD(b, 64); G2LOAD(c, 128);
}
__device__ __forceinline__ void gemm2_mainloop(const bf16_t* __restrict__ A, const bf16_t* __restrict__ Bt, int m0, int n0,
                                               bf16_t* lds, f32x16 (&acc)[4], Gemm2Regs& R2) {
    const int tid = ltid(), lane = tid & 63, w = tid >> 6;
    const int wm = w >> 1, wn = w & 1;
#pragma unroll
    for (int i = 0; i < 16; ++i) { acc[0][i] = 0.f; acc[1][i] = 0.f; acc[2][i] = 0.f; acc[3][i] = 0.f; }
    const int r0 = tid >> 3, kc = (tid & 7) * 8;
    const bf16_t* ap0 = A + (size_t)(m0 + r0) * 1024 + kc;
    const bf16_t* bp0 = Bt + (size_t)(n0 + r0) * 1024 + kc;
    G2WRITE(a, 0);
    __syncthreads();
    const int arow = wm * 64 + (lane & 31), brow = wn * 64 + (lane & 31), koff = (lane >> 5) * 8;
    G2STEP_L(0, a, b)  G2STEP_L(1, b, c)  G2STEP_L(2, c, a)
    G2STEP_L(3, a, b)  G2STEP_L(4, b, c)  G2STEP_L(5, c, a)
    G2STEP_L(6, a, b)  G2STEP_L(7, b, c)  G2STEP_L(8, c, a)
    G2STEP_L(9, a, b)  G2STEP_L(10, b, c) G2STEP_L(11, c, a)
    G2STEP_L(12, a, b) G2STEP_N(13, c)    G2STEP_N(14, a)
    { G2COMPUTE(1); __syncthreads(); }
}

#define ACC_ROW(wm, lane, r) ((wm) * 32 + ((r) & 3) + 8 * ((r) >> 2) + 4 * ((lane) >> 5))
#define ACC_COL(wn, lane, nt) ((wn) * 64 + (nt) * 32 + ((lane) & 31))

enum { EPI_RGIN = 0, EPI_GLAIN = 1, EPI_OUT = 2 };

__device__ __forceinline__ void phase_gemm(const Params& p, int l, int kind, float* ldsf, bool dry = false) {
    bf16_t* lds = (bf16_t*)ldsf;
    const int lane = ltid() & 63, w = ltid() >> 6, wm = w >> 1, wn = w & 1;
    const int jl = l >> 1;
    const bf16_t* A; const bf16_t* Bt; int ntn, N;
    float* PB = (float*)(p.ws + OFF_PB);
    float* X = (float*)(p.ws + OFF_X);
    if (kind == EPI_RGIN)       { A = (const bf16_t*)(p.ws + OFF_H); Bt = (const bf16_t*)(p.ws + OFF_RGWIN) + (size_t)jl * 2048 * 1024; ntn = 16; N = 2048; }
    else if (kind == EPI_GLAIN) { A = (const bf16_t*)(p.ws + OFF_H); Bt = (const bf16_t*)(p.ws + OFF_GLWIN) + (size_t)jl * 3200 * 1024; ntn = 25; N = 3104; }
    else { A = (const bf16_t*)(p.ws + OFF_Y); Bt = (l & 1) ? (const bf16_t*)(p.ws + OFF_GLWOUT) + (size_t)jl * 1024 * 1024 : (const bf16_t*)(p.ws + OFF_RGWOUT) + (size_t)jl * 1024 * 1024; ntn = 8; N = 1024; }
    const float* mods = (const float*)(p.ws + OFF_MODS) + (size_t)l * 3 * 6144;
    if (kind != EPI_RGIN) {
        const int ntn2 = (kind == EPI_GLAIN) ? 21 : ntn;
        const int ntiles2 = 24 * ntn2;
        Gemm2Regs R2;
        if ((int)blockIdx.x < ntiles2) gemm2_prefetch(A, Bt, ((int)blockIdx.x % 24) * 256, ((int)blockIdx.x / 24) * 128, R2);
#pragma unroll 1
        for (int t = blockIdx.x; t < ntiles2; t += gridDim.x) {
            const int m0 = (t % 24) * 256, n0 = (t / 24) * 128;
            f32x16 acc[4];
            gemm2_mainloop(A, Bt, m0, n0, lds, acc, R2);
            { const int tn = t + gridDim.x; if (tn < ntiles2) gemm2_prefetch(A, Bt, (tn % 24) * 256, (tn / 24) * 128, R2); }
            const int cnd = cond_of(m0);
#pragma unroll
            for (int q = 0; q < 4; ++q) {
                const int col = n0 + wn * 64 + (q & 1) * 32 + (lane & 31);
                const float gate = (kind == EPI_OUT) ? mods[cnd * 6144 + 2 * 1024 + col] : 0.f;
#pragma unroll
                for (int r = 0; r < 16; ++r) {
                    const int row = m0 + (w >> 1) * 64 + (q >> 1) * 32 + (r & 3) + 8 * (r >> 2) + 4 * (lane >> 5);
                    float v = acc[q][r];
                    if (kind == EPI_GLAIN) {
                        if (col < 512) v *= 0.08838834764831845f;
                        if (col < N) PB[(size_t)row * 3104 + col] = v;
                    } else {
                        float* Xo = dry ? PB : X;
                        Xo[(size_t)row * 1024 + col] = X[(size_t)row * 1024 + col] + gate * v;
                    }
                }
            }
        }
        if (kind == EPI_OUT) {
            if (!dry && gridDim.x == 256 && (int)blockIdx.x >= 192) {
#pragma unroll 1
                for (int k = 0; k < 4; ++k) setup_convert_unit(p, 256 + l * 256 + ((int)blockIdx.x - 192) * 4 + k, true);
            }
            return;
        }
    }
    const int ntb = (kind == EPI_GLAIN) ? 21 : 0;
    const int ntiles = 48 * (ntn - ntb);
    GemmRegs R;
    if ((int)blockIdx.x < ntiles) gemm_prefetch(A, Bt, ((int)blockIdx.x % 48) * 128, (ntb + (int)blockIdx.x / 48) * 128, R);
#pragma unroll 1
    for (int t = blockIdx.x; t < ntiles; t += gridDim.x) {
        const int mt = t % 48, nt_ = ntb + t / 48;
        const int m0 = mt * 128, n0 = nt_ * 128;
        f32x16 acc[2];
        gemm_mainloop(A, Bt, m0, n0, lds, acc, R);
        { const int tn = t + gridDim.x; if (tn < ntiles) gemm_prefetch(A, Bt, (tn % 48) * 128, (ntb + tn / 48) * 128, R); }
#pragma unroll
        for (int nt = 0; nt < 2; ++nt) {
#pragma unroll
            for (int r = 0; r < 16; ++r) {
                const int row = m0 + ACC_ROW(wm, lane, r), col = n0 + ACC_COL(wn, lane, nt);
                float v = acc[nt][r];
                if (kind == EPI_RGIN) {
                    if (col < 1024) v = gelu_tanh(v);
                    PB[(size_t)row * 2048 + col] = v;
                } else if (kind == EPI_GLAIN) {
                    if (col < 512) v *= 0.08838834764831845f;
                    if (col < N) PB[(size_t)row * 3104 + col] = v;
                } else {
                    const float gate = mods[cond_of(row) * 6144 + 2 * 1024 + col];
                    float* Xo = dry ? PB : X;
                    Xo[(size_t)row * 1024 + col] = X[(size_t)row * 1024 + col] + gate * v;
                }
            }
        }
    }
}

__device__ __forceinline__ void phase_peerq(const Params& p, int l, float* ldsf) {
    bf16_t* lds = (bf16_t*)ldsf;
    const int tid = ltid(), lane = tid & 63, w = tid >> 6, wm = w >> 1, wn = w & 1;
    const bf16_t* A = (const bf16_t*)(p.ws + OFF_H);
    const bf16_t* Bt = (const bf16_t*)(p.ws + OFF_PWQ) + (size_t)l * 2048 * 1024;
    const bf16_t* PK = (const bf16_t*)(p.ws + OFF_PK) + (size_t)l * 262144;
    float* TK = (float*)(p.ws + OFF_TK);
    bf16_t* Qs = lds;
    float* Ss = ldsf + (128 * 136 * 2) / 4;
    GemmRegs R;
    if ((int)blockIdx.x < 768) gemm_prefetch(A, Bt, ((int)blockIdx.x % 48) * 128, ((int)blockIdx.x / 48) * 128, R);
#pragma unroll 1
    for (int t = blockIdx.x; t < 48 * 16; t += gridDim.x) {
        const int mt = t % 48, nt_ = t / 48;
        const int m0 = mt * 128, n0 = nt_ * 128;
        const int h = nt_ >> 1, side = nt_ & 1;
        f32x16 acc[2];
        gemm_mainloop(A, Bt, m0, n0, lds, acc, R);
        { const int tn = t + gridDim.x; if (tn < 768) gemm_prefetch(A, Bt, (tn % 48) * 128, (tn / 48) * 128, R); }
#pragma unroll
        for (int nt = 0; nt < 2; ++nt)
#pragma unroll
            for (int r = 0; r < 16; ++r)
                Qs[ACC_ROW(wm, lane, r) * 136 + ACC_COL(wn, lane, nt)] = (bf16_t)f2bf(acc[nt][r]);
        __syncthreads();
        const bf16_t* kp = PK + (size_t)(side * 8 + h) * 16384;
#pragma unroll
        for (int i = 0; i < 16; ++i) { acc[0][i] = 0.f; acc[1][i] = 0.f; }
#pragma unroll
        for (int kk = 0; kk < 8; ++kk) {
            bf16x8 a = *(const bf16x8*)(Qs + (wm * 32 + (lane & 31)) * 136 + kk * 16 + (lane >> 5) * 8);
            bf16x8 b0 = *(const bf16x8*)(kp + (wn * 64 + (lane & 31)) * 128 + kk * 16 + (lane >> 5) * 8);
            bf16x8 b1 = *(const bf16x8*)(kp + (wn * 64 + 32 + (lane & 31)) * 128 + kk * 16 + (lane >> 5) * 8);
            acc[0] = __builtin_amdgcn_mfma_f32_32x32x16_bf16(a, b0, acc[0], 0, 0, 0);
            acc[1] = __builtin_amdgcn_mfma_f32_32x32x16_bf16(a, b1, acc[1], 0, 0, 0);
        }
#pragma unroll
        for (int nt = 0; nt < 2; ++nt)
#pragma unroll
            for (int r = 0; r < 16; ++r)
                Ss[ACC_ROW(wm, lane, r) * 129 + ACC_COL(wn, lane, nt)] = acc[nt][r];
        __syncthreads();
        {
            const int row = tid & 127, part = tid >> 7;
            float v[16];
#pragma unroll
            for (int j = 0; j < 16; ++j) v[j] = -3.0e38f;
            const float* sr = Ss + row * 129 + part * 32;
#pragma unroll 4
            for (int n = 0; n < 32; ++n) {
                float x = __uint_as_float((__float_as_uint(sr[n]) & 0xffffff80u) | (unsigned)(part * 32 + n));
#pragma unroll
                for (int j = 15; j >= 1; --j) v[j] = __builtin_amdgcn_fmed3f(x, v[j - 1], v[j]);
                v[0] = fmaxf(x, v[0]);
            }
            float* mg = ldsf;
#define TOPK_MERGE() { \
                _Pragma("unroll") for (int j = 0; j < 16; ++j) v[j] = fmaxf(v[j], o[15 - j]); \
                _Pragma("unroll") for (int dd = 8; dd >= 1; dd >>= 1) { \
                    _Pragma("unroll") for (int i = 0; i < 16; ++i) { if ((i & dd) == 0) { const float hi_ = fmaxf(v[i], v[i + dd]), lo_ = fminf(v[i], v[i + dd]); v[i] = hi_; v[i + dd] = lo_; } } } }
            __syncthreads();
            if (part & 1) {
#pragma unroll
                for (int j = 0; j < 16; ++j) mg[((part >> 1) * 128 + row) * 17 + j] = v[j];
            }
            __syncthreads();
            if (!(part & 1)) {
                float o[16];
#pragma unroll
                for (int j = 0; j < 16; ++j) o[j] = mg[((part >> 1) * 128 + row) * 17 + j];
                TOPK_MERGE()
            }
            __syncthreads();
            if (part == 2) {
#pragma unroll
                for (int j = 0; j < 16; ++j) mg[row * 17 + j] = v[j];
            }
            __syncthreads();
            if (part == 0) {
                float o[16];
#pragma unroll
                for (int j = 0; j < 16; ++j) o[j] = mg[row * 17 + j];
                TOPK_MERGE()
                float4* og = (float4*)(TK + ((size_t)(m0 + row) * 16 + h * 2 + side) * 16);
                og[0] = make_float4(v[0], v[1], v[2], v[3]); og[1] = make_float4(v[4], v[5], v[6], v[7]);
                og[2] = make_float4(v[8], v[9], v[10], v[11]); og[3] = make_float4(v[12], v[13], v[14], v[15]);
            }
        }
        __syncthreads();
    }
}

__device__ __forceinline__ void conv_row(int l, int gw, int st, int& tab, int& r) {
    const int rid = 16384 + gw * 8 + st; tab = rid >> 14; r = (l + 1) * 16384 + (rid & 16383);
}
__device__ __forceinline__ void phase_peer_gather(const Params& p, int l, float* ldsf, bool dry = false) {
    const int tid = ltid(), lane = tid & 63, w = tid >> 6;
    int* eidL = (int*)ldsf;
    float* gateL = ldsf + 24 * 128;
    float* suL = ldsf + 48 * 128;
    float* wL = ldsf + 72 * 128 + w * 384;
    int* cntL = (int*)(ldsf + 96 * 128);
    int* baseL = cntL + 192 * 16;
    int* eidU = baseL + 24 * 16;
    float* gateU = (float*)(eidU + 24 * 128);
    const float* TK = (const float*)(p.ws + OFF_TK);
    float* X = (float*)(p.ws + OFF_X);
    bf16_t* H = (bf16_t*)(p.ws + OFF_H);
    float* Xw = dry ? (float*)(p.ws + OFF_PB) : X;
    bf16_t* Hw = dry ? (bf16_t*)(p.ws + OFF_PB + (size_t)TTOK * DM * 4) : H;
    float* Yw = dry ? (float*)(p.ws + OFF_PB) : p.out + OUT_Y;
    const unsigned char* PU = p.ws + OFF_PU + (size_t)l * 16384 * 1024;
    const unsigned char* PV = p.ws + OFF_PV + (size_t)l * 16384 * 1024;
    const float* SU = (const float*)(p.ws + OFF_SU) + l * 16384;
    const float* SV = (const float*)(p.ws + OFF_SV) + l * 16384;
    const float* mods = (const float*)(p.ws + OFF_MODS) + (size_t)l * 3 * 6144;
    for (int sg = blockIdx.x; sg < 256; sg += gridDim.x) {
        const int t0 = sg * 24;
        const bool defer = ((l & 1) == 0) && (gridDim.x == 256) && !dry;
        f32x4 cv0, cv1, cv2, cv3;
        cv0 = cv1 = cv2 = cv3 = (f32x4){0.f, 0.f, 0.f, 0.f};
#define CONV_ISSUE(st_) { if (defer) { int tab_, r_; conv_row(l, (int)blockIdx.x * 8 + w, (st_), tab_, r_); \
            const float* src_ = p.in[tab_ ? I_PV : I_PU] + (size_t)r_ * 1024 + lane * 4; \
            cv0 = __builtin_nontemporal_load((const f32x4*)src_); cv1 = __builtin_nontemporal_load((const f32x4*)(src_ + 256)); \
            cv2 = __builtin_nontemporal_load((const f32x4*)(src_ + 512)); cv3 = __builtin_nontemporal_load((const f32x4*)(src_ + 768)); } }
#define CONV_Q(v_) ({ int pk_ = 0; pk_ = __builtin_amdgcn_cvt_pk_fp8_f32((v_)[0] * inv_, (v_)[1] * inv_, pk_, false); \
            pk_ = __builtin_amdgcn_cvt_pk_fp8_f32((v_)[2] * inv_, (v_)[3] * inv_, pk_, true); (unsigned)pk_; })
#define CONV_AM(v_) fmaxf(fmaxf(fabsf((v_)[0]), fabsf((v_)[1])), fmaxf(fabsf((v_)[2]), fabsf((v_)[3])))
#define CONV_FINISH(st_) { if (defer) { int tab_, r_; conv_row(l, (int)blockIdx.x * 8 + w, (st_), tab_, r_); \
            float am_ = fmaxf(fmaxf(CONV_AM(cv0), CONV_AM(cv1)), fmaxf(CONV_AM(cv2), CONV_AM(cv3))); \
            _Pragma("unroll") for (int o_ = 32; o_ >= 1; o_ >>= 1) am_ = fmaxf(am_, __shfl_xor(am_, o_)); \
            const float scale_ = am_ > 0.f ? am_ * (1.0f / 448.0f) : 1.0f; const float inv_ = 1.0f / scale_; \
            const u32x4 ov_ = {CONV_Q(cv0), CONV_Q(cv1), CONV_Q(cv2), CONV_Q(cv3)}; \
            __builtin_nontemporal_store(ov_, (u32x4*)(p.ws + (tab_ ? OFF_PV : OFF_PU) + (size_t)r_ * 1024 + lane * 16)); \
            if (lane == 0) ((float*)(p.ws + (tab_ ? OFF_SV : OFF_SU)))[r_] = scale_; } }
        f32x2 xf2[3][8];
#pragma unroll
        for (int tt = 0; tt < 3; ++tt) {
            const int tok = t0 + w + tt * 8;
#pragma unroll
            for (int q = 0; q < 4; ++q) {
                uint2 hv = *(const uint2*)(H + (size_t)tok * 1024 + q * 256 + lane * 4);
                xf2[tt][q * 2] = (f32x2){bflo(hv.x), bfhi(hv.x)}; xf2[tt][q * 2 + 1] = (f32x2){bflo(hv.y), bfhi(hv.y)};
            }
        }
        __syncthreads();
        const int ctl = tid >> 3, ch = tid & 7;
        if (tid < 192) {
            const float* tk = TK + ((size_t)(t0 + ctl) * 16 + ch * 2) * 16;
            float v1[16], v2[16];
#pragma unroll
            for (int j = 0; j < 4; ++j) {
                float4 a = *(const float4*)(tk + j * 4), b = *(const float4*)(tk + 16 + j * 4);
                v1[j * 4] = a.x; v1[j * 4 + 1] = a.y; v1[j * 4 + 2] = a.z; v1[j * 4 + 3] = a.w;
                v2[j * 4] = b.x; v2[j * 4 + 1] = b.y; v2[j * 4 + 2] = b.z; v2[j * 4 + 3] = b.w;
            }
            int* idxL = (int*)(gateU + 24 * 128) + tid * 32;
#pragma unroll
            for (int j = 0; j < 16; ++j) {
                idxL[j] = (int)(__float_as_uint(v1[j]) & 127u); idxL[16 + j] = (int)(__float_as_uint(v2[j]) & 127u);
                v1[j] = __uint_as_float(__float_as_uint(v1[j]) & 0xffffff80u);
                v2[j] = __uint_as_float(__float_as_uint(v2[j]) & 0xffffff80u);
            }
            float top[16];
#pragma unroll
            for (int j = 0; j < 16; ++j) top[j] = -3.0e38f;
#pragma unroll
            for (int a = 0; a < 16; ++a) {
#pragma unroll
                for (int b = 0; b < 16; ++b) {
                    if ((a + 1) * (b + 1) <= 16) {
                        float sm = v1[a] + v2[b];
                        float x = __uint_as_float((__float_as_uint(sm) & 0xffffff00u) | (unsigned)(a * 16 + b));
#pragma unroll
                        for (int j = 15; j >= 1; --j) top[j] = __builtin_amdgcn_fmed3f(x, top[j - 1], top[j]);
                        top[0] = fmaxf(x, top[0]);
                    }
                }
            }
            const float mx = __uint_as_float(__float_as_uint(top[0]) & 0xffffff00u);
            float gg[16]; float sum = 0.f;
#pragma unroll
            for (int j = 0; j < 16; ++j) {
                float sv = __uint_as_float(__float_as_uint(top[j]) & 0xffffff00u);
                gg[j] = __expf(sv - mx); sum += gg[j];
            }
            const float inv = 1.0f / sum;
            int* myc = cntL + tid * 16;
#pragma unroll
            for (int b = 0; b < 16; ++b) myc[b] = 0;
            int eu[16];
#pragma unroll
            for (int j = 0; j < 16; ++j) {
                const unsigned ab = __float_as_uint(top[j]) & 0xffu;
                const int e = idxL[ab >> 4] * 128 + idxL[16 + (ab & 15u)];
                const int b = e >> 10;
                const int r = myc[b]; myc[b] = r + 1;
                eu[j] = e | (r << 16);
            }
#pragma unroll
            for (int j = 0; j < 16; ++j) { eidU[ctl * 128 + ch * 16 + j] = eu[j]; }
#pragma unroll
            for (int j = 0; j < 16; ++j) gg[j] *= inv;
#pragma unroll
            for (int j = 0; j < 16; ++j) gateU[ctl * 128 + ch * 16 + j] = gg[j];
        }
        __syncthreads();
        if (tid < 384) {
            const int tl = tid >> 4, b = tid & 15;
            int run = 0;
#pragma unroll
            for (int hh = 0; hh < 8; ++hh) { int* c = cntL + (tl * 8 + hh) * 16 + b; const int v = *c; *c = run; run += v; }
            baseL[tl * 16 + b] = run;
        }
        __syncthreads();
        if (tid < 24) {
            int run = 0;
#pragma unroll
            for (int b = 0; b < 16; ++b) { const int v = baseL[tid * 16 + b]; baseL[tid * 16 + b] = run; run += v; }
        }
        __syncthreads();
        if (tid < 192) {
#pragma unroll 4
            for (int j = 0; j < 16; ++j) {
                const int pk = eidU[ctl * 128 + ch * 16 + j];
                const int e = pk & 0xffff, r = pk >> 16, b = e >> 10;
                const int pos = baseL[ctl * 16 + b] + cntL[tid * 16 + b] + r;
                eidL[ctl * 128 + pos] = e;
                gateL[ctl * 128 + pos] = gateU[ctl * 128 + ch * 16 + j] * SV[e];
                suL[ctl * 128 + pos] = SU[e];
            }
        }
        __syncthreads();
        int ecur[3][8];
#pragma unroll
        for (int tt = 0; tt < 3; ++tt)
#pragma unroll
            for (int j = 0; j < 8; ++j) ecur[tt][j] = __builtin_amdgcn_readfirstlane(eidL[(w + tt * 8) * 128 + j]);
#pragma unroll 1
        for (int bt = 0; bt < 16; ++bt) {
            u32x4 ua[3][8];
#pragma unroll
            for (int tt = 0; tt < 3; ++tt) {
#pragma unroll
                for (int j = 0; j < 8; ++j) ua[tt][j] = *(const u32x4*)(PU + (size_t)ecur[tt][j] * 1024 + lane * 16);
            }
            {
                const int bn = (bt + 1) & 15;
#pragma unroll
                for (int tt = 0; tt < 3; ++tt)
#pragma unroll
                    for (int j = 0; j < 8; ++j) ecur[tt][j] = __builtin_amdgcn_readfirstlane(eidL[(w + tt * 8) * 128 + bn * 8 + j]);
            }
#pragma unroll
            for (int tt = 0; tt < 3; ++tt) {
                const int tl = w + tt * 8;
                float pp[8];
#pragma unroll
                for (int j = 0; j < 8; ++j) {
                    f32x2 sv = {0.f, 0.f};
#pragma unroll
                    for (int q = 0; q < 4; ++q) {
                        f32x2 lo = __builtin_amdgcn_cvt_pk_f32_fp8((int)ua[tt][j][q], false);
                        f32x2 hi = __builtin_amdgcn_cvt_pk_f32_fp8((int)ua[tt][j][q], true);
                        sv = xf2[tt][q * 2] * lo + sv;
                        sv = xf2[tt][q * 2 + 1] * hi + sv;
                    }
                    pp[j] = sv[0] + sv[1];
                }
                float q4[4], q2[2], s1;
                {
                    const bool hi = (lane & 32) != 0;
#pragma unroll
                    for (int i = 0; i < 4; ++i) { float a = pp[2 * i], b = pp[2 * i + 1]; float send = hi ? a : b, keep = hi ? b : a; q4[i] = keep + __shfl_xor(send, 32); }
                }
                {
                    const bool hi = (lane & 16) != 0;
#pragma unroll
                    for (int i = 0; i < 2; ++i) { float a = q4[2 * i], b = q4[2 * i + 1]; float send = hi ? a : b, keep = hi ? b : a; q2[i] = keep + __shfl_xor(send, 16); }
                }
                {
                    const bool hi = (lane & 8) != 0;
                    float a = q2[0], b = q2[1]; float send = hi ? a : b, keep = hi ? b : a; s1 = keep + __shfl_xor(send, 8);
                }
                s1 += __shfl_xor(s1, 4); s1 += __shfl_xor(s1, 2); s1 += __shfl_xor(s1, 1);
                const int jj = ((lane >> 5) & 1) + 2 * ((lane >> 4) & 1) + 4 * ((lane >> 3) & 1);
                if ((lane & 7) == 0) wL[tt * 128 + bt * 8 + jj] = gateL[tl * 128 + bt * 8 + jj] * gelu_tanh(s1 * suL[tl * 128 + bt * 8 + jj]);
            }
        }
        f32x2 acc2[3][8];
#pragma unroll
        for (int tt = 0; tt < 3; ++tt)
#pragma unroll
            for (int j = 0; j < 8; ++j) acc2[tt][j] = (f32x2){0.f, 0.f};
        CONV_ISSUE(0)
#pragma unroll 1
        for (int bt = 0; bt < 16; ++bt) {
            u32x4 va[3][8];
#pragma unroll
            for (int tt = 0; tt < 3; ++tt) {
#pragma unroll
                for (int j = 0; j < 8; ++j) va[tt][j] = *(const u32x4*)(PV + (size_t)ecur[tt][j] * 1024 + lane * 16);
            }
            {
                const int bn = (bt + 1) & 15;
#pragma unroll
                for (int tt = 0; tt < 3; ++tt)
#pragma unroll
                    for (int j = 0; j < 8; ++j) ecur[tt][j] = __builtin_amdgcn_readfirstlane(eidL[(w + tt * 8) * 128 + bn * 8 + j]);
            }
#pragma unroll
            for (int tt = 0; tt < 3; ++tt) {
#pragma unroll
                for (int j = 0; j < 8; ++j) {
                    const float wj = wL[tt * 128 + bt * 8 + j];
                    const f32x2 wj2 = {wj, wj};
#pragma unroll
                    for (int q = 0; q < 4; ++q) {
                        f32x2 lo = __builtin_amdgcn_cvt_pk_f32_fp8((int)va[tt][j][q], false);
                        f32x2 hi = __builtin_amdgcn_cvt_pk_f32_fp8((int)va[tt][j][q], true);
                        acc2[tt][q * 2] = wj2 * lo + acc2[tt][q * 2];
                        acc2[tt][q * 2 + 1] = wj2 * hi + acc2[tt][q * 2 + 1];
                    }
                }
            }
            if (bt < 8) CONV_FINISH(bt)
            if (bt + 1 < 8) CONV_ISSUE(bt + 1)
        }
        int oz2 = 0; asm volatile("" : "+v"(oz2));
#pragma unroll
        for (int tt = 0; tt < 3; ++tt) {
            const int lane = (ltid() & 63) + oz2, w = (ltid() >> 6) + oz2;
            const int tok = t0 + w + tt * 8;
            float* xr = X + (size_t)tok * 1024;
            const float* m5 = mods + cond_of(tok) * 6144 + 5 * 1024;
            float x[16];
#pragma unroll
            for (int q = 0; q < 4; ++q) {
                float4 a = *(const float4*)(xr + q * 256 + lane * 4);
                float4 g = *(const float4*)(m5 + q * 256 + lane * 4);
                x[q * 4] = a.x + g.x * acc2[tt][q * 2][0]; x[q * 4 + 1] = a.y + g.y * acc2[tt][q * 2][1];
                x[q * 4 + 2] = a.z + g.z * acc2[tt][q * 2 + 1][0]; x[q * 4 + 3] = a.w + g.w * acc2[tt][q * 2 + 1][1];
            }
            float ss = 0.f;
#pragma unroll
            for (int j = 0; j < 16; ++j) ss += x[j] * x[j];
            ss = wave_sum(ss);
            const float rs = rsqrtf(ss * (1.0f / 1024.0f) + EPSV);
            if (l < 3) {
                float* xw = Xw + (size_t)tok * 1024;
                const float* modn = (const float*)(p.ws + OFF_MODS) + (size_t)(l + 1) * 3 * 6144 + cond_of(tok) * 6144;
                const float* g1 = p.in[I_N1G] + (l + 1) * 1024;
                bf16_t* hw = Hw + (size_t)tok * 1024;
#pragma unroll
                for (int q = 0; q < 4; ++q) {
                    const int d0 = q * 256 + lane * 4;
                    *(float4*)(xw + d0) = make_float4(x[q * 4], x[q * 4 + 1], x[q * 4 + 2], x[q * 4 + 3]);
                    float4 g = *(const float4*)(g1 + d0), sh = *(const float4*)(modn + d0), sc = *(const float4*)(modn + 1024 + d0);
                    float o0 = (x[q * 4] * rs * g.x) * (1.0f + sc.x) + sh.x, o1 = (x[q * 4 + 1] * rs * g.y) * (1.0f + sc.y) + sh.y;
                    float o2 = (x[q * 4 + 2] * rs * g.z) * (1.0f + sc.z) + sh.z, o3 = (x[q * 4 + 3] * rs * g.w) * (1.0f + sc.w) + sh.w;
                    *(uint2*)(hw + d0) = make_uint2(pack2(o0, o1), pack2(o2, o3));
                }
            } else {
                const float* g = p.in[I_FNG];
                float* yo = Yw + (size_t)tok * 1024;
#pragma unroll
                for (int q = 0; q < 4; ++q) {
                    const int d0 = q * 256 + lane * 4;
                    float4 g0 = *(const float4*)(g + d0);
                    *(float4*)(yo + d0) = make_float4(x[q * 4] * rs * g0.x, x[q * 4 + 1] * rs * g0.y, x[q * 4 + 2] * rs * g0.z, x[q * 4 + 3] * rs * g0.w);
                }
            }
        }
    }
}

#define RG_XS 68
#define RG_RS 257
__device__ __forceinline__ void rg_unit(const Params& p, int l, int seq, int n, int ct, float* lds) {
    const int tid0 = ltid(), lane0 = tid0 & 63, w0 = tid0 >> 6;
    const int jl = l >> 1;
    const int L = seq < 16 ? 256 : 1024;
    const int tokbase = seq < 16 ? seq * 256 : 4096 + (seq - 16) * 1024;
    const int nsteps = L >> 8;
    const int cbase = n * 64, obase = cbase + ct * 32;
    float* xr = lds;
    float* aS = lds + 256 * RG_XS;
    float* bS = aS + 32 * RG_RS;
    float* segA = bS + 32 * RG_RS;
    float* segB = segA + 512;
    bf16_t* wS = (bf16_t*)(segB + 512);
    const float* PB = (const float*)(p.ws + OFF_PB);
    float* HF = (float*)(p.ws + OFF_HF);
    bf16_t* Y = (bf16_t*)(p.ws + OFF_Y);
    const int cg0 = tid0 & 15, tr0 = tid0 >> 4;
    f32x4 cwv[4]; f32x4 cbv;
    {
        const float* cw = p.in[I_RGCW] + jl * 4096 + cbase + cg0 * 4;
#pragma unroll
        for (int j = 0; j < 4; ++j) cwv[j] = *(const f32x4*)(cw + j * 1024);
        cbv = *(const f32x4*)(p.in[I_RGCB] + jl * 1024 + cbase + cg0 * 4);
    }
    const int sc0 = tid0 & 31, sg0 = tid0 >> 5;
    f32x4 rw[11];
#define RG_ISSUE(pb_) { const int pos0_ = (pb_) + tr * 8 - 2; \
        _Pragma("unroll") for (int j = 0; j < 11; ++j) { const int pp_ = pos0_ + j; \
            f32x4 z_ = {0.f, 0.f, 0.f, 0.f}; if (pp_ >= 0 && pp_ < L) z_ = *(const f32x4*)(PB + (size_t)(tokbase + pp_) * 2048 + 1024 + cbase + cg * 4); rw[j] = z_; } }
    { const int tr = tr0, cg = cg0; RG_ISSUE(0) }
    float hfreg[16];
#pragma unroll
    for (int j = 0; j < 16; ++j) hfreg[j] = 0.f;
    __syncthreads();
#pragma unroll 1
    for (int d = 0; d < 2; ++d) {
        const int m = (jl * 2 + d) * 16 + n;
        const bf16_t* WT = (const bf16_t*)(p.ws + OFF_RGW) + (size_t)m * 2 * 4096;
        {
            const int g_ = tid0 >> 8, j_ = (tid0 >> 3) & 31, k8 = (tid0 & 7) * 8;
            *(u32x4*)(wS + (g_ * 32 + j_) * 72 + k8) = *(const u32x4*)(WT + g_ * 4096 + (ct * 32 + j_) * 64 + k8);
        }
        const int cch = obase + (lane0 & 31);
        const float bav = p.in[I_RGBA][(jl * 2 + d) * 1024 + cch];
        const float biv = p.in[I_RGBI][(jl * 2 + d) * 1024 + cch];
        const float spv = __logf(1.0f + __expf(-p.in[I_RGLAM][(jl * 2 + d) * 1024 + cch]));
        float hc = 0.f;
        if (seq >= 16) hc = p.in[I_SRG][(((seq - 16) * 2 + jl) * 2 + d) * 1024 + obase + sc0];
#pragma unroll 1
        for (int st = 0; st < nsteps; ++st) {
            const int pbase = d ? (L - 256 - st * 256) : st * 256;
            int oz = 0; asm volatile("" : "+v"(oz));
            const int lane = lane0 + oz, w = w0 + oz, tid = tid0 + oz;
            const int cg = tid & 15, tr = tid >> 4, sc = tid & 31, sg = tid >> 5, tt = tid >> 1, half = tid & 1;
            if (!(nsteps == 1 && d == 1)) {
#pragma unroll
                for (int t = 0; t < 8; ++t) {
                    f32x4 o = cbv + cwv[0] * rw[t] + cwv[1] * rw[t + 1] + cwv[2] * rw[t + 2] + cwv[3] * rw[t + 3];
                    *(f32x4*)(xr + (tr * 8 + t) * RG_XS + cg * 4) = o;
                }
                if (nsteps > 1) {
                    int nd = d, nst = st + 1;
                    if (nst == nsteps) { nd = d + 1; nst = 0; }
                    if (nd < 2) { const int npb = nd ? (L - 256 - nst * 256) : nst * 256; RG_ISSUE(npb) }
                }
            }
            __syncthreads();
            f32x16 accR, accI;
#pragma unroll
            for (int i = 0; i < 16; ++i) { accR[i] = 0.f; accI[i] = 0.f; }
#pragma unroll
            for (int kk = 0; kk < 4; ++kk) {
                const float* ap = xr + (w * 32 + (lane & 31)) * RG_XS + kk * 16 + (lane >> 5) * 8;
                const float4 x0 = *(const float4*)ap, x1 = *(const float4*)(ap + 4);
                union { bf16x8 v; unsigned u[4]; } af;
                af.u[0] = pack2(x0.x, x0.y); af.u[1] = pack2(x0.z, x0.w); af.u[2] = pack2(x1.x, x1.y); af.u[3] = pack2(x1.z, x1.w);
                const bf16x8 bRk = *(const bf16x8*)(wS + (lane & 31) * 72 + kk * 16 + (lane >> 5) * 8);
                const bf16x8 bIk = *(const bf16x8*)(wS + (32 + (lane & 31)) * 72 + kk * 16 + (lane >> 5) * 8);
                accR = __builtin_amdgcn_mfma_f32_32x32x16_bf16(af.v, bRk, accR, 0, 0, 0);
                accI = __builtin_amdgcn_mfma_f32_32x32x16_bf16(af.v, bIk, accI, 0, 0, 0);
            }
#pragma unroll
            for (int r = 0; r < 16; ++r) {
                const int row = w * 32 + (r & 3) + 8 * (r >> 2) + 4 * (lane >> 5);
                const float rg = sigmoidf_(accR[r] + bav);
                const float ig = sigmoidf_(accI[r] + biv);
                const float av = __expf(-8.0f * rg * spv);
                const float mult = sqrtf(fmaxf(1.0f - av * av, 0.f));
                const float xc = xr[row * RG_XS + ct * 32 + (lane & 31)];
                const int s_ = d ? 255 - row : row;
                aS[(lane & 31) * RG_RS + s_] = av;
                bS[(lane & 31) * RG_RS + s_] = mult * ig * xc;
            }
            const int tok = tokbase + pbase + tt;
            f32x4 gq[4], hq[4];
            if (d == 1) {
                const float* gp = PB + (size_t)tok * 2048 + obase + half * 16;
#pragma unroll
                for (int j = 0; j < 4; ++j) gq[j] = *(const f32x4*)(gp + j * 4);
                if (nsteps > 1) {
                    const float* hp = HF + (size_t)tok * 1024 + obase + half * 16;
#pragma unroll
                    for (int j = 0; j < 4; ++j) hq[j] = *(const f32x4*)(hp + j * 4);
                }
            }
            __syncthreads();
            {
                const int base = sc * RG_RS + sg * 16;
                float av[16], bv[16];
                float Aa = 1.f, Bb = 0.f;
#pragma unroll
                for (int i = 0; i < 16; ++i) { av[i] = aS[base + i]; bv[i] = bS[base + i]; Bb = av[i] * Bb + bv[i]; Aa *= av[i]; }
                segA[sg * 32 + sc] = Aa; segB[sg * 32 + sc] = Bb;
                __syncthreads();
                float hin = hc, hall = hc;
#pragma unroll
                for (int g = 0; g < 16; ++g) {
                    const float sa = segA[g * 32 + sc], sb = segB[g * 32 + sc];
                    hall = sa * hall + sb;
                    if (g < sg) hin = hall;
                }
                float hcur = hin;
#pragma unroll
                for (int i = 0; i < 16; ++i) { hcur = av[i] * hcur + bv[i]; bS[base + i] = hcur; }
                hc = hall;
            }
            __syncthreads();
            {
                const int s_ = d ? 255 - tt : tt;
                float hv[16];
#pragma unroll
                for (int j = 0; j < 16; ++j) hv[j] = bS[(half * 16 + j) * RG_RS + s_];
                if (d == 0) {
                    if (nsteps == 1) {
#pragma unroll
                        for (int j = 0; j < 16; ++j) hfreg[j] = hv[j];
                    } else {
                        float* hp = HF + (size_t)tok * 1024 + obase + half * 16;
#pragma unroll
                        for (int j = 0; j < 4; ++j) *(float4*)(hp + j * 4) = make_float4(hv[4 * j], hv[4 * j + 1], hv[4 * j + 2], hv[4 * j + 3]);
                    }
                } else {
                    float hf[16];
                    if (nsteps == 1) {
#pragma unroll
                        for (int j = 0; j < 16; ++j) hf[j] = hfreg[j];
                    } else {
#pragma unroll
                        for (int j = 0; j < 4; ++j) { hf[4 * j] = hq[j][0]; hf[4 * j + 1] = hq[j][1]; hf[4 * j + 2] = hq[j][2]; hf[4 * j + 3] = hq[j][3]; }
                    }
                    unsigned o[8];
#pragma unroll
                    for (int j = 0; j < 4; ++j) {
                        o[2 * j] = pack2(gq[j][0] * (hf[4 * j] + hv[4 * j]), gq[j][1] * (hf[4 * j + 1] + hv[4 * j + 1]));
                        o[2 * j + 1] = pack2(gq[j][2] * (hf[4 * j + 2] + hv[4 * j + 2]), gq[j][3] * (hf[4 * j + 3] + hv[4 * j + 3]));
                    }
                    bf16_t* yp = Y + (size_t)tok * 1024 + obase + half * 16;
                    *(uint4*)yp = make_uint4(o[0], o[1], o[2], o[3]);
                    *(uint4*)(yp + 8) = make_uint4(o[4], o[5], o[6], o[7]);
                }
            }
        }
        if (seq < 16 && sg0 == 0)
            p.out[OUT_RG + ((seq * 2 + jl) * 2 + d) * 1024 + obase + sc0] = hc;
    }
}

__device__ __forceinline__ void phase_rgscan(const Params& p, int l, float* lds) {
    const int b = blockIdx.x, G = gridDim.x;
    int u, stride, end;
    if (G == 256) { if (b < 64) { u = b; stride = 1024; end = 64; } else { u = 64 + (b - 64); stride = 192; end = 576; } }
    else { u = b; stride = G; end = 576; }
#pragma unroll 1
    for (; u < end; u += stride) {
        int seq, rest;
        if (u < 64) { seq = 16 + (u >> 5); rest = u & 31; } else { seq = (u - 64) >> 5; rest = (u - 64) & 31; }
        rg_unit(p, l, seq, rest >> 1, rest & 1, lds);
    }
    if (G == 256 && b >= 192) {
#pragma unroll 1
        for (int k = 0; k < 4; ++k) setup_convert_unit(p, 256 + 1024 + l * 256 + (b - 192) * 4 + k, true);
    }
}

__device__ __forceinline__ int gla_tok(int seq, int d, int sidx) {
    if (seq < 16) { int pp = d ? 255 - sidx : sidx; return seq * 256 + pp; }
    int pp = d ? 1023 - sidx : sidx;
    return 4096 + (seq - 16) * 1024 + ((pp & 15) << 6) + (pp >> 4);
}

__device__ __forceinline__ int gla_uidx(int seq, int c, int h, int d) {
    const int cg = seq < 16 ? seq * 4 + c : 64 + (seq - 16) * 16 + c;
    return (cg * 4 + h) * 2 + d;
}

__device__ __forceinline__ void gla_pre_unit(const Params& p, int l, int seq, int h, int d, int c, float* ldsf) {
    const int tid = ltid(), lane = tid & 63, w = tid >> 6;
    const int jl = l >> 1;
    float* zs = ldsf;
    float* tot = ldsf + 1024;
    float* gd = ldsf + 1536;
    bf16_t* qin = (bf16_t*)(ldsf + 1664);
    bf16_t* kin = qin + 64 * 136;
    bf16_t* kinT = kin + 64 * 136;
    bf16_t* att = kinT + 128 * 72;
    bf16_t* vT = att + 64 * 72;
    const float* PB = (const float*)(p.ws + OFF_PB);
    float* O = (float*)(p.ws + (d ? OFF_HB : OFF_HF));
    const int uidx = gla_uidx(seq, c, h, d);
    const int kk = tid & 127, ig = tid >> 7;
    const int dvv = tid & 63, i8 = tid >> 6;
    float4 zreg = make_float4(0.f, 0.f, 0.f, 0.f);
    float qreg[16], kreg[16];
    if (tid < 256) { const int tok_ = gla_tok(seq, d, c * 64 + (tid >> 2)); zreg = *(const float4*)(PB + (size_t)tok_ * 3104 + 3072 + d * 16 + (tid & 3) * 4); }
#pragma unroll
    for (int ii = 0; ii < 16; ++ii) {
        const int tok_ = gla_tok(seq, d, c * 64 + ig * 16 + ii);
        qreg[ii] = PB[(size_t)tok_ * 3104 + h * 128 + kk]; kreg[ii] = PB[(size_t)tok_ * 3104 + 512 + h * 128 + kk];
    }
    f32x2 wal2[8];
#pragma unroll
    for (int r = 0; r < 8; ++r) {
        wal2[r][0] = p.in[I_GLWAL][((size_t)(jl * 2 + d) * 16 + 2 * r) * 512 + h * 128 + kk];
        wal2[r][1] = p.in[I_GLWAL][((size_t)(jl * 2 + d) * 16 + 2 * r + 1) * 512 + h * 128 + kk];
    }
    const float bal = p.in[I_GLBAL][(jl * 2 + d) * 512 + h * 128 + kk];
    __syncthreads();
    if (tid < 256) *(float4*)(zs + (tid >> 2) * 16 + (tid & 3) * 4) = zreg;
    {
        float vreg[4][8];
#pragma unroll
        for (int ii = 0; ii < 8; ++ii) {
            const int tok_ = gla_tok(seq, d, c * 64 + i8 * 8 + ii);
#pragma unroll
            for (int g = 0; g < 4; ++g) vreg[g][ii] = PB[(size_t)tok_ * 3104 + 1024 + h * 256 + g * 64 + dvv];
        }
#pragma unroll
        for (int g = 0; g < 4; ++g)
            *(uint4*)(vT + (g * 64 + dvv) * 72 + i8 * 8) = make_uint4(pack2(vreg[g][0], vreg[g][1]), pack2(vreg[g][2], vreg[g][3]), pack2(vreg[g][4], vreg[g][5]), pack2(vreg[g][6], vreg[g][7]));
    }
    __syncthreads();
    float cum[16]; float run = 0.f;
#pragma unroll
    for (int ii = 0; ii < 16; ++ii) {
        const int i = ig * 16 + ii;
        const f32x4 z0 = *(const f32x4*)(zs + i * 16), z1 = *(const f32x4*)(zs + i * 16 + 4), z2 = *(const f32x4*)(zs + i * 16 + 8), z3 = *(const f32x4*)(zs + i * 16 + 12);
        f32x2 xa = z0.xy * wal2[0];
        xa = z0.zw * wal2[1] + xa; xa = z1.xy * wal2[2] + xa; xa = z1.zw * wal2[3] + xa;
        xa = z2.xy * wal2[4] + xa; xa = z2.zw * wal2[5] + xa; xa = z3.xy * wal2[6] + xa; xa = z3.zw * wal2[7] + xa;
        const float x = bal + xa[0] + xa[1];
        const float ls = fminf(x, 0.f) - __logf(1.0f + __expf(-fabsf(x)));
        run += ls * 0.0625f; cum[ii] = run;
    }
    tot[ig * 128 + kk] = run;
    __syncthreads();
    float off = 0.f, blast = 0.f;
#pragma unroll
    for (int g = 0; g < 4; ++g) { const float tv = tot[g * 128 + kk]; blast += tv; if (g < ig) off += tv; }
    if (ig == 0) { const float gv = __expf(blast); ((float*)(p.ws + OFF_GD))[(size_t)uidx * 128 + kk] = gv; }
    {
        unsigned kp[8];
#pragma unroll
        for (int ii = 0; ii < 16; ++ii) {
            const int i = ig * 16 + ii;
            const float bc = off + cum[ii];
            const unsigned qk = pack2(qreg[ii] * __expf(bc), kreg[ii] * __expf(-bc));
            const unsigned qb = qk & 0xffffu, kb = qk >> 16;
            qin[i * 136 + kk] = (bf16_t)qb;
            kin[i * 136 + kk] = (bf16_t)kb;
            if (ii & 1) kp[ii >> 1] |= kb << 16; else kp[ii >> 1] = kb;
        }
        *(uint4*)(kinT + kk * 72 + ig * 16) = make_uint4(kp[0], kp[1], kp[2], kp[3]);
        *(uint4*)(kinT + kk * 72 + ig * 16 + 8) = make_uint4(kp[4], kp[5], kp[6], kp[7]);
    }
    __syncthreads();
    {
        const uint4* qs = (const uint4*)qin;
        uint4* qg = (uint4*)(p.ws + OFF_QIN + (size_t)uidx * 64 * 136 * 2);
        for (int i = tid; i < 1088; i += NTHR) qg[i] = qs[i];
    }
    const int mt = w >> 1;
    const int l15 = lane & 15, l4 = lane >> 4;
#pragma unroll
    for (int nn = 0; nn < 2; ++nn) {
        const int nt = (w & 1) * 2 + nn;
        f32x4 acc = {0.f, 0.f, 0.f, 0.f};
        if (nt <= mt) {
#pragma unroll
            for (int ks = 0; ks < 4; ++ks) {
                bf16x8 a = *(const bf16x8*)(qin + (mt * 16 + l15) * 136 + ks * 32 + l4 * 8);
                bf16x8 b = *(const bf16x8*)(kin + (nt * 16 + l15) * 136 + ks * 32 + l4 * 8);
                acc = __builtin_amdgcn_mfma_f32_16x16x32_bf16(a, b, acc, 0, 0, 0);
            }
        }
#pragma unroll
        for (int r = 0; r < 4; ++r) {
            const int i = mt * 16 + l4 * 4 + r, j = nt * 16 + l15;
            att[i * 72 + j] = (bf16_t)f2bf(j <= i ? acc[r] : 0.f);
        }
    }
    {
        uint2* ug = (uint2*)(p.ws + OFF_UR) + ((size_t)uidx * 8 + w) * 16 * 64 + lane;
        const bf16x8 a0 = *(const bf16x8*)(kinT + (w * 16 + l15) * 72 + l4 * 8);
        const bf16x8 a1 = *(const bf16x8*)(kinT + (w * 16 + l15) * 72 + 32 + l4 * 8);
#pragma unroll 4
        for (int nt = 0; nt < 16; ++nt) {
            f32x4 acc = {0.f, 0.f, 0.f, 0.f};
            bf16x8 b0 = *(const bf16x8*)(vT + (nt * 16 + l15) * 72 + l4 * 8);
            bf16x8 b1 = *(const bf16x8*)(vT + (nt * 16 + l15) * 72 + 32 + l4 * 8);
            acc = __builtin_amdgcn_mfma_f32_16x16x32_bf16(a0, b0, acc, 0, 0, 0);
            acc = __builtin_amdgcn_mfma_f32_16x16x32_bf16(a1, b1, acc, 0, 0, 0);
            ug[nt * 64] = make_uint2(pack2(acc[0], acc[1]), pack2(acc[2], acc[3]));
        }
    }
    __syncthreads();
    {
        const bf16x8 a0 = *(const bf16x8*)(att + (mt * 16 + l15) * 72 + l4 * 8);
        const bf16x8 a1 = *(const bf16x8*)(att + (mt * 16 + l15) * 72 + 32 + l4 * 8);
        int tokr[4];
#pragma unroll
        for (int r = 0; r < 4; ++r) tokr[r] = gla_tok(seq, d, c * 64 + mt * 16 + l4 * 4 + r);
#pragma unroll 4
        for (int nn = 0; nn < 8; ++nn) {
            const int nt = (w & 1) * 8 + nn;
            f32x4 acc = {0.f, 0.f, 0.f, 0.f};
            bf16x8 b0 = *(const bf16x8*)(vT + (nt * 16 + l15) * 72 + l4 * 8);
            bf16x8 b1 = *(const bf16x8*)(vT + (nt * 16 + l15) * 72 + 32 + l4 * 8);
            acc = __builtin_amdgcn_mfma_f32_16x16x32_bf16(a0, b0, acc, 0, 0, 0);
            acc = __builtin_amdgcn_mfma_f32_16x16x32_bf16(a1, b1, acc, 0, 0, 0);
#pragma unroll
            for (int r = 0; r < 4; ++r) O[(size_t)tokr[r] * 1024 + h * 256 + nt * 16 + l15] = acc[r];
        }
    }
}

__device__ __forceinline__ void phase_gla_pre(const Params& p, int l, float* lds) {
#pragma unroll 1
    for (int u = blockIdx.x; u < 768; u += gridDim.x) {
        const int d = u & 1, h = (u >> 1) & 3, cg = u >> 3;
        int seq, c;
        if (cg < 64) { seq = cg >> 2; c = cg & 3; } else { seq = 16 + ((cg - 64) >> 4); c = (cg - 64) & 15; }
        gla_pre_unit(p, l, seq, h, d, c, lds);
    }
}

__device__ __forceinline__ void gla_scan_unit(const Params& p, int l, int seq, int h, int d, int e, float* ldsf, bool dry) {
    const int tid = ltid(), lane = tid & 63, w = tid >> 6;
    const int jl = l >> 1;
    const int nch = seq < 16 ? 4 : 16;
    bf16_t* ST = (bf16_t*)ldsf;
    float* O = (float*)(p.ws + (d ? OFF_HB : OFF_HF));
    float* Ow = dry ? (float*)(p.ws + WS_END) : O;
    const int kt = w, mt = w >> 1;
    const int l15 = lane & 15, l4 = lane >> 4;
    f32x4 S[4];
    __syncthreads();
#pragma unroll
    for (int nt = 0; nt < 4; ++nt) {
#pragma unroll
        for (int r = 0; r < 4; ++r) {
            const int k = kt * 16 + l4 * 4 + r, dv = nt * 16 + l15;
            float v = 0.f;
            if (seq >= 16) v = p.in[I_SGLA][((((size_t)((seq - 16) * 2 + jl) * 2 + d) * 4 + h) * 128 + k) * 256 + e * 64 + dv];
            S[nt][r] = v;
        }
        *(uint2*)(ST + (nt * 16 + l15) * 136 + kt * 16 + l4 * 4) = make_uint2(pack2(S[nt][0], S[nt][1]), pack2(S[nt][2], S[nt][3]));
    }
    bf16x8 aA[4], aB[4], aC[4];
    uint2 uA[4], uB[4], uC[4];
    f32x4 gA, gB, gC, oA[2], oB[2], oC[2];
#define GLB_LOAD(S_, c_) { const int ui_ = gla_uidx(seq, (c_), h, d); \
        const uint2* ug_ = (const uint2*)(p.ws + OFF_UR) + ((size_t)ui_ * 8 + kt) * 16 * 64 + lane; \
        _Pragma("unroll") for (int nt = 0; nt < 4; ++nt) u##S_[nt] = ug_[(e * 4 + nt) * 64]; \
        g##S_ = *(const f32x4*)((const float*)(p.ws + OFF_GD) + (size_t)ui_ * 128 + kt * 16 + l4 * 4); \
        const bf16_t* qg_ = (const bf16_t*)(p.ws + OFF_QIN) + (size_t)ui_ * 64 * 136 + (mt * 16 + l15) * 136 + l4 * 8; \
        _Pragma("unroll") for (int ks = 0; ks < 4; ++ks) a##S_[ks] = *(const bf16x8*)(qg_ + ks * 32); \
        _Pragma("unroll") for (int nn = 0; nn < 2; ++nn) { _Pragma("unroll") for (int r = 0; r < 4; ++r) { \
            const int tok_ = gla_tok(seq, d, (c_) * 64 + mt * 16 + l4 * 4 + r); \
            o##S_[nn][r] = O[(size_t)tok_ * 1024 + h * 256 + e * 64 + ((w & 1) * 2 + nn) * 16 + l15]; } } }
#define GLB_STEP(S_, cc_) if ((cc_) < nch) { \
        _Pragma("unroll") for (int nn = 0; nn < 2; ++nn) { \
            const int nt = (w & 1) * 2 + nn; \
            f32x4 acc = o##S_[nn]; \
            _Pragma("unroll") for (int ks = 0; ks < 4; ++ks) { \
                bf16x8 b = *(const bf16x8*)(ST + (nt * 16 + l15) * 136 + ks * 32 + l4 * 8); \
                acc = __builtin_amdgcn_mfma_f32_16x16x32_bf16(a##S_[ks], b, acc, 0, 0, 0); } \
            _Pragma("unroll") for (int r = 0; r < 4; ++r) { \
                const int tok_ = gla_tok(seq, d, (cc_) * 64 + mt * 16 + l4 * 4 + r); \
                Ow[(size_t)tok_ * 1024 + h * 256 + e * 64 + nt * 16 + l15] = acc[r]; } } \
        __syncthreads(); \
        _Pragma("unroll") for (int nt = 0; nt < 4; ++nt) { \
            { const uint2 uu_ = u##S_[nt]; const f32x4 uf_ = {bflo(uu_.x), bfhi(uu_.x), bflo(uu_.y), bfhi(uu_.y)}; S[nt] = g##S_ * (S[nt] + uf_); } \
            *(uint2*)(ST + (nt * 16 + l15) * 136 + kt * 16 + l4 * 4) = make_uint2(pack2(S[nt][0], S[nt][1]), pack2(S[nt][2], S[nt][3])); } \
        if ((cc_) + 3 < nch) GLB_LOAD(S_, (cc_) + 3) \
        __syncthreads(); }
    GLB_LOAD(A, 0) GLB_LOAD(B, 1) GLB_LOAD(C, 2)
    __syncthreads();
#pragma unroll
    for (int c = 0; c < 18; c += 3) {
        int oz = 0; asm volatile("" : "+v"(oz));
        const int lane_i = lane + oz, w_i = w + oz;
        {
            const int lane = lane_i, w = w_i, kt = w_i, mt = w_i >> 1, l15 = lane_i & 15, l4 = lane_i >> 4;
            GLB_STEP(A, c)
            GLB_STEP(B, c + 1)
            GLB_STEP(C, c + 2)
        }
    }
    if (seq < 16) {
#pragma unroll
        for (int nt = 0; nt < 4; ++nt)
#pragma unroll
            for (int r = 0; r < 4; ++r) {
                const int k = kt * 16 + l4 * 4 + r, dv = nt * 16 + l15;
                p.out[OUT_GLA + ((((size_t)(seq * 2 + jl) * 2 + d) * 4 + h) * 128 + k) * 256 + e * 64 + dv] = S[nt][r];
            }
    }
}

__device__ __forceinline__ void phase_gla(const Params& p, int l, float* lds, bool dry = false) {
    const int b = blockIdx.x, G = gridDim.x;
    int u, stride, end;
    if (G == 256) { if (b < 64) { u = b; stride = 1024; end = 64; } else { u = 64 + (b - 64); stride = 192; end = 576; } }
    else { u = b; stride = G; end = 576; }
#pragma unroll 1
    for (; u < end; u += stride) {
        int seq, rest;
        if (u < 64) { seq = 16 + (u >> 5); rest = u & 31; } else { seq = (u - 64) >> 5; rest = (u - 64) & 31; }
        gla_scan_unit(p, l, seq, rest >> 3, (rest >> 2) & 1, rest & 3, lds, dry);
    }
}

__device__ __forceinline__ void phase_gla_norm(const Params& p, int l) {
    const int lane = ltid() & 63, w = ltid() >> 6;
    const int jl = l >> 1;
    const float* OF = (const float*)(p.ws + OFF_HF);
    const float* OB = (const float*)(p.ws + OFF_HB);
    const float* PB = (const float*)(p.ws + OFF_PB);
    bf16_t* Y = (bf16_t*)(p.ws + OFF_Y);
    const float* ng = p.in[I_GLNG] + jl * 1024;
    for (int tok = blockIdx.x * 8 + w; tok < TTOK; tok += gridDim.x * 8) {
#pragma unroll
        for (int hh = 0; hh < 4; ++hh) {
            const int d0 = hh * 256 + lane * 4;
            float4 a = *(const float4*)(OF + (size_t)tok * 1024 + d0), b = *(const float4*)(OB + (size_t)tok * 1024 + d0);
            float o0 = a.x + b.x, o1 = a.y + b.y, o2 = a.z + b.z, o3 = a.w + b.w;
            float ss = wave_sum(o0 * o0 + o1 * o1 + o2 * o2 + o3 * o3);
            const float rs = rsqrtf(ss * (1.0f / 256.0f) + EPSV);
            float4 gn = *(const float4*)(ng + d0);
            float4 gg = *(const float4*)(PB + (size_t)tok * 3104 + 2048 + d0);
            float y0 = siluf_(gg.x) * (o0 * rs * gn.x), y1 = siluf_(gg.y) * (o1 * rs * gn.y);
            float y2 = siluf_(gg.z) * (o2 * rs * gn.z), y3 = siluf_(gg.w) * (o3 * rs * gn.w);
            *(uint2*)(Y + (size_t)tok * 1024 + d0) = make_uint2(pack2(y0, y1), pack2(y2, y3));
        }
    }
}

#define LDS_FLOATS 38400
#define NPHASE 34
#ifndef REP_MASK
#define REP_MASK 0
#endif

__device__ __forceinline__ bool phase_noop(int ph) {
    if (ph < 2) return false;
    const int l = (ph - 2) / 8, s = (ph - 2) % 8;
    return ((s == 2) || (s == 3)) && ((l & 1) == 0);
}

__global__ void __launch_bounds__(NTHR) hybrid_fwd(Params p) {
    __shared__ __attribute__((aligned(16))) float lds[LDS_FLOATS];
    __shared__ uint4 xb_words;
    if (threadIdx.x == 0) xb_words = make_uint4(0u, 0u, 0u, 0u);
    __syncthreads();
    XcdBarrier bar = xcd_barrier_post((unsigned*)(p.ws + OFF_BAR), (volatile LAS unsigned*)&xb_words);
    bool first = true;
    for (int ph = p.ph_lo; ph < p.ph_hi; ++ph) {
        if (phase_noop(ph)) continue;
        if (!first) xcd_barrier(bar);
        first = false;
        if (ph == 0) { for (int r = 0; r < 1 + ((REP_MASK >> 0) & 1); ++r) { if (r) __syncthreads(); phase_setup(p, lds); } }
        else if (ph == 1) phase_norm(p, 0, 0);
        else {
            const int l = (ph - 2) / 8, s = (ph - 2) % 8;
            const bool gla = (l & 1) != 0;
            if (s == 0 || s == 4) {
                const int kind = (s == 4) ? EPI_OUT : (gla ? EPI_GLAIN : EPI_RGIN);
                const int nrep = 1 + ((REP_MASK >> 2) & 1);
                for (int r = 0; r < nrep; ++r) { if (r) __syncthreads(); phase_gemm(p, l, kind, lds, (kind == EPI_OUT) && (r + 1 < nrep)); }
            } else switch (s) {
                case 1: if (gla) { for (int r = 0; r < 1 + ((REP_MASK >> 4) & 1); ++r) { if (r) __syncthreads(); phase_gla_pre(p, l, lds); } }
                        else { for (int r = 0; r < 1 + ((REP_MASK >> 3) & 1); ++r) { if (r) __syncthreads(); phase_rgscan(p, l, lds); } } break;
                case 2: { const int nrep = 1 + ((REP_MASK >> 5) & 1); for (int r = 0; r < nrep; ++r) { if (r) __syncthreads(); phase_gla(p, l, lds, r + 1 < nrep); } } break;
                case 3: phase_gla_norm(p, l); break;
                case 5: for (int r = 0; r < 1 + ((REP_MASK >> 1) & 1); ++r) phase_norm(p, l, 1); break;
                case 6: for (int r = 0; r < 1 + ((REP_MASK >> 6) & 1); ++r) { if (r) __syncthreads(); phase_peerq(p, l, lds); } break;
                case 7: { const int nrep = 1 + ((REP_MASK >> 7) & 1); for (int r = 0; r < nrep; ++r) { if (r) __syncthreads(); phase_peer_gather(p, l, lds, r + 1 < nrep); } } break;
            }
        }
    }
}

extern "C" void kernel_launch(void* const* d_in, const int* in_sizes, int n_in, void* d_out, int out_size, void* d_ws, size_t ws_size,
                              hipStream_t stream) {
    static int grid = 0;
    if (grid == 0) {
        int dev = 0, cus = 0, per_cu = 0;
        hipGetDevice(&dev);
        hipDeviceGetAttribute(&cus, hipDeviceAttributeMultiprocessorCount, dev);
        hipOccupancyMaxActiveBlocksPerMultiprocessor(&per_cu, (const void*)hybrid_fwd, NTHR, 0);
        (void)hipGetLastError();
        if (per_cu < 1) fprintf(stderr, "kernel_launch: occupancy query says %d blocks per CU\n", per_cu);
        grid = cus > 0 ? cus : 256;
        if (ws_size < WS_END) fprintf(stderr, "kernel_launch: workspace too small (%zu < %zu)\n", ws_size, (size_t)WS_END);
    }
    hipMemsetAsync((char*)d_ws + OFF_BAR, 0, 16384, stream);
    Params p{};
    for (int i = 0; i < 30; ++i) p.in[i] = (const float*)d_in[i];
    p.out = (float*)d_out; p.ws = (unsigned char*)d_ws;
#if MULTI_LAUNCH
    for (int ph = 0; ph < NPHASE; ++ph) {
        p.ph_lo = ph; p.ph_hi = ph + 1;
        hipLaunchKernelGGL(hybrid_fwd, dim3(grid), dim3(NTHR), 0, stream, p);
    }
#else
    p.ph_lo = 0; p.ph_hi = NPHASE;
    void* args[] = {&p};
    hipError_t e = hipLaunchCooperativeKernel((const void*)hybrid_fwd, dim3(grid), dim3(NTHR), args, 0, stream);
    if (e != hipSuccess) fprintf(stderr, "cooperative launch failed: %s (grid %d)\n", hipGetErrorString(e), grid);
#endif
}
```

```cpp
#include <hip/hip_runtime.h>
#include <stdint.h>
#include <stdio.h>

#ifndef MULTI_LAUNCH
#define MULTI_LAUNCH 0
#endif

typedef __attribute__((ext_vector_type(8))) short bf16x8;
typedef __attribute__((ext_vector_type(4))) float f32x4;
typedef __attribute__((ext_vector_type(16))) float f32x16;
typedef __attribute__((ext_vector_type(2))) __bf16 bf2_t;
typedef unsigned short bf16_t;
typedef unsigned u32x4 __attribute__((ext_vector_type(4)));

#define NTHR 512
#define TTOK 6144
#define DM 1024
#define EPSV 1e-6f

constexpr size_t AL(size_t x) { return (x + 255) & ~(size_t)255; }
constexpr size_t OFF_BAR   = 0;
constexpr size_t OFF_MODS  = 16384;
constexpr size_t OFF_X     = AL(OFF_MODS + (size_t)4 * 3 * 6144 * 4);
constexpr size_t OFF_H     = AL(OFF_X + (size_t)TTOK * DM * 4);
constexpr size_t OFF_Y     = AL(OFF_H + (size_t)TTOK * DM * 2);
constexpr size_t OFF_PB    = AL(OFF_Y + (size_t)TTOK * DM * 2);
constexpr size_t OFF_HF    = AL(OFF_PB + (size_t)TTOK * 3104 * 4);
constexpr size_t OFF_HB    = AL(OFF_HF + (size_t)TTOK * DM * 4);
constexpr size_t OFF_TK    = AL(OFF_HB + (size_t)TTOK * DM * 4);
constexpr size_t OFF_RGWIN = AL(OFF_TK + (size_t)TTOK * 256 * 4);
constexpr size_t OFF_RGWOUT= AL(OFF_RGWIN + (size_t)2 * 2048 * 1024 * 2);
constexpr size_t OFF_GLWIN = AL(OFF_RGWOUT + (size_t)2 * 1024 * 1024 * 2);
constexpr size_t OFF_GLWOUT= AL(OFF_GLWIN + (size_t)2 * 3200 * 1024 * 2);
constexpr size_t OFF_PWQ   = AL(OFF_GLWOUT + (size_t)2 * 1024 * 1024 * 2);
constexpr size_t OFF_PK    = AL(OFF_PWQ + (size_t)4 * 2048 * 1024 * 2);
constexpr size_t OFF_PU    = AL(OFF_PK + (size_t)4 * 2 * 8 * 128 * 128 * 2);
constexpr size_t OFF_PV    = AL(OFF_PU + (size_t)4 * 16384 * 1024);
constexpr size_t OFF_SU    = AL(OFF_PV + (size_t)4 * 16384 * 1024);
constexpr size_t OFF_SV    = AL(OFF_SU + (size_t)4 * 16384 * 4);
constexpr size_t OFF_RGW   = AL(OFF_SV + (size_t)4 * 16384 * 4);
constexpr size_t OFF_QIN   = AL(OFF_RGW + (size_t)2 * 2 * 16 * 2 * 4096 * 2);
constexpr size_t OFF_GD    = AL(OFF_QIN + (size_t)768 * 64 * 136 * 2);
constexpr size_t OFF_UR    = AL(OFF_GD + (size_t)768 * 128 * 4);
constexpr size_t WS_END    = AL(OFF_UR + (size_t)768 * 8 * 16 * 64 * 8);

constexpr size_t OUT_Y    = 0;
constexpr size_t OUT_RG   = (size_t)TTOK * DM;
constexpr size_t OUT_GLA  = OUT_RG + 16 * 2 * 2 * 1024;

struct Params {
    const float* in[30];
    float* out;
    unsigned char* ws;
    int ph_lo, ph_hi;
};

enum { I_XP = 0, I_XS, I_SRG, I_SGLA, I_C, I_CCTX, I_N1G, I_N2G, I_ADAW, I_ADAB, I_PWQ, I_PK1, I_PK2, I_PU, I_PV,
       I_RGWIN, I_RGCW, I_RGCB, I_RGWA, I_RGBA, I_RGWI, I_RGBI, I_RGLAM, I_RGWOUT, I_GLWIN, I_GLWAL, I_GLBAL, I_GLNG, I_GLWOUT, I_FNG };

typedef float f32x2 __attribute__((ext_vector_type(2)));
__device__ __forceinline__ unsigned pack2(float a, float b) {
    f32x2 v = {a, b};
    return __builtin_bit_cast(unsigned, __builtin_convertvector(v, bf2_t));
}
__device__ __forceinline__ unsigned f2bf(float f) { return pack2(f, 0.f) & 0xffffu; }
__device__ __forceinline__ float bflo(unsigned u) { return __uint_as_float(u << 16); }
__device__ __forceinline__ float bfhi(unsigned u) { return __uint_as_float(u & 0xffff0000u); }
__device__ __forceinline__ float sigmoidf_(float x) { return 1.0f / (1.0f + __expf(-x)); }
__device__ __forceinline__ float siluf_(float x) { return x * sigmoidf_(x); }
__device__ __forceinline__ float gelu_tanh(float x) {
    float u = 0.7978845608028654f * (x + 0.044715f * x * x * x);
    float t = __expf(2.0f * u);
    float th = 1.0f - 2.0f / (t + 1.0f);
    return 0.5f * x * (1.0f + th);
}
__device__ __forceinline__ int ltid() { int t = threadIdx.x; asm volatile("" : "+v"(t)); return t; }
__device__ __forceinline__ int cond_of(int tok) { return tok < 4096 ? 0 : 1 + ((tok - 4096) >> 10); }
__device__ __forceinline__ float wave_sum(float v) {
#pragma unroll
    for (int o = 32; o >= 1; o >>= 1) v += __shfl_xor(v, o);
    return v;
}

#define XB_TMO      128
#define XB_XCNT(j)  (256  + 64 * (j))
#define XB_XSUB(j)  (1280 + 64 * (j))
#define XB_XGEN(j)  (2304 + 64 * (j))
#define XB_TOP      3328
#define XB_TOPGEN   3392
#define XCD_BAR_WORDS 3456
#define XB_SPIN_CAP (1u << 22)
#define LAS __attribute__((address_space(3)))

__device__ __forceinline__ unsigned xb_ld(unsigned* p)              { return __hip_atomic_load(p, __ATOMIC_RELAXED, __HIP_MEMORY_SCOPE_AGENT); }
__device__ __forceinline__ unsigned xb_add(unsigned* p, unsigned v) { return __hip_atomic_fetch_add(p, v, __ATOMIC_RELAXED, __HIP_MEMORY_SCOPE_AGENT); }
__device__ __forceinline__ unsigned xb_xcc_id() { return (unsigned)__builtin_amdgcn_s_getreg((3 << 11) | 20) & 0xFu; }
#define XB_SPIN(cond, bar) do { unsigned _sp = 0; while (cond) { __builtin_amdgcn_s_sleep(1); \
    if ((++_sp & 255u) == 0u) { if (xb_ld(&(bar)[XB_TMO])) break; if (_sp > XB_SPIN_CAP) { atomicAdd(&(bar)[XB_TMO], 1u); break; } } } } while (0)

struct XcdBarrier { unsigned* bar; unsigned x; volatile LAS unsigned* st; };

__device__ __forceinline__ XcdBarrier xcd_barrier_post(unsigned* bar, volatile LAS unsigned* st) {
    XcdBarrier b; b.bar = bar; b.x = xb_xcc_id(); b.st = st;
    if (threadIdx.x == 0) (void)xb_add(&bar[XB_XCNT(b.x)], 1u);
    return b;
}
__device__ __forceinline__ void xcd_barrier_complete(unsigned* bar, unsigned x, unsigned& nloc, unsigned& nx) {
    const unsigned G = gridDim.x * gridDim.y * gridDim.z;
    unsigned sum, cnt, mine, sp = 0u;
    for (;;) {
        sum = 0u; cnt = 0u; mine = 0u;
#pragma unroll
        for (unsigned j = 0; j < 16; ++j) { const unsigned c = xb_ld(&bar[XB_XCNT(j)]); sum += c; cnt += (c > 0u) ? 1u : 0u; mine = (j == x) ? c : mine; }
        if (sum == G) break;
        __builtin_amdgcn_s_sleep(1);
        if ((++sp & 255u) == 0u) { if (xb_ld(&bar[XB_TMO])) break; if (sp > XB_SPIN_CAP) { atomicAdd(&bar[XB_TMO], 1u); break; } }
    }
    nloc = mine > 0u ? mine : 1u; nx = cnt > 0u ? cnt : 1u;
}
__device__ __forceinline__ void xcd_barrier(const XcdBarrier& b) {
    asm volatile("s_waitcnt vmcnt(0)" ::: "memory");
    __syncthreads();
    if (threadIdx.x == 0) {
        unsigned* bar = b.bar;
        __builtin_amdgcn_s_waitcnt(0);
        unsigned nloc = b.st[0], nx = b.st[1];
        if (nloc == 0u) { xcd_barrier_complete(bar, b.x, nloc, nx); b.st[0] = nloc; b.st[1] = nx; }
        const unsigned old = xb_add(&bar[XB_XSUB(b.x)], 1u);
        const unsigned gen = old / nloc;
        if (old + 1u == (gen + 1u) * nloc) {
            __builtin_amdgcn_fence(__ATOMIC_RELEASE, "agent");
            asm volatile("s_waitcnt vmcnt(0)" ::: "memory");
            const unsigned og = xb_add(&bar[XB_TOP], 1u);
            const unsigned tg = og / nx;
            if (og + 1u == (tg + 1u) * nx) xb_add(&bar[XB_TOPGEN], 1u);
            else XB_SPIN(xb_ld(&bar[XB_TOPGEN]) == tg, bar);
            __builtin_amdgcn_fence(__ATOMIC_ACQUIRE, "agent");
            xb_add(&bar[XB_XGEN(b.x)], 1u);
            asm volatile("s_waitcnt vmcnt(0)" ::: "memory");
        } else {
            XB_SPIN(xb_ld(&bar[XB_XGEN(b.x)]) == gen, bar);
            __builtin_amdgcn_fence(__ATOMIC_ACQUIRE, "agent");
            asm volatile("s_waitcnt vmcnt(0)" ::: "memory");
        }
    }
    __syncthreads();
}

__device__ __forceinline__ void setup_ada_unit(const Params& p, int a, float* lds) {
    const int tid = ltid();
    const int l = a / 48, jb = (a % 48) * 128;
    float* scond = lds;
    float* part = lds + 3072;
    for (int i = tid; i < 3072; i += NTHR) {
        int n = i >> 10, k = i & 1023;
        float c = (n == 0) ? p.in[I_CCTX][k] : p.in[I_C][(n - 1) * 1024 + k];
        scond[i] = siluf_(c);
    }
    __syncthreads();
    const int lane = tid & 63, kg = tid >> 6;
    const float* w = p.in[I_ADAW] + (size_t)l * 1024 * 6144 + jb + lane * 2;
    float a0x = 0.f, a0y = 0.f, a1x = 0.f, a1y = 0.f, a2x = 0.f, a2y = 0.f;
#pragma unroll 1
    for (int k0 = 0; k0 < 128; k0 += 32) {
        float2 wv[32];
#pragma unroll
        for (int kk = 0; kk < 32; ++kk) { const f32x2 t_ = __builtin_nontemporal_load((const f32x2*)(w + (size_t)(kg * 128 + k0 + kk) * 6144)); wv[kk] = make_float2(t_[0], t_[1]); }
#pragma unroll
        for (int kk = 0; kk < 32; ++kk) {
            const int k = kg * 128 + k0 + kk;
            const float s0 = scond[k], s1 = scond[1024 + k], s2 = scond[2048 + k];
            a0x += s0 * wv[kk].x; a0y += s0 * wv[kk].y; a1x += s1 * wv[kk].x; a1y += s1 * wv[kk].y; a2x += s2 * wv[kk].x; a2y += s2 * wv[kk].y;
        }
    }
    float* pp = part + kg * 384 + lane * 2;
    pp[0] = a0x; pp[1] = a0y; pp[128] = a1x; pp[129] = a1y; pp[256] = a2x; pp[257] = a2y;
    __syncthreads();
    if (tid < 384) {
        const int n = tid >> 7, c2 = tid & 127;
        float sm = p.in[I_ADAB][l * 6144 + jb + c2];
#pragma unroll
        for (int g = 0; g < 8; ++g) sm += part[g * 384 + n * 128 + c2];
        float* mods = (float*)(p.ws + OFF_MODS);
        mods[(l * 3 + n) * 6144 + jb + c2] = sm;
    }
    __syncthreads();
}

__device__ __forceinline__ void setup_transpose_unit(const Params& p, int u, float* lds) {
    const int tid = ltid();
    const float* src; bf16_t* dst; int N, tiles_n, t, dstride = 1024;
    const bool gates = u >= 1424;
    const int i = u * 4;
    if (gates)         { t = 0; N = 64; tiles_n = 1; dstride = 64; src = p.in[I_RGWA]; dst = (bf16_t*)(p.ws + OFF_RGW) + (size_t)(i - 5696) * 4096; }
    else if (i < 1024) { int m = i / 512;          t = i % 512;          N = 2048; tiles_n = 32; src = p.in[I_RGWIN] + (size_t)m * 1024 * 2048;  dst = (bf16_t*)(p.ws + OFF_RGWIN) + (size_t)m * 2048 * 1024; }
    else if (i < 1536) { int m = (i - 1024) / 256; t = (i - 1024) % 256; N = 1024; tiles_n = 16; src = p.in[I_RGWOUT] + (size_t)m * 1024 * 1024; dst = (bf16_t*)(p.ws + OFF_RGWOUT) + (size_t)m * 1024 * 1024; }
    else if (i < 3136) { int m = (i - 1536) / 800; t = (i - 1536) % 800; N = 3104; tiles_n = 50; src = p.in[I_GLWIN] + (size_t)m * 1024 * 3104;  dst = (bf16_t*)(p.ws + OFF_GLWIN) + (size_t)m * 3200 * 1024; }
    else if (i < 3648) { int m = (i - 3136) / 256; t = (i - 3136) % 256; N = 1024; tiles_n = 16; src = p.in[I_GLWOUT] + (size_t)m * 1024 * 1024; dst = (bf16_t*)(p.ws + OFF_GLWOUT) + (size_t)m * 1024 * 1024; }
    else               { int m = (i - 3648) / 512; t = (i - 3648) % 512; N = 2048; tiles_n = 32; src = p.in[I_PWQ] + (size_t)m * 1024 * 2048;    dst = (bf16_t*)(p.ws + OFF_PWQ) + (size_t)m * 2048 * 1024; }
    const int mg = (i - 5696) >> 1;
    {
        const int k = tid >> 3, nc = (tid & 7) * 8;
        f32x4 v0[4], v1[4];
#pragma unroll
        for (int q = 0; q < 4; ++q) {
            const int tq = t + q, kt = tq / tiles_n, nt = tq % tiles_n;
            const float* sq = gates ? p.in[(q & 1) ? I_RGWI : I_RGWA] + (size_t)(mg + (q >> 1)) * 4096 : src;
            const int n = nt * 64 + nc;
            f32x4 z = {0.f, 0.f, 0.f, 0.f};
            v0[q] = z; v1[q] = z;
            if (n < N) {
                const f32x4* s4 = (const f32x4*)(sq + (size_t)((gates ? 0 : kt) * 64 + k) * N + n);
                v0[q] = __builtin_nontemporal_load(s4); v1[q] = __builtin_nontemporal_load(s4 + 1);
            }
        }
#pragma unroll
        for (int q = 0; q < 4; ++q) {
            float* tp = lds + q * 4160 + k * 65 + nc;
#pragma unroll
            for (int j = 0; j < 4; ++j) { tp[j] = v0[q][j]; tp[4 + j] = v1[q][j]; }
        }
    }
    __syncthreads();
    {
        const int n = tid >> 3, kc = (tid & 7) * 8;
#pragma unroll
        for (int q = 0; q < 4; ++q) {
            const int tq = t + q, kt = gates ? 0 : tq / tiles_n, nt = gates ? 0 : tq % tiles_n;
            bf16_t* dq = gates ? dst + (size_t)q * 4096 : dst;
            const float* tile = lds + q * 4160;
            float x[8];
#pragma unroll
            for (int j = 0; j < 8; ++j) x[j] = tile[(kc + j) * 65 + n];
            uint4 o; o.x = pack2(x[0], x[1]); o.y = pack2(x[2], x[3]); o.z = pack2(x[4], x[5]); o.w = pack2(x[6], x[7]);
            *(uint4*)(dq + (size_t)(nt * 64 + n) * dstride + kt * 64 + kc) = o;
        }
    }
    __syncthreads();
}

__device__ __forceinline__ void setup_convert_unit(const Params& p, int i, bool force = false) {
    const int tid = ltid();
    if (i < 256) {
        int side = i >> 7, ii = i & 127;
        size_t e = (size_t)ii * 4096;
        int l = (int)(e / 131072); size_t rest = e % 131072;
        const float* src = p.in[side ? I_PK2 : I_PK1] + e;
        bf16_t* dst = (bf16_t*)(p.ws + OFF_PK) + (size_t)l * 262144 + (size_t)side * 131072 + rest;
        const float4* s4 = (const float4*)(src + tid * 8);
        float4 v0 = s4[0], v1 = s4[1];
        uint4 o; o.x = pack2(v0.x, v0.y); o.y = pack2(v0.z, v0.w); o.z = pack2(v1.x, v1.y); o.w = pack2(v1.z, v1.w);
        *(uint4*)(dst + tid * 8) = o;
        return;
    }
    i -= 256;
    if (!force && gridDim.x == 256) return;
    const int tab = i >> 10;
    const int lane = tid & 63, w = tid >> 6;
    const float* src = p.in[tab ? I_PV : I_PU];
    unsigned char* dst = p.ws + (tab ? OFF_PV : OFF_PU);
    float* sc = (float*)(p.ws + (tab ? OFF_SV : OFF_SU));
    const size_t rowbase = (size_t)(i & 1023) * 64 + w * 8;
    f32x4 v[8][4];
#pragma unroll
    for (int rr = 0; rr < 8; ++rr) {
        const float* rp = src + (rowbase + rr) * 1024;
#pragma unroll
        for (int q = 0; q < 4; ++q) v[rr][q] = __builtin_nontemporal_load((const f32x4*)(rp + q * 256 + lane * 4));
    }
#pragma unroll
    for (int rr = 0; rr < 8; ++rr) {
        float am = 0.f;
#pragma unroll
        for (int q = 0; q < 4; ++q) am = fmaxf(am, fmaxf(fmaxf(fabsf(v[rr][q][0]), fabsf(v[rr][q][1])), fmaxf(fabsf(v[rr][q][2]), fabsf(v[rr][q][3]))));
#pragma unroll
        for (int o = 32; o >= 1; o >>= 1) am = fmaxf(am, __shfl_xor(am, o));
        const float scale = am > 0.f ? am * (1.0f / 448.0f) : 1.0f;
        const float inv = 1.0f / scale;
        unsigned o4[4];
#pragma unroll
        for (int q = 0; q < 4; ++q) {
            int pk = 0;
            pk = __builtin_amdgcn_cvt_pk_fp8_f32(v[rr][q][0] * inv, v[rr][q][1] * inv, pk, false);
            pk = __builtin_amdgcn_cvt_pk_fp8_f32(v[rr][q][2] * inv, v[rr][q][3] * inv, pk, true);
            o4[q] = (unsigned)pk;
        }
        const size_t row = rowbase + rr;
        { const u32x4 ov = {o4[0], o4[1], o4[2], o4[3]}; __builtin_nontemporal_store(ov, (u32x4*)(dst + row * 1024 + lane * 16)); }
        if (lane == 0) sc[row] = scale;
    }
}

__device__ __forceinline__ void setup_xinit_unit(const Params& p, int i) {
    const int tid = ltid();
    const int row = i * 4 + (tid >> 7), d0 = (tid & 127) * 8;
    float* X = (float*)(p.ws + OFF_X);
    float v[8];
    if (row < 4096) {
        const f32x4* s4 = (const f32x4*)(p.in[I_XP] + (size_t)row * 1024 + d0);
        const f32x4 a_ = __builtin_nontemporal_load(s4), b_ = __builtin_nontemporal_load(s4 + 1);
        const float4 a = make_float4(a_[0], a_[1], a_[2], a_[3]), b = make_float4(b_[0], b_[1], b_[2], b_[3]);
        v[0] = a.x; v[1] = a.y; v[2] = a.z; v[3] = a.w; v[4] = b.x; v[5] = b.y; v[6] = b.z; v[7] = b.w;
    } else {
        const f32x4* s4 = (const f32x4*)(p.in[I_XS] + (size_t)(row - 4096) * 1024 + d0);
        const f32x4 a_ = __builtin_nontemporal_load(s4), b_ = __builtin_nontemporal_load(s4 + 1);
        const float4 a = make_float4(a_[0], a_[1], a_[2], a_[3]), b = make_float4(b_[0], b_[1], b_[2], b_[3]);
        v[0] = a.x; v[1] = a.y; v[2] = a.z; v[3] = a.w; v[4] = b.x; v[5] = b.y; v[6] = b.z; v[7] = b.w;
        int n = (row - 4096) & 1023;
        float r = (float)(n >> 6), cc = (float)(n & 63);
#pragma unroll
        for (int j = 0; j < 8; ++j) {
            int d = d0 + j; int q = d >> 8, fi = d & 255;
            float freq = exp2f(-13.287712379549449f * ((float)fi * (1.0f / 256.0f)));
            float ang = ((q < 2) ? r : cc) * freq;
            v[j] += (q & 1) ? __cosf(ang) : __sinf(ang);
        }
    }
    float4* o4 = (float4*)(X + (size_t)row * 1024 + d0);
    o4[0] = make_float4(v[0], v[1], v[2], v[3]); o4[1] = make_float4(v[4], v[5], v[6], v[7]);
}

__device__ __forceinline__ void phase_setup(const Params& p, float* lds) {
    constexpr int NA = 192, NB = (5696 + 128) / 4, NC = 256 + 2048, ND = 1536;
    constexpr int total = NA + NB + NC + ND;
    for (int u = blockIdx.x; u < total; u += gridDim.x) {
        if (u < NA) setup_ada_unit(p, u, lds);
        else if (u < NA + NB) setup_transpose_unit(p, u - NA, lds);
        else if (u < NA + NB + NC) setup_convert_unit(p, u - NA - NB);
        else setup_xinit_unit(p, u - NA - NB - NC);
    }
}

__device__ __forceinline__ void premod_store(const float* x  , float ss, const float* g, const float* mrow, int shift_i, int scale_i,
                                             bf16_t* Hrow, int lane) {
    const float rs = rsqrtf(ss * (1.0f / 1024.0f) + EPSV);
    unsigned pk[8];
#pragma unroll
    for (int hf = 0; hf < 2; ++hf) {
        const int d0 = hf * 512 + lane * 8;
        float4 g0 = *(const float4*)(g + d0), g1 = *(const float4*)(g + d0 + 4);
        float4 s0 = *(const float4*)(mrow + shift_i * 1024 + d0), s1 = *(const float4*)(mrow + shift_i * 1024 + d0 + 4);
        float4 c0 = *(const float4*)(mrow + scale_i * 1024 + d0), c1 = *(const float4*)(mrow + scale_i * 1024 + d0 + 4);
        float gg[8] = {g0.x, g0.y, g0.z, g0.w, g1.x, g1.y, g1.z, g1.w};
        float sh[8] = {s0.x, s0.y, s0.z, s0.w, s1.x, s1.y, s1.z, s1.w};
        float sc[8] = {c0.x, c0.y, c0.z, c0.w, c1.x, c1.y, c1.z, c1.w};
        float o[8];
#pragma unroll
        for (int j = 0; j < 8; ++j) o[j] = (x[hf * 8 + j] * rs * gg[j]) * (1.0f + sc[j]) + sh[j];
#pragma unroll
        for (int j = 0; j < 4; ++j) pk[hf * 4 + j] = pack2(o[2 * j], o[2 * j + 1]);
    }
    *(uint4*)(Hrow + lane * 8) = make_uint4(pk[0], pk[1], pk[2], pk[3]);
    *(uint4*)(Hrow + 512 + lane * 8) = make_uint4(pk[4], pk[5], pk[6], pk[7]);
}

__device__ __forceinline__ void phase_norm(const Params& p, int l, int which  ) {
    const int lane = ltid() & 63, w = ltid() >> 6;
    const float* X = (const float*)(p.ws + OFF_X);
    bf16_t* H = (bf16_t*)(p.ws + OFF_H);
    const float* mods = (const float*)(p.ws + OFF_MODS) + (size_t)l * 3 * 6144;
    const float* g = p.in[which ? I_N2G : I_N1G] + l * 1024;
    for (int row = blockIdx.x * 8 + w; row < TTOK; row += gridDim.x * 8) {
        const float* xr = X + (size_t)row * 1024;
        float x[16];
        float4 a = *(const float4*)(xr + lane * 8), b = *(const float4*)(xr + lane * 8 + 4);
        float4 c = *(const float4*)(xr + 512 + lane * 8), d = *(const float4*)(xr + 512 + lane * 8 + 4);
        x[0] = a.x; x[1] = a.y; x[2] = a.z; x[3] = a.w; x[4] = b.x; x[5] = b.y; x[6] = b.z; x[7] = b.w;
        x[8] = c.x; x[9] = c.y; x[10] = c.z; x[11] = c.w; x[12] = d.x; x[13] = d.y; x[14] = d.z; x[15] = d.w;
        float ss = 0.f;
#pragma unroll
        for (int j = 0; j < 16; ++j) ss += x[j] * x[j];
        ss = wave_sum(ss);
        premod_store(x, ss, g, mods + cond_of(row) * 6144, which ? 3 : 0, which ? 4 : 1, H + (size_t)row * 1024, lane);
    }
}

#define GT_STRIDE 72
#define GT_BUF (2 * 128 * GT_STRIDE)

#define GLOAD(RR, k0) { RR##0 = *(const u32x4*)(ap0 + (k0)); RR##1 = *(const u32x4*)(ap1 + (k0)); RR##2 = *(const u32x4*)(bp0 + (k0)); RR##3 = *(const u32x4*)(bp1 + (k0)); }
#define GWRITE(RR, buf) { bf16_t* dA = lds + (buf) * GT_BUF; bf16_t* dB = dA + 128 * GT_STRIDE; \
        *(u32x4*)(dA + r0 * GT_STRIDE + kc) = RR##0; *(u32x4*)(dA + (r0 + 64) * GT_STRIDE + kc) = RR##1; \
        *(u32x4*)(dB + r0 * GT_STRIDE + kc) = RR##2; *(u32x4*)(dB + (r0 + 64) * GT_STRIDE + kc) = RR##3; }
#define GCOMPUTE(buf) { const bf16_t* sA = lds + (buf) * GT_BUF; const bf16_t* sB = sA + 128 * GT_STRIDE; \
        _Pragma("unroll") for (int kk = 0; kk < 4; ++kk) { \
            bf16x8 a = *(const bf16x8*)(sA + arow * GT_STRIDE + kk * 16 + koff); \
            bf16x8 b0 = *(const bf16x8*)(sB + (wn * 64 + (lane & 31)) * GT_STRIDE + kk * 16 + koff); \
            bf16x8 b1 = *(const bf16x8*)(sB + (wn * 64 + 32 + (lane & 31)) * GT_STRIDE + kk * 16 + koff); \
            acc[0] = __builtin_amdgcn_mfma_f32_32x32x16_bf16(a, b0, acc[0], 0, 0, 0); \
            acc[1] = __builtin_amdgcn_mfma_f32_32x32x16_bf16(a, b1, acc[1], 0, 0, 0); } }
#define GSTEP_L(ks, RL, RW) { GLOAD(RL, ((ks) + 3) * 64); GCOMPUTE((ks) & 1); GWRITE(RW, ((ks) + 1) & 1); __syncthreads(); }
#define GSTEP_N(ks, RW)     { GCOMPUTE((ks) & 1); GWRITE(RW, ((ks) + 1) & 1); __syncthreads(); }

struct GemmRegs { u32x4 a0, a1, a2, a3, b0, b1, b2, b3, c0, c1, c2, c3; };
#define Ra0 R.a0
#define Ra1 R.a1
#define Ra2 R.a2
#define Ra3 R.a3
#define Rb0 R.b0
#define Rb1 R.b1
#define Rb2 R.b2
#define Rb3 R.b3
#define Rc0 R.c0
#define Rc1 R.c1
#define Rc2 R.c2
#define Rc3 R.c3
__device__ __forceinline__ void gemm_prefetch(const bf16_t* __restrict__ A, const bf16_t* __restrict__ Bt, int m0, int n0, GemmRegs& R) {
    const int tid = ltid();
    const int r0 = tid >> 3, kc = (tid & 7) * 8;
    const bf16_t* ap0 = A + (size_t)(m0 + r0) * 1024 + kc;
    const bf16_t* ap1 = A + (size_t)(m0 + r0 + 64) * 1024 + kc;
    const bf16_t* bp0 = Bt + (size_t)(n0 + r0) * 1024 + kc;
    const bf16_t* bp1 = Bt + (size_t)(n0 + r0 + 64) * 1024 + kc;
    GLOAD(Ra, 0); GLOAD(Rb, 64); GLOAD(Rc, 128);
}
__device__ __forceinline__ void gemm_mainloop(const bf16_t* __restrict__ A, const bf16_t* __restrict__ Bt, int m0, int n0,
                                              bf16_t* lds, f32x16 (&acc)[2], GemmRegs& R) {
    const int tid = ltid(), lane = tid & 63, w = tid >> 6;
    const int wm = w >> 1, wn = w & 1;
#pragma unroll
    for (int i = 0; i < 16; ++i) { acc[0][i] = 0.f; acc[1][i] = 0.f; }
    const int r0 = tid >> 3, kc = (tid & 7) * 8;
    const bf16_t* ap0 = A + (size_t)(m0 + r0) * 1024 + kc;
    const bf16_t* ap1 = A + (size_t)(m0 + r0 + 64) * 1024 + kc;
    const bf16_t* bp0 = Bt + (size_t)(n0 + r0) * 1024 + kc;
    const bf16_t* bp1 = Bt + (size_t)(n0 + r0 + 64) * 1024 + kc;
    GWRITE(Ra, 0);
    __syncthreads();
    const int arow = wm * 32 + (lane & 31), koff = (lane >> 5) * 8;
    GSTEP_L(0, Ra, Rb)  GSTEP_L(1, Rb, Rc)  GSTEP_L(2, Rc, Ra)
    GSTEP_L(3, Ra, Rb)  GSTEP_L(4, Rb, Rc)  GSTEP_L(5, Rc, Ra)
    GSTEP_L(6, Ra, Rb)  GSTEP_L(7, Rb, Rc)  GSTEP_L(8, Rc, Ra)
    GSTEP_L(9, Ra, Rb)  GSTEP_L(10, Rb, Rc) GSTEP_L(11, Rc, Ra)
    GSTEP_L(12, Ra, Rb) GSTEP_N(13, Rc)     GSTEP_N(14, Ra)
    { GCOMPUTE(1); __syncthreads(); }
}

#define G2_BUF (384 * GT_STRIDE)
struct Gemm2Regs { u32x4 a0, a1, a2, a3, a4, a5, b0, b1, b2, b3, b4, b5, c0, c1, c2, c3, c4, c5; };
#define G2LOAD(RR, k0) { R2.RR##0 = *(const u32x4*)(ap0 + (k0)); R2.RR##1 = *(const u32x4*)(ap0 + (size_t)64 * 1024 + (k0)); \
        R2.RR##2 = *(const u32x4*)(ap0 + (size_t)128 * 1024 + (k0)); R2.RR##3 = *(const u32x4*)(ap0 + (size_t)192 * 1024 + (k0)); \
        R2.RR##4 = *(const u32x4*)(bp0 + (k0)); R2.RR##5 = *(const u32x4*)(bp0 + (size_t)64 * 1024 + (k0)); }
#define G2WRITE(RR, buf) { bf16_t* dA = lds + (buf) * G2_BUF; bf16_t* dB = dA + 256 * GT_STRIDE; \
        *(u32x4*)(dA + r0 * GT_STRIDE + kc) = R2.RR##0; *(u32x4*)(dA + (r0 + 64) * GT_STRIDE + kc) = R2.RR##1; \
        *(u32x4*)(dA + (r0 + 128) * GT_STRIDE + kc) = R2.RR##2; *(u32x4*)(dA + (r0 + 192) * GT_STRIDE + kc) = R2.RR##3; \
        *(u32x4*)(dB + r0 * GT_STRIDE + kc) = R2.RR##4; *(u32x4*)(dB + (r0 + 64) * GT_STRIDE + kc) = R2.RR##5; }
#define G2COMPUTE(buf) { const bf16_t* sA = lds + (buf) * G2_BUF; const bf16_t* sB = sA + 256 * GT_STRIDE; \
        _Pragma("unroll") for (int kk = 0; kk < 4; ++kk) { \
            bf16x8 a0 = *(const bf16x8*)(sA + arow * GT_STRIDE + kk * 16 + koff); \
            bf16x8 a1 = *(const bf16x8*)(sA + (arow + 32) * GT_STRIDE + kk * 16 + koff); \
            bf16x8 b0 = *(const bf16x8*)(sB + brow * GT_STRIDE + kk * 16 + koff); \
            bf16x8 b1 = *(const bf16x8*)(sB + (brow + 32) * GT_STRIDE + kk * 16 + koff); \
            acc[0] = __builtin_amdgcn_mfma_f32_32x32x16_bf16(a0, b0, acc[0], 0, 0, 0); \
            acc[1] = __builtin_amdgcn_mfma_f32_32x32x16_bf16(a0, b1, acc[1], 0, 0, 0); \
            acc[2] = __builtin_amdgcn_mfma_f32_32x32x16_bf16(a1, b0, acc[2], 0, 0, 0); \
            acc[3] = __builtin_amdgcn_mfma_f32_32x32x16_bf16(a1, b1, acc[3], 0, 0, 0); } }
#define G2STEP_L(ks, RL, RW) { G2LOAD(RL, ((ks) + 3) * 64); G2COMPUTE((ks) & 1); G2WRITE(RW, ((ks) + 1) & 1); __syncthreads(); }
#define G2STEP_N(ks, RW)     { G2COMPUTE((ks) & 1); G2WRITE(RW, ((ks) + 1) & 1); __syncthreads(); }
__device__ __forceinline__ void gemm2_prefetch(const bf16_t* __restrict__ A, const bf16_t* __restrict__ Bt, int m0, int n0, Gemm2Regs& R2) {
    const int tid = ltid();
    const int r0 = tid >> 3, kc = (tid & 7) * 8;
    const bf16_t* ap0 = A + (size_t)(m0 + r0) * 1024 + kc;
    const bf16_t* bp0 = Bt + (size_t)(n0 + r0) * 1024 + kc;
    G2LOAD(a, 0); G2LOAD(b, 64); G2LOAD(c, 128);
}
__device__ __forceinline__ void gemm2_mainloop(const bf16_t* __restrict__ A, const bf16_t* __restrict__ Bt, int m0, int n0,
                                               bf16_t* lds, f32x16 (&acc)[4], Gemm2Regs& R2) {
    const int tid = ltid(), lane = tid & 63, w = tid >> 6;
    const int wm = w >> 1, wn = w & 1;
#pragma unroll
    for (int i = 0; i < 16; ++i) { acc[0][i] = 0.f; acc[1][i] = 0.f; acc[2][i] = 0.f; acc[3][i] = 0.f; }
    const int r0 = tid >> 3, kc = (tid & 7) * 8;
    const bf16_t* ap0 = A + (size_t)(m0 + r0) * 1024 + kc;
    const bf16_t* bp0 = Bt + (size_t)(n0 + r0) * 1024 + kc;
    G2WRITE(a, 0);
    __syncthreads();
    const int arow = wm * 64 + (lane & 31), brow = wn * 64 + (lane & 31), koff = (lane >> 5) * 8;
    G2STEP_L(0, a, b)  G2STEP_L(1, b, c)  G2STEP_L(2, c, a)
    G2STEP_L(3, a, b)  G2STEP_L(4, b, c)  G2STEP_L(5, c, a)
    G2STEP_L(6, a, b)  G2STEP_L(7, b, c)  G2STEP_L(8, c, a)
    G2STEP_L(9, a, b)  G2STEP_L(10, b, c) G2STEP_L(11, c, a)
    G2STEP_L(12, a, b) G2STEP_N(13, c)    G2STEP_N(14, a)
    { G2COMPUTE(1); __syncthreads(); }
}

#define ACC_ROW(wm, lane, r) ((wm) * 32 + ((r) & 3) + 8 * ((r) >> 2) + 4 * ((lane) >> 5))
#define ACC_COL(wn, lane, nt) ((wn) * 64 + (nt) * 32 + ((lane) & 31))

enum { EPI_RGIN = 0, EPI_GLAIN = 1, EPI_OUT = 2 };

__device__ __forceinline__ void phase_gemm(const Params& p, int l, int kind, float* ldsf, bool dry = false) {
    bf16_t* lds = (bf16_t*)ldsf;
    const int lane = ltid() & 63, w = ltid() >> 6, wm = w >> 1, wn = w & 1;
    const int jl = l >> 1;
    const bf16_t* A; const bf16_t* Bt; int ntn, N;
    float* PB = (float*)(p.ws + OFF_PB);
    float* X = (float*)(p.ws + OFF_X);
    if (kind == EPI_RGIN)       { A = (const bf16_t*)(p.ws + OFF_H); Bt = (const bf16_t*)(p.ws + OFF_RGWIN) + (size_t)jl * 2048 * 1024; ntn = 16; N = 2048; }
    else if (kind == EPI_GLAIN) { A = (const bf16_t*)(p.ws + OFF_H); Bt = (const bf16_t*)(p.ws + OFF_GLWIN) + (size_t)jl * 3200 * 1024; ntn = 25; N = 3104; }
    else { A = (const bf16_t*)(p.ws + OFF_Y); Bt = (l & 1) ? (const bf16_t*)(p.ws + OFF_GLWOUT) + (size_t)jl * 1024 * 1024 : (const bf16_t*)(p.ws + OFF_RGWOUT) + (size_t)jl * 1024 * 1024; ntn = 8; N = 1024; }
    const float* mods = (const float*)(p.ws + OFF_MODS) + (size_t)l * 3 * 6144;
    if (kind != EPI_RGIN) {
        const int ntn2 = (kind == EPI_GLAIN) ? 21 : ntn;
        const int ntiles2 = 24 * ntn2;
        Gemm2Regs R2;
        if ((int)blockIdx.x < ntiles2) gemm2_prefetch(A, Bt, ((int)blockIdx.x % 24) * 256, ((int)blockIdx.x / 24) * 128, R2);
#pragma unroll 1
        for (int t = blockIdx.x; t < ntiles2; t += gridDim.x) {
            const int m0 = (t % 24) * 256, n0 = (t / 24) * 128;
            f32x16 acc[4];
            gemm2_mainloop(A, Bt, m0, n0, lds, acc, R2);
            { const int tn = t + gridDim.x; if (tn < ntiles2) gemm2_prefetch(A, Bt, (tn % 24) * 256, (tn / 24) * 128, R2); }
            const int cnd = cond_of(m0);
#pragma unroll
            for (int q = 0; q < 4; ++q) {
                const int col = n0 + wn * 64 + (q & 1) * 32 + (lane & 31);
                const float gate = (kind == EPI_OUT) ? mods[cnd * 6144 + 2 * 1024 + col] : 0.f;
#pragma unroll
                for (int r = 0; r < 16; ++r) {
                    const int row = m0 + (w >> 1) * 64 + (q >> 1) * 32 + (r & 3) + 8 * (r >> 2) + 4 * (lane >> 5);
                    float v = acc[q][r];
                    if (kind == EPI_GLAIN) {
                        if (col < 512) v *= 0.08838834764831845f;
                        if (col < N) PB[(size_t)row * 3104 + col] = v;
                    } else {
                        float* Xo = dry ? PB : X;
                        Xo[(size_t)row * 1024 + col] = X[(size_t)row * 1024 + col] + gate * v;
                    }
                }
            }
        }
        if (kind == EPI_OUT) {
            if (!dry && gridDim.x == 256 && (int)blockIdx.x >= 192) {
#pragma unroll 1
                for (int k = 0; k < 4; ++k) setup_convert_unit(p, 256 + l * 256 + ((int)blockIdx.x - 192) * 4 + k, true);
            }
            return;
        }
    }
    const int ntb = (kind == EPI_GLAIN) ? 21 : 0;
    if (kind == EPI_GLAIN && gridDim.x == 256 && (int)blockIdx.x >= 192) {
#pragma unroll 1
        for (int k = 0; k < 2; ++k) setup_convert_unit(p, 256 + 1024 + l * 256 + ((int)blockIdx.x - 192) * 2 + k, true);
    }
    const int ntiles = 48 * (ntn - ntb);
    GemmRegs R;
    if ((int)blockIdx.x < ntiles) gemm_prefetch(A, Bt, ((int)blockIdx.x % 48) * 128, (ntb + (int)blockIdx.x / 48) * 128, R);
#pragma unroll 1
    for (int t = blockIdx.x; t < ntiles; t += gridDim.x) {
        const int mt = t % 48, nt_ = ntb + t / 48;
        const int m0 = mt * 128, n0 = nt_ * 128;
        f32x16 acc[2];
        gemm_mainloop(A, Bt, m0, n0, lds, acc, R);
        { const int tn = t + gridDim.x; if (tn < ntiles) gemm_prefetch(A, Bt, (tn % 48) * 128, (ntb + tn / 48) * 128, R); }
#pragma unroll
        for (int nt = 0; nt < 2; ++nt) {
#pragma unroll
            for (int r = 0; r < 16; ++r) {
                const int row = m0 + ACC_ROW(wm, lane, r), col = n0 + ACC_COL(wn, lane, nt);
                float v = acc[nt][r];
                if (kind == EPI_RGIN) {
                    if (col < 1024) v = gelu_tanh(v);
                    PB[(size_t)row * 2048 + col] = v;
                } else if (kind == EPI_GLAIN) {
                    if (col < 512) v *= 0.08838834764831845f;
                    if (col < N) PB[(size_t)row * 3104 + col] = v;
                } else {
                    const float gate = mods[cond_of(row) * 6144 + 2 * 1024 + col];
                    float* Xo = dry ? PB : X;
                    Xo[(size_t)row * 1024 + col] = X[(size_t)row * 1024 + col] + gate * v;
                }
            }
        }
    }
}

__device__ __forceinline__ void phase_peerq(const Params& p, int l, float* ldsf) {
    bf16_t* lds = (bf16_t*)ldsf;
    const int tid = ltid(), lane = tid & 63, w = tid >> 6, wm = w >> 1, wn = w & 1;
    const bf16_t* A = (const bf16_t*)(p.ws + OFF_H);
    const bf16_t* Bt = (const bf16_t*)(p.ws + OFF_PWQ) + (size_t)l * 2048 * 1024;
    const bf16_t* PK = (const bf16_t*)(p.ws + OFF_PK) + (size_t)l * 262144;
    float* TK = (float*)(p.ws + OFF_TK);
    bf16_t* Qs = lds;
    float* Ss = ldsf + (128 * 136 * 2) / 4;
    GemmRegs R;
    if ((int)blockIdx.x < 768) gemm_prefetch(A, Bt, ((int)blockIdx.x % 48) * 128, ((int)blockIdx.x / 48) * 128, R);
#pragma unroll 1
    for (int t = blockIdx.x; t < 48 * 16; t += gridDim.x) {
        const int mt = t % 48, nt_ = t / 48;
        const int m0 = mt * 128, n0 = nt_ * 128;
        const int h = nt_ >> 1, side = nt_ & 1;
        f32x16 acc[2];
        gemm_mainloop(A, Bt, m0, n0, lds, acc, R);
        { const int tn = t + gridDim.x; if (tn < 768) gemm_prefetch(A, Bt, (tn % 48) * 128, (tn / 48) * 128, R); }
#pragma unroll
        for (int nt = 0; nt < 2; ++nt)
#pragma unroll
            for (int r = 0; r < 16; ++r)
                Qs[ACC_ROW(wm, lane, r) * 136 + ACC_COL(wn, lane, nt)] = (bf16_t)f2bf(acc[nt][r]);
        __syncthreads();
        const bf16_t* kp = PK + (size_t)(side * 8 + h) * 16384;
#pragma unroll
        for (int i = 0; i < 16; ++i) { acc[0][i] = 0.f; acc[1][i] = 0.f; }
#pragma unroll
        for (int kk = 0; kk < 8; ++kk) {
            bf16x8 a = *(const bf16x8*)(Qs + (wm * 32 + (lane & 31)) * 136 + kk * 16 + (lane >> 5) * 8);
            bf16x8 b0 = *(const bf16x8*)(kp + (wn * 64 + (lane & 31)) * 128 + kk * 16 + (lane >> 5) * 8);
            bf16x8 b1 = *(const bf16x8*)(kp + (wn * 64 + 32 + (lane & 31)) * 128 + kk * 16 + (lane >> 5) * 8);
            acc[0] = __builtin_amdgcn_mfma_f32_32x32x16_bf16(a, b0, acc[0], 0, 0, 0);
            acc[1] = __builtin_amdgcn_mfma_f32_32x32x16_bf16(a, b1, acc[1], 0, 0, 0);
        }
#pragma unroll
        for (int nt = 0; nt < 2; ++nt)
#pragma unroll
            for (int r = 0; r < 16; ++r)
                Ss[ACC_ROW(wm, lane, r) * 129 + ACC_COL(wn, lane, nt)] = acc[nt][r];
        __syncthreads();
        {
            const int row = tid & 127, part = tid >> 7;
            float v[16];
#pragma unroll
            for (int j = 0; j < 16; ++j) v[j] = -3.0e38f;
            const float* sr = Ss + row * 129 + part * 32;
#pragma unroll 4
            for (int n = 0; n < 32; ++n) {
                float x = __uint_as_float((__float_as_uint(sr[n]) & 0xffffff80u) | (unsigned)(part * 32 + n));
#pragma unroll
                for (int j = 15; j >= 1; --j) v[j] = __builtin_amdgcn_fmed3f(x, v[j - 1], v[j]);
                v[0] = fmaxf(x, v[0]);
            }
            float* mg = ldsf;
#define TOPK_MERGE() { \
                _Pragma("unroll") for (int j = 0; j < 16; ++j) v[j] = fmaxf(v[j], o[15 - j]); \
                _Pragma("unroll") for (int dd = 8; dd >= 1; dd >>= 1) { \
                    _Pragma("unroll") for (int i = 0; i < 16; ++i) { if ((i & dd) == 0) { const float hi_ = fmaxf(v[i], v[i + dd]), lo_ = fminf(v[i], v[i + dd]); v[i] = hi_; v[i + dd] = lo_; } } } }
            __syncthreads();
            if (part & 1) {
#pragma unroll
                for (int j = 0; j < 16; ++j) mg[((part >> 1) * 128 + row) * 17 + j] = v[j];
            }
            __syncthreads();
            if (!(part & 1)) {
                float o[16];
#pragma unroll
                for (int j = 0; j < 16; ++j) o[j] = mg[((part >> 1) * 128 + row) * 17 + j];
                TOPK_MERGE()
            }
            __syncthreads();
            if (part == 2) {
#pragma unroll
                for (int j = 0; j < 16; ++j) mg[row * 17 + j] = v[j];
            }
            __syncthreads();
            if (part == 0) {
                float o[16];
#pragma unroll
                for (int j = 0; j < 16; ++j) o[j] = mg[row * 17 + j];
                TOPK_MERGE()
                float4* og = (float4*)(TK + ((size_t)(m0 + row) * 16 + h * 2 + side) * 16);
                og[0] = make_float4(v[0], v[1], v[2], v[3]); og[1] = make_float4(v[4], v[5], v[6], v[7]);
                og[2] = make_float4(v[8], v[9], v[10], v[11]); og[3] = make_float4(v[12], v[13], v[14], v[15]);
            }
        }
        __syncthreads();
    }
}

__device__ __forceinline__ void conv_row(int l, int gw, int st, int& tab, int& r) {
    const int rid = 16384 + 8192 + gw * 4 + st; tab = rid >> 14; r = (l + 1) * 16384 + (rid & 16383);
}
__device__ __forceinline__ void phase_peer_gather(const Params& p, int l, float* ldsf, bool dry = false) {
    const int tid = ltid(), lane = tid & 63, w = tid >> 6;
    int* eidL = (int*)ldsf;
    float* gateL = ldsf + 24 * 128;
    float* suL = ldsf + 48 * 128;
    float* wL = ldsf + 72 * 128 + w * 384;
    int* cntL = (int*)(ldsf + 96 * 128);
    int* baseL = cntL + 192 * 16;
    int* eidU = baseL + 24 * 16;
    float* gateU = (float*)(eidU + 24 * 128);
    const float* TK = (const float*)(p.ws + OFF_TK);
    float* X = (float*)(p.ws + OFF_X);
    bf16_t* H = (bf16_t*)(p.ws + OFF_H);
    float* Xw = dry ? (float*)(p.ws + OFF_PB) : X;
    bf16_t* Hw = dry ? (bf16_t*)(p.ws + OFF_PB + (size_t)TTOK * DM * 4) : H;
    float* Yw = dry ? (float*)(p.ws + OFF_PB) : p.out + OUT_Y;
    const unsigned char* PU = p.ws + OFF_PU + (size_t)l * 16384 * 1024;
    const unsigned char* PV = p.ws + OFF_PV + (size_t)l * 16384 * 1024;
    const float* SU = (const float*)(p.ws + OFF_SU) + l * 16384;
    const float* SV = (const float*)(p.ws + OFF_SV) + l * 16384;
    const float* mods = (const float*)(p.ws + OFF_MODS) + (size_t)l * 3 * 6144;
    for (int sg = blockIdx.x; sg < 256; sg += gridDim.x) {
        const int t0 = sg * 24;
        const bool defer = ((l & 1) == 0) && (gridDim.x == 256) && !dry;
        f32x4 cv0, cv1, cv2, cv3;
        cv0 = cv1 = cv2 = cv3 = (f32x4){0.f, 0.f, 0.f, 0.f};
#define CONV_ISSUE(st_) { if (defer) { int tab_, r_; conv_row(l, (int)blockIdx.x * 8 + w, (st_), tab_, r_); \
            const float* src_ = p.in[tab_ ? I_PV : I_PU] + (size_t)r_ * 1024 + lane * 4; \
            cv0 = __builtin_nontemporal_load((const f32x4*)src_); cv1 = __builtin_nontemporal_load((const f32x4*)(src_ + 256)); \
            cv2 = __builtin_nontemporal_load((const f32x4*)(src_ + 512)); cv3 = __builtin_nontemporal_load((const f32x4*)(src_ + 768)); } }
#define CONV_Q(v_) ({ int pk_ = 0; pk_ = __builtin_amdgcn_cvt_pk_fp8_f32((v_)[0] * inv_, (v_)[1] * inv_, pk_, false); \
            pk_ = __builtin_amdgcn_cvt_pk_fp8_f32((v_)[2] * inv_, (v_)[3] * inv_, pk_, true); (unsigned)pk_; })
#define CONV_AM(v_) fmaxf(fmaxf(fabsf((v_)[0]), fabsf((v_)[1])), fmaxf(fabsf((v_)[2]), fabsf((v_)[3])))
#define CONV_FINISH(st_) { if (defer) { int tab_, r_; conv_row(l, (int)blockIdx.x * 8 + w, (st_), tab_, r_); \
            float am_ = fmaxf(fmaxf(CONV_AM(cv0), CONV_AM(cv1)), fmaxf(CONV_AM(cv2), CONV_AM(cv3))); \
            _Pragma("unroll") for (int o_ = 32; o_ >= 1; o_ >>= 1) am_ = fmaxf(am_, __shfl_xor(am_, o_)); \
            const float scale_ = am_ > 0.f ? am_ * (1.0f / 448.0f) : 1.0f; const float inv_ = 1.0f / scale_; \
            const u32x4 ov_ = {CONV_Q(cv0), CONV_Q(cv1), CONV_Q(cv2), CONV_Q(cv3)}; \
            __builtin_nontemporal_store(ov_, (u32x4*)(p.ws + (tab_ ? OFF_PV : OFF_PU) + (size_t)r_ * 1024 + lane * 16)); \
            if (lane == 0) ((float*)(p.ws + (tab_ ? OFF_SV : OFF_SU)))[r_] = scale_; } }
        f32x2 xf2[3][8];
#pragma unroll
        for (int tt = 0; tt < 3; ++tt) {
            const int tok = t0 + w + tt * 8;
#pragma unroll
            for (int q = 0; q < 4; ++q) {
                uint2 hv = *(const uint2*)(H + (size_t)tok * 1024 + q * 256 + lane * 4);
                xf2[tt][q * 2] = (f32x2){bflo(hv.x), bfhi(hv.x)}; xf2[tt][q * 2 + 1] = (f32x2){bflo(hv.y), bfhi(hv.y)};
            }
        }
        __syncthreads();
        const int ctl = tid >> 3, ch = tid & 7;
        if (tid < 192) {
            const float* tk = TK + ((size_t)(t0 + ctl) * 16 + ch * 2) * 16;
            float v1[16], v2[16];
#pragma unroll
            for (int j = 0; j < 4; ++j) {
                float4 a = *(const float4*)(tk + j * 4), b = *(const float4*)(tk + 16 + j * 4);
                v1[j * 4] = a.x; v1[j * 4 + 1] = a.y; v1[j * 4 + 2] = a.z; v1[j * 4 + 3] = a.w;
                v2[j * 4] = b.x; v2[j * 4 + 1] = b.y; v2[j * 4 + 2] = b.z; v2[j * 4 + 3] = b.w;
            }
            int* idxL = (int*)(gateU + 24 * 128) + tid * 32;
#pragma unroll
            for (int j = 0; j < 16; ++j) {
                idxL[j] = (int)(__float_as_uint(v1[j]) & 127u); idxL[16 + j] = (int)(__float_as_uint(v2[j]) & 127u);
                v1[j] = __uint_as_float(__float_as_uint(v1[j]) & 0xffffff80u);
                v2[j] = __uint_as_float(__float_as_uint(v2[j]) & 0xffffff80u);
            }
            float top[16];
#pragma unroll
            for (int j = 0; j < 16; ++j) top[j] = -3.0e38f;
#pragma unroll
            for (int a = 0; a < 16; ++a) {
#pragma unroll
                for (int b = 0; b < 16; ++b) {
                    if ((a + 1) * (b + 1) <= 16) {
                        float sm = v1[a] + v2[b];
                        float x = __uint_as_float((__float_as_uint(sm) & 0xffffff00u) | (unsigned)(a * 16 + b));
#pragma unroll
                        for (int j = 15; j >= 1; --j) top[j] = __builtin_amdgcn_fmed3f(x, top[j - 1], top[j]);
                        top[0] = fmaxf(x, top[0]);
                    }
                }
            }
            const float mx = __uint_as_float(__float_as_uint(top[0]) & 0xffffff00u);
            float gg[16]; float sum = 0.f;
#pragma unroll
            for (int j = 0; j < 16; ++j) {
                float sv = __uint_as_float(__float_as_uint(top[j]) & 0xffffff00u);
                gg[j] = __expf(sv - mx); sum += gg[j];
            }
            const float inv = 1.0f / sum;
            int* myc = cntL + tid * 16;
#pragma unroll
            for (int b = 0; b < 16; ++b) myc[b] = 0;
            int eu[16];
#pragma unroll
            for (int j = 0; j < 16; ++j) {
                const unsigned ab = __float_as_uint(top[j]) & 0xffu;
                const int e = idxL[ab >> 4] * 128 + idxL[16 + (ab & 15u)];
                const int b = e >> 10;
                const int r = myc[b]; myc[b] = r + 1;
                eu[j] = e | (r << 16);
            }
#pragma unroll
            for (int j = 0; j < 16; ++j) { eidU[ctl * 128 + ch * 16 + j] = eu[j]; }
#pragma unroll
            for (int j = 0; j < 16; ++j) gg[j] *= inv;
#pragma unroll
            for (int j = 0; j < 16; ++j) gateU[ctl * 128 + ch * 16 + j] = gg[j];
        }
        __syncthreads();
        if (tid < 384) {
            const int tl = tid >> 4, b = tid & 15;
            int run = 0;
#pragma unroll
            for (int hh = 0; hh < 8; ++hh) { int* c = cntL + (tl * 8 + hh) * 16 + b; const int v = *c; *c = run; run += v; }
            baseL[tl * 16 + b] = run;
        }
        __syncthreads();
        if (tid < 24) {
            int run = 0;
#pragma unroll
            for (int b = 0; b < 16; ++b) { const int v = baseL[tid * 16 + b]; baseL[tid * 16 + b] = run; run += v; }
        }
        __syncthreads();
        if (tid < 192) {
#pragma unroll 4
            for (int j = 0; j < 16; ++j) {
                const int pk = eidU[ctl * 128 + ch * 16 + j];
                const int e = pk & 0xffff, r = pk >> 16, b = e >> 10;
                const int pos = baseL[ctl * 16 + b] + cntL[tid * 16 + b] + r;
                eidL[ctl * 128 + pos] = e;
                gateL[ctl * 128 + pos] = gateU[ctl * 128 + ch * 16 + j] * SV[e];
                suL[ctl * 128 + pos] = SU[e];
            }
        }
        __syncthreads();
        int ecur[3][8];
#pragma unroll
        for (int tt = 0; tt < 3; ++tt)
#pragma unroll
            for (int j = 0; j < 8; ++j) ecur[tt][j] = __builtin_amdgcn_readfirstlane(eidL[(w + tt * 8) * 128 + j]);
#pragma unroll 1
        for (int bt = 0; bt < 16; ++bt) {
            u32x4 ua[3][8];
#pragma unroll
            for (int tt = 0; tt < 3; ++tt) {
#pragma unroll
                for (int j = 0; j < 8; ++j) ua[tt][j] = *(const u32x4*)(PU + (size_t)ecur[tt][j] * 1024 + lane * 16);
            }
            {
                const int bn = (bt + 1) & 15;
#pragma unroll
                for (int tt = 0; tt < 3; ++tt)
#pragma unroll
                    for (int j = 0; j < 8; ++j) ecur[tt][j] = __builtin_amdgcn_readfirstlane(eidL[(w + tt * 8) * 128 + bn * 8 + j]);
            }
#pragma unroll
            for (int tt = 0; tt < 3; ++tt) {
                const int tl = w + tt * 8;
                float pp[8];
#pragma unroll
                for (int j = 0; j < 8; ++j) {
                    f32x2 sv = {0.f, 0.f};
#pragma unroll
                    for (int q = 0; q < 4; ++q) {
                        f32x2 lo = __builtin_amdgcn_cvt_pk_f32_fp8((int)ua[tt][j][q], false);
                        f32x2 hi = __builtin_amdgcn_cvt_pk_f32_fp8((int)ua[tt][j][q], true);
                        sv = xf2[tt][q * 2] * lo + sv;
                        sv = xf2[tt][q * 2 + 1] * hi + sv;
                    }
                    pp[j] = sv[0] + sv[1];
                }
                float q4[4], q2[2], s1;
                {
                    const bool hi = (lane & 32) != 0;
#pragma unroll
                    for (int i = 0; i < 4; ++i) { float a = pp[2 * i], b = pp[2 * i + 1]; float send = hi ? a : b, keep = hi ? b : a; q4[i] = keep + __shfl_xor(send, 32); }
                }
                {
                    const bool hi = (lane & 16) != 0;
#pragma unroll
                    for (int i = 0; i < 2; ++i) { float a = q4[2 * i], b = q4[2 * i + 1]; float send = hi ? a : b, keep = hi ? b : a; q2[i] = keep + __shfl_xor(send, 16); }
                }
                {
                    const bool hi = (lane & 8) != 0;
                    float a = q2[0], b = q2[1]; float send = hi ? a : b, keep = hi ? b : a; s1 = keep + __shfl_xor(send, 8);
                }
                s1 += __shfl_xor(s1, 4); s1 += __shfl_xor(s1, 2); s1 += __shfl_xor(s1, 1);
                const int jj = ((lane >> 5) & 1) + 2 * ((lane >> 4) & 1) + 4 * ((lane >> 3) & 1);
                if ((lane & 7) == 0) wL[tt * 128 + bt * 8 + jj] = gateL[tl * 128 + bt * 8 + jj] * gelu_tanh(s1 * suL[tl * 128 + bt * 8 + jj]);
            }
        }
        f32x2 acc2[3][8];
#pragma unroll
        for (int tt = 0; tt < 3; ++tt)
#pragma unroll
            for (int j = 0; j < 8; ++j) acc2[tt][j] = (f32x2){0.f, 0.f};
        CONV_ISSUE(0)
#pragma unroll 1
        for (int bt = 0; bt < 16; ++bt) {
            u32x4 va[3][8];
#pragma unroll
            for (int tt = 0; tt < 3; ++tt) {
#pragma unroll
                for (int j = 0; j < 8; ++j) va[tt][j] = *(const u32x4*)(PV + (size_t)ecur[tt][j] * 1024 + lane * 16);
            }
            {
                const int bn = (bt + 1) & 15;
#pragma unroll
                for (int tt = 0; tt < 3; ++tt)
#pragma unroll
                    for (int j = 0; j < 8; ++j) ecur[tt][j] = __builtin_amdgcn_readfirstlane(eidL[(w + tt * 8) * 128 + bn * 8 + j]);
            }
#pragma unroll
            for (int tt = 0; tt < 3; ++tt) {
#pragma unroll
                for (int j = 0; j < 8; ++j) {
                    const float wj = wL[tt * 128 + bt * 8 + j];
                    const f32x2 wj2 = {wj, wj};
#pragma unroll
                    for (int q = 0; q < 4; ++q) {
                        f32x2 lo = __builtin_amdgcn_cvt_pk_f32_fp8((int)va[tt][j][q], false);
                        f32x2 hi = __builtin_amdgcn_cvt_pk_f32_fp8((int)va[tt][j][q], true);
                        acc2[tt][q * 2] = wj2 * lo + acc2[tt][q * 2];
                        acc2[tt][q * 2 + 1] = wj2 * hi + acc2[tt][q * 2 + 1];
                    }
                }
            }
            if (bt < 4) CONV_FINISH(bt)
            if (bt + 1 < 4) CONV_ISSUE(bt + 1)
        }
        int oz2 = 0; asm volatile("" : "+v"(oz2));
#pragma unroll
        for (int tt = 0; tt < 3; ++tt) {
            const int lane = (ltid() & 63) + oz2, w = (ltid() >> 6) + oz2;
            const int tok = t0 + w + tt * 8;
            float* xr = X + (size_t)tok * 1024;
            const float* m5 = mods + cond_of(tok) * 6144 + 5 * 1024;
            float x[16];
#pragma unroll
            for (int q = 0; q < 4; ++q) {
                float4 a = *(const float4*)(xr + q * 256 + lane * 4);
                float4 g = *(const float4*)(m5 + q * 256 + lane * 4);
                x[q * 4] = a.x + g.x * acc2[tt][q * 2][0]; x[q * 4 + 1] = a.y + g.y * acc2[tt][q * 2][1];
                x[q * 4 + 2] = a.z + g.z * acc2[tt][q * 2 + 1][0]; x[q * 4 + 3] = a.w + g.w * acc2[tt][q * 2 + 1][1];
            }
            float ss = 0.f;
#pragma unroll
            for (int j = 0; j < 16; ++j) ss += x[j] * x[j];
            ss = wave_sum(ss);
            const float rs = rsqrtf(ss * (1.0f / 1024.0f) + EPSV);
            if (l < 3) {
                float* xw = Xw + (size_t)tok * 1024;
                const float* modn = (const float*)(p.ws + OFF_MODS) + (size_t)(l + 1) * 3 * 6144 + cond_of(tok) * 6144;
                const float* g1 = p.in[I_N1G] + (l + 1) * 1024;
                bf16_t* hw = Hw + (size_t)tok * 1024;
#pragma unroll
                for (int q = 0; q < 4; ++q) {
                    const int d0 = q * 256 + lane * 4;
                    *(float4*)(xw + d0) = make_float4(x[q * 4], x[q * 4 + 1], x[q * 4 + 2], x[q * 4 + 3]);
                    float4 g = *(const float4*)(g1 + d0), sh = *(const float4*)(modn + d0), sc = *(const float4*)(modn + 1024 + d0);
                    float o0 = (x[q * 4] * rs * g.x) * (1.0f + sc.x) + sh.x, o1 = (x[q * 4 + 1] * rs * g.y) * (1.0f + sc.y) + sh.y;
                    float o2 = (x[q * 4 + 2] * rs * g.z) * (1.0f + sc.z) + sh.z, o3 = (x[q * 4 + 3] * rs * g.w) * (1.0f + sc.w) + sh.w;
                    *(uint2*)(hw + d0) = make_uint2(pack2(o0, o1), pack2(o2, o3));
                }
            } else {
                const float* g = p.in[I_FNG];
                float* yo = Yw + (size_t)tok * 1024;
#pragma unroll
                for (int q = 0; q < 4; ++q) {
                    const int d0 = q * 256 + lane * 4;
                    float4 g0 = *(const float4*)(g + d0);
                    *(float4*)(yo + d0) = make_float4(x[q * 4] * rs * g0.x, x[q * 4 + 1] * rs * g0.y, x[q * 4 + 2] * rs * g0.z, x[q * 4 + 3] * rs * g0.w);
                }
            }
        }
    }
}

#define RG_XS 68
#define RG_RS 257
__device__ __forceinline__ void rg_unit(const Params& p, int l, int seq, int n, int ct, float* lds) {
    const int tid0 = ltid(), lane0 = tid0 & 63, w0 = tid0 >> 6;
    const int jl = l >> 1;
    const int L = seq < 16 ? 256 : 1024;
    const int tokbase = seq < 16 ? seq * 256 : 4096 + (seq - 16) * 1024;
    const int nsteps = L >> 8;
    const int cbase = n * 64, obase = cbase + ct * 32;
    float* xr = lds;
    float* aS = lds + 256 * RG_XS;
    float* bS = aS + 32 * RG_RS;
    float* segA = bS + 32 * RG_RS;
    float* segB = segA + 512;
    bf16_t* wS = (bf16_t*)(segB + 512);
    const float* PB = (const float*)(p.ws + OFF_PB);
    float* HF = (float*)(p.ws + OFF_HF);
    bf16_t* Y = (bf16_t*)(p.ws + OFF_Y);
    const int cg0 = tid0 & 15, tr0 = tid0 >> 4;
    f32x4 cwv[4]; f32x4 cbv;
    {
        const float* cw = p.in[I_RGCW] + jl * 4096 + cbase + cg0 * 4;
#pragma unroll
        for (int j = 0; j < 4; ++j) cwv[j] = *(const f32x4*)(cw + j * 1024);
        cbv = *(const f32x4*)(p.in[I_RGCB] + jl * 1024 + cbase + cg0 * 4);
    }
    const int sc0 = tid0 & 31, sg0 = tid0 >> 5;
    f32x4 rw[11];
#define RG_ISSUE(pb_) { const int pos0_ = (pb_) + tr * 8 - 2; \
        _Pragma("unroll") for (int j = 0; j < 11; ++j) { const int pp_ = pos0_ + j; \
            f32x4 z_ = {0.f, 0.f, 0.f, 0.f}; if (pp_ >= 0 && pp_ < L) z_ = *(const f32x4*)(PB + (size_t)(tokbase + pp_) * 2048 + 1024 + cbase + cg * 4); rw[j] = z_; } }
    { const int tr = tr0, cg = cg0; RG_ISSUE(0) }
    float hfreg[16];
#pragma unroll
    for (int j = 0; j < 16; ++j) hfreg[j] = 0.f;
    __syncthreads();
#pragma unroll 1
    for (int d = 0; d < 2; ++d) {
        const int m = (jl * 2 + d) * 16 + n;
        const bf16_t* WT = (const bf16_t*)(p.ws + OFF_RGW) + (size_t)m * 2 * 4096;
        {
            const int g_ = tid0 >> 8, j_ = (tid0 >> 3) & 31, k8 = (tid0 & 7) * 8;
            *(u32x4*)(wS + (g_ * 32 + j_) * 72 + k8) = *(const u32x4*)(WT + g_ * 4096 + (ct * 32 + j_) * 64 + k8);
        }
        const int cch = obase + (lane0 & 31);
        const float bav = p.in[I_RGBA][(jl * 2 + d) * 1024 + cch];
        const float biv = p.in[I_RGBI][(jl * 2 + d) * 1024 + cch];
        const float spv = __logf(1.0f + __expf(-p.in[I_RGLAM][(jl * 2 + d) * 1024 + cch]));
        float hc = 0.f;
        if (seq >= 16) hc = p.in[I_SRG][(((seq - 16) * 2 + jl) * 2 + d) * 1024 + obase + sc0];
#pragma unroll 1
        for (int st = 0; st < nsteps; ++st) {
            const int pbase = d ? (L - 256 - st * 256) : st * 256;
            int oz = 0; asm volatile("" : "+v"(oz));
            const int lane = lane0 + oz, w = w0 + oz, tid = tid0 + oz;
            const int cg = tid & 15, tr = tid >> 4, sc = tid & 31, sg = tid >> 5, tt = tid >> 1, half = tid & 1;
            if (!(nsteps == 1 && d == 1)) {
#pragma unroll
                for (int t = 0; t < 8; ++t) {
                    f32x4 o = cbv + cwv[0] * rw[t] + cwv[1] * rw[t + 1] + cwv[2] * rw[t + 2] + cwv[3] * rw[t + 3];
                    *(f32x4*)(xr + (tr * 8 + t) * RG_XS + cg * 4) = o;
                }
                if (nsteps > 1) {
                    int nd = d, nst = st + 1;
                    if (nst == nsteps) { nd = d + 1; nst = 0; }
                    if (nd < 2) { const int npb = nd ? (L - 256 - nst * 256) : nst * 256; RG_ISSUE(npb) }
                }
            }
            __syncthreads();
            f32x16 accR, accI;
#pragma unroll
            for (int i = 0; i < 16; ++i) { accR[i] = 0.f; accI[i] = 0.f; }
#pragma unroll
            for (int kk = 0; kk < 4; ++kk) {
                const float* ap = xr + (w * 32 + (lane & 31)) * RG_XS + kk * 16 + (lane >> 5) * 8;
                const float4 x0 = *(const float4*)ap, x1 = *(const float4*)(ap + 4);
                union { bf16x8 v; unsigned u[4]; } af;
                af.u[0] = pack2(x0.x, x0.y); af.u[1] = pack2(x0.z, x0.w); af.u[2] = pack2(x1.x, x1.y); af.u[3] = pack2(x1.z, x1.w);
                const bf16x8 bRk = *(const bf16x8*)(wS + (lane & 31) * 72 + kk * 16 + (lane >> 5) * 8);
                const bf16x8 bIk = *(const bf16x8*)(wS + (32 + (lane & 31)) * 72 + kk * 16 + (lane >> 5) * 8);
                accR = __builtin_amdgcn_mfma_f32_32x32x16_bf16(af.v, bRk, accR, 0, 0, 0);
                accI = __builtin_amdgcn_mfma_f32_32x32x16_bf16(af.v, bIk, accI, 0, 0, 0);
            }
#pragma unroll
            for (int r = 0; r < 16; ++r) {
                const int row = w * 32 + (r & 3) + 8 * (r >> 2) + 4 * (lane >> 5);
                const float rg = sigmoidf_(accR[r] + bav);
                const float ig = sigmoidf_(accI[r] + biv);
                const float av = __expf(-8.0f * rg * spv);
                const float mult = sqrtf(fmaxf(1.0f - av * av, 0.f));
                const float xc = xr[row * RG_XS + ct * 32 + (lane & 31)];
                const int s_ = d ? 255 - row : row;
                aS[(lane & 31) * RG_RS + s_] = av;
                bS[(lane & 31) * RG_RS + s_] = mult * ig * xc;
            }
            const int tok = tokbase + pbase + tt;
            f32x4 gq[4], hq[4];
            if (d == 1) {
                const float* gp = PB + (size_t)tok * 2048 + obase + half * 16;
#pragma unroll
                for (int j = 0; j < 4; ++j) gq[j] = *(const f32x4*)(gp + j * 4);
                if (nsteps > 1) {
                    const float* hp = HF + (size_t)tok * 1024 + obase + half * 16;
#pragma unroll
                    for (int j = 0; j < 4; ++j) hq[j] = *(const f32x4*)(hp + j * 4);
                }
            }
            __syncthreads();
            {
                const int base = sc * RG_RS + sg * 16;
                float av[16], bv[16];
                float Aa = 1.f, Bb = 0.f;
#pragma unroll
                for (int i = 0; i < 16; ++i) { av[i] = aS[base + i]; bv[i] = bS[base + i]; Bb = av[i] * Bb + bv[i]; Aa *= av[i]; }
                segA[sg * 32 + sc] = Aa; segB[sg * 32 + sc] = Bb;
                __syncthreads();
                float hin = hc, hall = hc;
#pragma unroll
                for (int g = 0; g < 16; ++g) {
                    const float sa = segA[g * 32 + sc], sb = segB[g * 32 + sc];
                    hall = sa * hall + sb;
                    if (g < sg) hin = hall;
                }
                float hcur = hin;
#pragma unroll
                for (int i = 0; i < 16; ++i) { hcur = av[i] * hcur + bv[i]; bS[base + i] = hcur; }
                hc = hall;
            }
            __syncthreads();
            {
                const int s_ = d ? 255 - tt : tt;
                float hv[16];
#pragma unroll
                for (int j = 0; j < 16; ++j) hv[j] = bS[(half * 16 + j) * RG_RS + s_];
                if (d == 0) {
                    if (nsteps == 1) {
#pragma unroll
                        for (int j = 0; j < 16; ++j) hfreg[j] = hv[j];
                    } else {
                        float* hp = HF + (size_t)tok * 1024 + obase + half * 16;
#pragma unroll
                        for (int j = 0; j < 4; ++j) *(float4*)(hp + j * 4) = make_float4(hv[4 * j], hv[4 * j + 1], hv[4 * j + 2], hv[4 * j + 3]);
                    }
                } else {
                    float hf[16];
                    if (nsteps == 1) {
#pragma unroll
                        for (int j = 0; j < 16; ++j) hf[j] = hfreg[j];
                    } else {
#pragma unroll
                        for (int j = 0; j < 4; ++j) { hf[4 * j] = hq[j][0]; hf[4 * j + 1] = hq[j][1]; hf[4 * j + 2] = hq[j][2]; hf[4 * j + 3] = hq[j][3]; }
                    }
                    unsigned o[8];
#pragma unroll
                    for (int j = 0; j < 4; ++j) {
                        o[2 * j] = pack2(gq[j][0] * (hf[4 * j] + hv[4 * j]), gq[j][1] * (hf[4 * j + 1] + hv[4 * j + 1]));
                        o[2 * j + 1] = pack2(gq[j][2] * (hf[4 * j + 2] + hv[4 * j + 2]), gq[j][3] * (hf[4 * j + 3] + hv[4 * j + 3]));
                    }
                    bf16_t* yp = Y + (size_t)tok * 1024 + obase + half * 16;
                    *(uint4*)yp = make_uint4(o[0], o[1], o[2], o[3]);
                    *(uint4*)(yp + 8) = make_uint4(o[4], o[5], o[6], o[7]);
                }
            }
        }
        if (seq < 16 && sg0 == 0)
            p.out[OUT_RG + ((seq * 2 + jl) * 2 + d) * 1024 + obase + sc0] = hc;
    }
}

__device__ __forceinline__ void phase_rgscan(const Params& p, int l, float* lds) {
    const int b = blockIdx.x, G = gridDim.x;
    int u, stride, end;
    if (G == 256) { if (b < 64) { u = b; stride = 1024; end = 64; } else { u = 64 + (b - 64); stride = 192; end = 576; } }
    else { u = b; stride = G; end = 576; }
#pragma unroll 1
    for (; u < end; u += stride) {
        int seq, rest;
        if (u < 64) { seq = 16 + (u >> 5); rest = u & 31; } else { seq = (u - 64) >> 5; rest = (u - 64) & 31; }
        rg_unit(p, l, seq, rest >> 1, rest & 1, lds);
    }
    if (G == 256 && b >= 192) {
#pragma unroll 1
        for (int k = 0; k < 4; ++k) setup_convert_unit(p, 256 + 1024 + l * 256 + (b - 192) * 4 + k, true);
    }
}

__device__ __forceinline__ int gla_tok(int seq, int d, int sidx) {
    if (seq < 16) { int pp = d ? 255 - sidx : sidx; return seq * 256 + pp; }
    int pp = d ? 1023 - sidx : sidx;
    return 4096 + (seq - 16) * 1024 + ((pp & 15) << 6) + (pp >> 4);
}

__device__ __forceinline__ int gla_uidx(int seq, int c, int h, int d) {
    const int cg = seq < 16 ? seq * 4 + c : 64 + (seq - 16) * 16 + c;
    return (cg * 4 + h) * 2 + d;
}

__device__ __forceinline__ void gla_pre_unit(const Params& p, int l, int seq, int h, int d, int c, float* ldsf) {
    const int tid = ltid(), lane = tid & 63, w = tid >> 6;
    const int jl = l >> 1;
    float* zs = ldsf;
    float* tot = ldsf + 1024;
    float* gd = ldsf + 1536;
    bf16_t* qin = (bf16_t*)(ldsf + 1664);
    bf16_t* kin = qin + 64 * 136;
    bf16_t* kinT = kin + 64 * 136;
    bf16_t* att = kinT + 128 * 72;
    bf16_t* vT = att + 64 * 72;
    const float* PB = (const float*)(p.ws + OFF_PB);
    float* O = (float*)(p.ws + (d ? OFF_HB : OFF_HF));
    const int uidx = gla_uidx(seq, c, h, d);
    const int kk = tid & 127, ig = tid >> 7;
    const int dvv = tid & 63, i8 = tid >> 6;
    float4 zreg = make_float4(0.f, 0.f, 0.f, 0.f);
    float qreg[16], kreg[16];
    if (tid < 256) { const int tok_ = gla_tok(seq, d, c * 64 + (tid >> 2)); zreg = *(const float4*)(PB + (size_t)tok_ * 3104 + 3072 + d * 16 + (tid & 3) * 4); }
#pragma unroll
    for (int ii = 0; ii < 16; ++ii) {
        const int tok_ = gla_tok(seq, d, c * 64 + ig * 16 + ii);
        qreg[ii] = PB[(size_t)tok_ * 3104 + h * 128 + kk]; kreg[ii] = PB[(size_t)tok_ * 3104 + 512 + h * 128 + kk];
    }
    f32x2 wal2[8];
#pragma unroll
    for (int r = 0; r < 8; ++r) {
        wal2[r][0] = p.in[I_GLWAL][((size_t)(jl * 2 + d) * 16 + 2 * r) * 512 + h * 128 + kk];
        wal2[r][1] = p.in[I_GLWAL][((size_t)(jl * 2 + d) * 16 + 2 * r + 1) * 512 + h * 128 + kk];
    }
    const float bal = p.in[I_GLBAL][(jl * 2 + d) * 512 + h * 128 + kk];
    __syncthreads();
    if (tid < 256) *(float4*)(zs + (tid >> 2) * 16 + (tid & 3) * 4) = zreg;
    {
        float vreg[4][8];
#pragma unroll
        for (int ii = 0; ii < 8; ++ii) {
            const int tok_ = gla_tok(seq, d, c * 64 + i8 * 8 + ii);
#pragma unroll
            for (int g = 0; g < 4; ++g) vreg[g][ii] = PB[(size_t)tok_ * 3104 + 1024 + h * 256 + g * 64 + dvv];
        }
#pragma unroll
        for (int g = 0; g < 4; ++g)
            *(uint4*)(vT + (g * 64 + dvv) * 72 + i8 * 8) = make_uint4(pack2(vreg[g][0], vreg[g][1]), pack2(vreg[g][2], vreg[g][3]), pack2(vreg[g][4], vreg[g][5]), pack2(vreg[g][6], vreg[g][7]));
    }
    __syncthreads();
    float cum[16]; float run = 0.f;
#pragma unroll
    for (int ii = 0; ii < 16; ++ii) {
        const int i = ig * 16 + ii;
        const f32x4 z0 = *(const f32x4*)(zs + i * 16), z1 = *(const f32x4*)(zs + i * 16 + 4), z2 = *(const f32x4*)(zs + i * 16 + 8), z3 = *(const f32x4*)(zs + i * 16 + 12);
        f32x2 xa = z0.xy * wal2[0];
        xa = z0.zw * wal2[1] + xa; xa = z1.xy * wal2[2] + xa; xa = z1.zw * wal2[3] + xa;
        xa = z2.xy * wal2[4] + xa; xa = z2.zw * wal2[5] + xa; xa = z3.xy * wal2[6] + xa; xa = z3.zw * wal2[7] + xa;
        const float x = bal + xa[0] + xa[1];
        const float ls = fminf(x, 0.f) - __logf(1.0f + __expf(-fabsf(x)));
        run += ls * 0.0625f; cum[ii] = run;
    }
    tot[ig * 128 + kk] = run;
    __syncthreads();
    float off = 0.f, blast = 0.f;
#pragma unroll
    for (int g = 0; g < 4; ++g) { const float tv = tot[g * 128 + kk]; blast += tv; if (g < ig) off += tv; }
    if (ig == 0) { const float gv = __expf(blast); ((float*)(p.ws + OFF_GD))[(size_t)uidx * 128 + kk] = gv; }
    {
        unsigned kp[8];
#pragma unroll
        for (int ii = 0; ii < 16; ++ii) {
            const int i = ig * 16 + ii;
            const float bc = off + cum[ii];
            const unsigned qk = pack2(qreg[ii] * __expf(bc), kreg[ii] * __expf(-bc));
            const unsigned qb = qk & 0xffffu, kb = qk >> 16;
            qin[i * 136 + kk] = (bf16_t)qb;
            kin[i * 136 + kk] = (bf16_t)kb;
            if (ii & 1) kp[ii >> 1] |= kb << 16; else kp[ii >> 1] = kb;
        }
        *(uint4*)(kinT + kk * 72 + ig * 16) = make_uint4(kp[0], kp[1], kp[2], kp[3]);
        *(uint4*)(kinT + kk * 72 + ig * 16 + 8) = make_uint4(kp[4], kp[5], kp[6], kp[7]);
    }
    __syncthreads();
    {
        const uint4* qs = (const uint4*)qin;
        uint4* qg = (uint4*)(p.ws + OFF_QIN + (size_t)uidx * 64 * 136 * 2);
        for (int i = tid; i < 1088; i += NTHR) qg[i] = qs[i];
    }
    const int mt = w >> 1;
    const int l15 = lane & 15, l4 = lane >> 4;
#pragma unroll
    for (int nn = 0; nn < 2; ++nn) {
        const int nt = (w & 1) * 2 + nn;
        f32x4 acc = {0.f, 0.f, 0.f, 0.f};
        if (nt <= mt) {
#pragma unroll
            for (int ks = 0; ks < 4; ++ks) {
                bf16x8 a = *(const bf16x8*)(qin + (mt * 16 + l15) * 136 + ks * 32 + l4 * 8);
                bf16x8 b = *(const bf16x8*)(kin + (nt * 16 + l15) * 136 + ks * 32 + l4 * 8);
                acc = __builtin_amdgcn_mfma_f32_16x16x32_bf16(a, b, acc, 0, 0, 0);
            }
        }
#pragma unroll
        for (int r = 0; r < 4; ++r) {
            const int i = mt * 16 + l4 * 4 + r, j = nt * 16 + l15;
            att[i * 72 + j] = (bf16_t)f2bf(j <= i ? acc[r] : 0.f);
        }
    }
    {
        uint2* ug = (uint2*)(p.ws + OFF_UR) + ((size_t)uidx * 8 + w) * 16 * 64 + lane;
        const bf16x8 a0 = *(const bf16x8*)(kinT + (w * 16 + l15) * 72 + l4 * 8);
        const bf16x8 a1 = *(const bf16x8*)(kinT + (w * 16 + l15) * 72 + 32 + l4 * 8);
#pragma unroll 4
        for (int nt = 0; nt < 16; ++nt) {
            f32x4 acc = {0.f, 0.f, 0.f, 0.f};
            bf16x8 b0 = *(const bf16x8*)(vT + (nt * 16 + l15) * 72 + l4 * 8);
            bf16x8 b1 = *(const bf16x8*)(vT + (nt * 16 + l15) * 72 + 32 + l4 * 8);
            acc = __builtin_amdgcn_mfma_f32_16x16x32_bf16(a0, b0, acc, 0, 0, 0);
            acc = __builtin_amdgcn_mfma_f32_16x16x32_bf16(a1, b1, acc, 0, 0, 0);
            ug[nt * 64] = make_uint2(pack2(acc[0], acc[1]), pack2(acc[2], acc[3]));
        }
    }
    __syncthreads();
    {
        const bf16x8 a0 = *(const bf16x8*)(att + (mt * 16 + l15) * 72 + l4 * 8);
        const bf16x8 a1 = *(const bf16x8*)(att + (mt * 16 + l15) * 72 + 32 + l4 * 8);
        int tokr[4];
#pragma unroll
        for (int r = 0; r < 4; ++r) tokr[r] = gla_tok(seq, d, c * 64 + mt * 16 + l4 * 4 + r);
#pragma unroll 4
        for (int nn = 0; nn < 8; ++nn) {
            const int nt = (w & 1) * 8 + nn;
            f32x4 acc = {0.f, 0.f, 0.f, 0.f};
            bf16x8 b0 = *(const bf16x8*)(vT + (nt * 16 + l15) * 72 + l4 * 8);
            bf16x8 b1 = *(const bf16x8*)(vT + (nt * 16 + l15) * 72 + 32 + l4 * 8);
            acc = __builtin_amdgcn_mfma_f32_16x16x32_bf16(a0, b0, acc, 0, 0, 0);
            acc = __builtin_amdgcn_mfma_f32_16x16x32_bf16(a1, b1, acc, 0, 0, 0);
#pragma unroll
            for (int r = 0; r < 4; ++r) O[(size_t)tokr[r] * 1024 + h * 256 + nt * 16 + l15] = acc[r];
        }
    }
}

__device__ __forceinline__ void phase_gla_pre(const Params& p, int l, float* lds) {
#pragma unroll 1
    for (int u = blockIdx.x; u < 768; u += gridDim.x) {
        const int d = u & 1, h = (u >> 1) & 3, cg = u >> 3;
        int seq, c;
        if (cg < 64) { seq = cg >> 2; c = cg & 3; } else { seq = 16 + ((cg - 64) >> 4); c = (cg - 64) & 15; }
        gla_pre_unit(p, l, seq, h, d, c, lds);
    }
}

__device__ __forceinline__ void gla_scan_unit(const Params& p, int l, int seq, int h, int d, int e, float* ldsf, bool dry) {
    const int tid = ltid(), lane = tid & 63, w = tid >> 6;
    const int jl = l >> 1;
    const int nch = seq < 16 ? 4 : 16;
    bf16_t* ST = (bf16_t*)ldsf;
    float* O = (float*)(p.ws + (d ? OFF_HB : OFF_HF));
    float* Ow = dry ? (float*)(p.ws + WS_END) : O;
    const int kt = w, mt = w >> 1;
    const int l15 = lane & 15, l4 = lane >> 4;
    f32x4 S[4];
    __syncthreads();
#pragma unroll
    for (int nt = 0; nt < 4; ++nt) {
#pragma unroll
        for (int r = 0; r < 4; ++r) {
            const int k = kt * 16 + l4 * 4 + r, dv = nt * 16 + l15;
            float v = 0.f;
            if (seq >= 16) v = p.in[I_SGLA][((((size_t)((seq - 16) * 2 + jl) * 2 + d) * 4 + h) * 128 + k) * 256 + e * 64 + dv];
            S[nt][r] = v;
        }
        *(uint2*)(ST + (nt * 16 + l15) * 136 + kt * 16 + l4 * 4) = make_uint2(pack2(S[nt][0], S[nt][1]), pack2(S[nt][2], S[nt][3]));
    }
    bf16x8 aA[4], aB[4], aC[4];
    uint2 uA[4], uB[4], uC[4];
    f32x4 gA, gB, gC, oA[2], oB[2], oC[2];
#define GLB_LOAD(S_, c_) { const int ui_ = gla_uidx(seq, (c_), h, d); \
        const uint2* ug_ = (const uint2*)(p.ws + OFF_UR) + ((size_t)ui_ * 8 + kt) * 16 * 64 + lane; \
        _Pragma("unroll") for (int nt = 0; nt < 4; ++nt) u##S_[nt] = ug_[(e * 4 + nt) * 64]; \
        g##S_ = *(const f32x4*)((const float*)(p.ws + OFF_GD) + (size_t)ui_ * 128 + kt * 16 + l4 * 4); \
        const bf16_t* qg_ = (const bf16_t*)(p.ws + OFF_QIN) + (size_t)ui_ * 64 * 136 + (mt * 16 + l15) * 136 + l4 * 8; \
        _Pragma("unroll") for (int ks = 0; ks < 4; ++ks) a##S_[ks] = *(const bf16x8*)(qg_ + ks * 32); \
        _Pragma("unroll") for (int nn = 0; nn < 2; ++nn) { _Pragma("unroll") for (int r = 0; r < 4; ++r) { \
            const int tok_ = gla_tok(seq, d, (c_) * 64 + mt * 16 + l4 * 4 + r); \
            o##S_[nn][r] = O[(size_t)tok_ * 1024 + h * 256 + e * 64 + ((w & 1) * 2 + nn) * 16 + l15]; } } }
#define GLB_STEP(S_, cc_) if ((cc_) < nch) { \
        _Pragma("unroll") for (int nn = 0; nn < 2; ++nn) { \
            const int nt = (w & 1) * 2 + nn; \
            f32x4 acc = o##S_[nn]; \
            _Pragma("unroll") for (int ks = 0; ks < 4; ++ks) { \
                bf16x8 b = *(const bf16x8*)(ST + (nt * 16 + l15) * 136 + ks * 32 + l4 * 8); \
                acc = __builtin_amdgcn_mfma_f32_16x16x32_bf16(a##S_[ks], b, acc, 0, 0, 0); } \
            _Pragma("unroll") for (int r = 0; r < 4; ++r) { \
                const int tok_ = gla_tok(seq, d, (cc_) * 64 + mt * 16 + l4 * 4 + r); \
                Ow[(size_t)tok_ * 1024 + h * 256 + e * 64 + nt * 16 + l15] = acc[r]; } } \
        __syncthreads(); \
        _Pragma("unroll") for (int nt = 0; nt < 4; ++nt) { \
            { const uint2 uu_ = u##S_[nt]; const f32x4 uf_ = {bflo(uu_.x), bfhi(uu_.x), bflo(uu_.y), bfhi(uu_.y)}; S[nt] = g##S_ * (S[nt] + uf_); } \
            *(uint2*)(ST + (nt * 16 + l15) * 136 + kt * 16 + l4 * 4) = make_uint2(pack2(S[nt][0], S[nt][1]), pack2(S[nt][2], S[nt][3])); } \
        if ((cc_) + 3 < nch) GLB_LOAD(S_, (cc_) + 3) \
        __syncthreads(); }
    GLB_LOAD(A, 0) GLB_LOAD(B, 1) GLB_LOAD(C, 2)
    __syncthreads();
#pragma unroll
    for (int c = 0; c < 18; c += 3) {
        int oz = 0; asm volatile("" : "+v"(oz));
        const int lane_i = lane + oz, w_i = w + oz;
        {
            const int lane = lane_i, w = w_i, kt = w_i, mt = w_i >> 1, l15 = lane_i & 15, l4 = lane_i >> 4;
            GLB_STEP(A, c)
            GLB_STEP(B, c + 1)
            GLB_STEP(C, c + 2)
        }
    }
    if (seq < 16) {
#pragma unroll
        for (int nt = 0; nt < 4; ++nt)
#pragma unroll
            for (int r = 0; r < 4; ++r) {
                const int k = kt * 16 + l4 * 4 + r, dv = nt * 16 + l15;
                p.out[OUT_GLA + ((((size_t)(seq * 2 + jl) * 2 + d) * 4 + h) * 128 + k) * 256 + e * 64 + dv] = S[nt][r];
            }
    }
}

__device__ __forceinline__ void phase_gla(const Params& p, int l, float* lds, bool dry = false) {
    const int b = blockIdx.x, G = gridDim.x;
    int u, stride, end;
    if (G == 256) { if (b < 64) { u = b; stride = 1024; end = 64; } else { u = 64 + (b - 64); stride = 192; end = 576; } }
    else { u = b; stride = G; end = 576; }
#pragma unroll 1
    for (; u < end; u += stride) {
        int seq, rest;
        if (u < 64) { seq = 16 + (u >> 5); rest = u & 31; } else { seq = (u - 64) >> 5; rest = (u - 64) & 31; }
        gla_scan_unit(p, l, seq, rest >> 3, (rest >> 2) & 1, rest & 3, lds, dry);
    }
}

__device__ __forceinline__ void phase_gla_norm(const Params& p, int l) {
    const int lane = ltid() & 63, w = ltid() >> 6;
    const int jl = l >> 1;
    const float* OF = (const float*)(p.ws + OFF_HF);
    const float* OB = (const float*)(p.ws + OFF_HB);
    const float* PB = (const float*)(p.ws + OFF_PB);
    bf16_t* Y = (bf16_t*)(p.ws + OFF_Y);
    const float* ng = p.in[I_GLNG] + jl * 1024;
    for (int tok = blockIdx.x * 8 + w; tok < TTOK; tok += gridDim.x * 8) {
#pragma unroll
        for (int hh = 0; hh < 4; ++hh) {
            const int d0 = hh * 256 + lane * 4;
            float4 a = *(const float4*)(OF + (size_t)tok * 1024 + d0), b = *(const float4*)(OB + (size_t)tok * 1024 + d0);
            float o0 = a.x + b.x, o1 = a.y + b.y, o2 = a.z + b.z, o3 = a.w + b.w;
            float ss = wave_sum(o0 * o0 + o1 * o1 + o2 * o2 + o3 * o3);
            const float rs = rsqrtf(ss * (1.0f / 256.0f) + EPSV);
            float4 gn = *(const float4*)(ng + d0);
            float4 gg = *(const float4*)(PB + (size_t)tok * 3104 + 2048 + d0);
            float y0 = siluf_(gg.x) * (o0 * rs * gn.x), y1 = siluf_(gg.y) * (o1 * rs * gn.y);
            float y2 = siluf_(gg.z) * (o2 * rs * gn.z), y3 = siluf_(gg.w) * (o3 * rs * gn.w);
            *(uint2*)(Y + (size_t)tok * 1024 + d0) = make_uint2(pack2(y0, y1), pack2(y2, y3));
        }
    }
}

#define LDS_FLOATS 38400
#define NPHASE 34
#ifndef REP_MASK
#define REP_MASK 0
#endif

__device__ __forceinline__ bool phase_noop(int ph) {
    if (ph < 2) return false;
    const int l = (ph - 2) / 8, s = (ph - 2) % 8;
    return ((s == 2) || (s == 3)) && ((l & 1) == 0);
}

__global__ void __launch_bounds__(NTHR) hybrid_fwd(Params p) {
    __shared__ __attribute__((aligned(16))) float lds[LDS_FLOATS];
    __shared__ uint4 xb_words;
    if (threadIdx.x == 0) xb_words = make_uint4(0u, 0u, 0u, 0u);
    __syncthreads();
    XcdBarrier bar = xcd_barrier_post((unsigned*)(p.ws + OFF_BAR), (volatile LAS unsigned*)&xb_words);
    bool first = true;
    for (int ph = p.ph_lo; ph < p.ph_hi; ++ph) {
        if (phase_noop(ph)) continue;
        if (!first) xcd_barrier(bar);
        first = false;
        if (ph == 0) { for (int r = 0; r < 1 + ((REP_MASK >> 0) & 1); ++r) { if (r) __syncthreads(); phase_setup(p, lds); } }
        else if (ph == 1) phase_norm(p, 0, 0);
        else {
            const int l = (ph - 2) / 8, s = (ph - 2) % 8;
            const bool gla = (l & 1) != 0;
            if (s == 0 || s == 4) {
                const int kind = (s == 4) ? EPI_OUT : (gla ? EPI_GLAIN : EPI_RGIN);
                const int nrep = 1 + ((REP_MASK >> 2) & 1);
                for (int r = 0; r < nrep; ++r) { if (r) __syncthreads(); phase_gemm(p, l, kind, lds, (kind == EPI_OUT) && (r + 1 < nrep)); }
            } else switch (s) {
                case 1: if (gla) { for (int r = 0; r < 1 + ((REP_MASK >> 4) & 1); ++r) { if (r) __syncthreads(); phase_gla_pre(p, l, lds); } }
                        else { for (int r = 0; r < 1 + ((REP_MASK >> 3) & 1); ++r) { if (r) __syncthreads(); phase_rgscan(p, l, lds); } } break;
                case 2: { const int nrep = 1 + ((REP_MASK >> 5) & 1); for (int r = 0; r < nrep; ++r) { if (r) __syncthreads(); phase_gla(p, l, lds, r + 1 < nrep); } } break;
                case 3: phase_gla_norm(p, l); break;
                case 5: for (int r = 0; r < 1 + ((REP_MASK >> 1) & 1); ++r) phase_norm(p, l, 1); break;
                case 6: for (int r = 0; r < 1 + ((REP_MASK >> 6) & 1); ++r) { if (r) __syncthreads(); phase_peerq(p, l, lds); } break;
                case 7: { const int nrep = 1 + ((REP_MASK >> 7) & 1); for (int r = 0; r < nrep; ++r) { if (r) __syncthreads(); phase_peer_gather(p, l, lds, r + 1 < nrep); } } break;
            }
        }
    }
}

extern "C" void kernel_launch(void* const* d_in, const int* in_sizes, int n_in, void* d_out, int out_size, void* d_ws, size_t ws_size,
                              hipStream_t stream) {
    static int grid = 0;
    if (grid == 0) {
        int dev = 0, cus = 0, per_cu = 0;
        hipGetDevice(&dev);
        hipDeviceGetAttribute(&cus, hipDeviceAttributeMultiprocessorCount, dev);
        hipOccupancyMaxActiveBlocksPerMultiprocessor(&per_cu, (const void*)hybrid_fwd, NTHR, 0);
        (void)hipGetLastError();
        if (per_cu < 1) fprintf(stderr, "kernel_launch: occupancy query says %d blocks per CU\n", per_cu);
        grid = cus > 0 ? cus : 256;
        if (ws_size < WS_END) fprintf(stderr, "kernel_launch: workspace too small (%zu < %zu)\n", ws_size, (size_t)WS_END);
    }
    hipMemsetAsync((char*)d_ws + OFF_BAR, 0, 16384, stream);
    Params p{};
    for (int i = 0; i < 30; ++i) p.in[i] = (const float*)d_in[i];
    p.out = (float*)d_out; p.ws = (unsigned char*)d_ws;
#if MULTI_LAUNCH
    for (int ph = 0; ph < NPHASE; ++ph) {
        p.ph_lo = ph; p.ph_hi = ph + 1;
        hipLaunchKernelGGL(hybrid_fwd, dim3(grid), dim3(NTHR), 0, stream, p);
    }
#else
    p.ph_lo = 0; p.ph_hi = NPHASE;
    void* args[] = {&p};
    hipError_t e = hipLaunchCooperativeKernel((const void*)hybrid_fwd, dim3(grid), dim3(NTHR), args, 0, stream);
    if (e != hipSuccess) fprintf(stderr, "cooperative launch failed: %s (grid %d)\n", hipGetErrorString(e), grid);
#endif
}
```
